# Optimizing an MI355X kernel written in HIP

```python
import math
import jax
import jax.numpy as jnp
from jax import lax
import numpy as np

D_MODEL = 1024
BATCH = 8
SEQ = 4096
DEPTH = 2

HEAD_DIM = 64
MIX_WIDTH = D_MODEL
N_MIXERS = 4
GROUP_WIDTH = MIX_WIDTH // N_MIXERS
DIL_HEADS = GROUP_WIDTH // HEAD_DIM
DIL_PATTERNS = ((128, 1), (512, 4), (2048, 16))
DIL_MAX_WIN = 2048
Q_BLOCK = 128
NSA_HEADS = GROUP_WIDTH // HEAD_DIM
NSA_CMP_LEN = 32
NSA_CMP_STRIDE = 16
NSA_CMP_HIDDEN = 256
NSA_SEL_LEN = 64
NSA_TOPN = 16
NSA_WIN = 512
NSA_BRANCHES = 3
FORCE_BONUS = 1.0e4
GLA_HEADS = 4
GLA_DV = GROUP_WIDTH // GLA_HEADS
GLA_DK = GLA_DV // 2
GLA_RANK = 16
GLA_TAU = 16.0
GLA_CHUNK = 16
S5_GROUP = 16
S5_GROUPS = GROUP_WIDTH // S5_GROUP
S5_STATE = 64
D_FF = 2752
N_EXPERTS = 8
TOP_K = 2
D_FF_EXPERT = 3584
N_SOFTMAX_HEADS = DIL_HEADS + NSA_HEADS
EPS = 1e-6
NEG_INF = -1e30

PROJ_LAYOUT = (
    ("dil_q", GROUP_WIDTH), ("dil_k", GROUP_WIDTH), ("dil_v", GROUP_WIDTH),
    ("nsa_q", GROUP_WIDTH),
    ("nsa_k_cmp", HEAD_DIM), ("nsa_v_cmp", HEAD_DIM),
    ("nsa_k_slc", HEAD_DIM), ("nsa_v_slc", HEAD_DIM),
    ("nsa_k_win", HEAD_DIM), ("nsa_v_win", HEAD_DIM),
    ("nsa_gate", NSA_HEADS * NSA_BRANCHES),
    ("gla_q", GLA_HEADS * GLA_DK), ("gla_k", GLA_HEADS * GLA_DK), ("gla_v", GROUP_WIDTH),
    ("gla_a", GLA_RANK), ("gla_r", GROUP_WIDTH),
    ("s5_u", GROUP_WIDTH),
)
PROJ_WIDTH = sum(w for _, w in PROJ_LAYOUT)

kernel_name = "hybrid_parallel_mixer_block"


def rms_norm(x, g):
    xf = x.astype(jnp.float32)
    y = xf * lax.rsqrt(jnp.mean(xf * xf, axis=-1, keepdims=True) + EPS)
    return (y * g.astype(jnp.float32)).astype(x.dtype)


def to_heads(t, n):
    b, s, _ = t.shape
    return t.reshape(b, s, n, -1).transpose(0, 2, 1, 3)


def from_heads(t):
    b, h, s, d = t.shape
    return t.transpose(0, 2, 1, 3).reshape(b, s, h * d)


def split_proj(p):
    out = []
    o = 0
    for _, w in PROJ_LAYOUT:
        out.append(p[..., o:o + w])
        o += w
    return out


def alibi_slopes(n):
    return 2.0 ** (-8.0 * jnp.arange(1, n + 1, dtype=jnp.float32) / n)


def dilated_attention(q, k, v, slopes):
    f32 = jnp.float32
    B, H, S, Dh = q.shape
    scale = Dh ** -0.5
    q = q.astype(f32)
    kp = jnp.pad(k.astype(f32), ((0, 0), (0, 0), (DIL_MAX_WIN, 0), (0, 0)))
    vp = jnp.pad(v.astype(f32), ((0, 0), (0, 0), (DIL_MAX_WIN, 0), (0, 0)))
    nb = S // Q_BLOCK
    q_blk = q.reshape(B, H, nb, Q_BLOCK, Dh).transpose(2, 0, 1, 3, 4)
    slope = slopes[None, :, None, None]

    def block(args):
        qb, t0 = args
        tq = t0 + jnp.arange(Q_BLOCK)
        outs, lses = [], []
        for win, dil in DIL_PATTERNS:
            n_keys = win // dil + 1
            j = jnp.arange(n_keys)
            pos = tq[:, None] - j[None, :] * dil
            idx = (pos + DIL_MAX_WIN).reshape(-1)
            kg = jnp.take(kp, idx, axis=2).reshape(B, H, Q_BLOCK, n_keys, Dh)
            vg = jnp.take(vp, idx, axis=2).reshape(B, H, Q_BLOCK, n_keys, Dh)
            s = jnp.einsum('bhqd,bhqkd->bhqk', qb, kg) * scale - slope * (j * dil).astype(f32)
            s = jnp.where((pos >= 0)[None, None], s, -jnp.inf)
            m = jnp.max(s, axis=-1, keepdims=True)
            p = jnp.exp(s - m)
            den = jnp.sum(p, axis=-1, keepdims=True)
            outs.append(jnp.einsum('bhqk,bhqkd->bhqd', p, vg) / den)
            lses.append(m + jnp.log(den))
        w = jax.nn.softmax(jnp.stack(lses, 0), axis=0)
        return jnp.sum(w * jnp.stack(outs, 0), axis=0)

    out = lax.map(block, (q_blk, jnp.arange(nb) * Q_BLOCK))
    return out.transpose(1, 2, 0, 3, 4).reshape(B, H, S, Dh)


def compress_blocks(kv, pos_emb, w1, w2):
    B, S, Dh = kv.shape
    n_cmp = (S - NSA_CMP_LEN) // NSA_CMP_STRIDE + 1
    idx = jnp.arange(n_cmp)[:, None] * NSA_CMP_STRIDE + jnp.arange(NSA_CMP_LEN)[None, :]
    blocks = kv[:, idx] + pos_emb
    h = jax.nn.gelu(blocks.reshape(B, n_cmp, NSA_CMP_LEN * Dh) @ w1)
    return h @ w2


def nsa_attention(q, k_cmp, v_cmp, k_slc, v_slc, k_win, v_win, gate_logits,
                  qk_g, cmp_pos, cmp_w1, cmp_w2, slopes):
    f32 = jnp.float32
    B, S, _ = q.shape
    scale = HEAD_DIM ** -0.5
    slope = slopes[None, :, None, None]
    qh = rms_norm(to_heads(q, NSA_HEADS), qk_g[0]).astype(f32)
    kc = rms_norm(compress_blocks(k_cmp, cmp_pos[0], cmp_w1[0], cmp_w2[0]), qk_g[1]).astype(f32)
    vc = compress_blocks(v_cmp, cmp_pos[1], cmp_w1[1], cmp_w2[1]).astype(f32)
    ks = rms_norm(k_slc, qk_g[2]).astype(f32)
    vs = v_slc.astype(f32)
    kw = rms_norm(k_win, qk_g[3]).astype(f32)
    vw = v_win.astype(f32)
    t = jnp.arange(S)

    n_cmp = kc.shape[1]
    cmp_start = jnp.arange(n_cmp) * NSA_CMP_STRIDE
    dist_c = t[:, None] - (cmp_start + NSA_CMP_LEN - 1)[None, :]
    valid_c = dist_c >= 0
    s_c = jnp.einsum('bhtd,bcd->bhtc', qh, kc) * scale - slope * dist_c.astype(f32)
    p_c = jax.nn.softmax(jnp.where(valid_c, s_c, NEG_INF), axis=-1) * valid_c
    o_cmp = jnp.einsum('bhtc,bcd->bhtd', p_c, vc)

    n_sel_blocks = S // NSA_SEL_LEN
    n_top = min(NSA_TOPN, n_sel_blocks)
    sel_start = jnp.arange(n_sel_blocks) * NSA_SEL_LEN
    cover = ((cmp_start[:, None] < sel_start[None, :] + NSA_SEL_LEN)
             & (cmp_start[:, None] + NSA_CMP_LEN > sel_start[None, :])).astype(f32)
    imp = jnp.einsum('bhtc,cj->btj', p_c, cover)
    cur = t // NSA_SEL_LEN
    j = jnp.arange(n_sel_blocks)
    forced = (j[None, :] == 0) | (j[None, :] == cur[:, None]) | (j[None, :] == cur[:, None] - 1)
    imp = jnp.where(j[None, :] <= cur[:, None], imp + jnp.where(forced, FORCE_BONUS, 0.0), NEG_INF)
    _, sel_idx = lax.top_k(imp, n_top)

    nb = S // Q_BLOCK
    ks_blocks = ks.reshape(B, n_sel_blocks, NSA_SEL_LEN, HEAD_DIM)
    vs_blocks = vs.reshape(B, n_sel_blocks, NSA_SEL_LEN, HEAD_DIM)
    kw_pad = jnp.pad(kw, ((0, 0), (NSA_WIN, 0), (0, 0)))
    vw_pad = jnp.pad(vw, ((0, 0), (NSA_WIN, 0), (0, 0)))
    q_blk = qh.reshape(B, NSA_HEADS, nb, Q_BLOCK, HEAD_DIM).transpose(2, 0, 1, 3, 4)
    idx_blk = sel_idx.reshape(B, nb, Q_BLOCK, n_top).transpose(1, 0, 2, 3)
    offs = jnp.arange(NSA_SEL_LEN)
    gather = jax.vmap(lambda kb, i: kb[i])

    def block(args):
        qb, ib, t0 = args
        tq = t0 + jnp.arange(Q_BLOCK)
        kg = gather(ks_blocks, ib).reshape(B, Q_BLOCK, n_top * NSA_SEL_LEN, HEAD_DIM)
        vg = gather(vs_blocks, ib).reshape(B, Q_BLOCK, n_top * NSA_SEL_LEN, HEAD_DIM)
        pos = (ib[..., None] * NSA_SEL_LEN + offs).reshape(B, Q_BLOCK, n_top * NSA_SEL_LEN)
        dist = tq[None, :, None] - pos
        s = jnp.einsum('bhqd,bqkd->bhqk', qb, kg) * scale - slope * dist[:, None].astype(f32)
        p = jax.nn.softmax(jnp.where((dist >= 0)[:, None], s, NEG_INF), axis=-1)
        o_s = jnp.einsum('bhqk,bqkd->bhqd', p, vg)
        kwb = lax.dynamic_slice_in_dim(kw_pad, t0, Q_BLOCK + NSA_WIN, axis=1)
        vwb = lax.dynamic_slice_in_dim(vw_pad, t0, Q_BLOCK + NSA_WIN, axis=1)
        posw = t0 - NSA_WIN + jnp.arange(Q_BLOCK + NSA_WIN)
        dw = tq[:, None] - posw[None, :]
        mask_w = (dw >= 0) & (dw < NSA_WIN) & (posw[None, :] >= 0)
        sw = jnp.einsum('bhqd,bkd->bhqk', qb, kwb) * scale - slope * dw.astype(f32)
        pw = jax.nn.softmax(jnp.where(mask_w, sw, NEG_INF), axis=-1)
        o_w = jnp.einsum('bhqk,bkd->bhqd', pw, vwb)
        return o_s, o_w

    o_s, o_w = lax.map(block, (q_blk, idx_blk, jnp.arange(nb) * Q_BLOCK))
    o_s = o_s.transpose(1, 2, 0, 3, 4).reshape(B, NSA_HEADS, S, HEAD_DIM)
    o_w = o_w.transpose(1, 2, 0, 3, 4).reshape(B, NSA_HEADS, S, HEAD_DIM)
    g = jax.nn.sigmoid(gate_logits.astype(f32)).reshape(B, S, NSA_HEADS, NSA_BRANCHES).transpose(0, 2, 1, 3)
    o = g[..., 0:1] * o_cmp + g[..., 1:2] * o_s + g[..., 2:3] * o_w
    return from_heads(o)


def gla_attention(q, k, v, a_lr, r, wa2, ba, norm_g):
    f32 = jnp.float32
    B, S, _ = q.shape
    H, dk, dv, C = GLA_HEADS, GLA_DK, GLA_DV, GLA_CHUNK
    n = S // C

    def chunks(t, d):
        return t.astype(f32).reshape(B, n, C, H, d).transpose(0, 3, 1, 2, 4)

    log_a = jax.nn.log_sigmoid((a_lr @ wa2 + ba).astype(f32)) / GLA_TAU
    qc = chunks(q, dk) * dk ** -0.5
    kc = chunks(k, dk)
    vc = chunks(v, dv)
    b = jnp.cumsum(chunks(log_a, dk), axis=3)
    causal = jnp.tril(jnp.ones((C, C), dtype=bool))
    decay = jnp.exp(jnp.where(causal[:, :, None], b[..., :, None, :] - b[..., None, :, :], -jnp.inf))
    attn = jnp.einsum('bhnik,bhnjk,bhnijk->bhnij', qc, kc, decay)
    o_intra = jnp.einsum('bhnij,bhnjv->bhniv', attn, vc)
    b_last = b[..., -1, :]
    kv_chunk = jnp.einsum('bhnjk,bhnjv->bhnkv', kc * jnp.exp(b_last[..., None, :] - b), vc)

    def step(state, inp):
        dl, kvn = inp
        return dl[..., None] * state + kvn, state

    _, prev = lax.scan(step, jnp.zeros((B, H, dk, dv), f32),
                       (jnp.moveaxis(jnp.exp(b_last), 2, 0), jnp.moveaxis(kv_chunk, 2, 0)))
    prev = jnp.moveaxis(prev, 0, 2)
    o_inter = jnp.einsum('bhnik,bhnkv->bhniv', qc * jnp.exp(b), prev)
    o = (o_intra + o_inter).transpose(0, 2, 3, 1, 4).reshape(B, S, H, dv)
    o = rms_norm(o, norm_g)
    return o.reshape(B, S, H * dv) * jax.nn.silu(r.astype(f32))


def _complex_linear_combine(e1, e2):
    a1r, a1i, x1r, x1i = e1
    a2r, a2i, x2r, x2i = e2
    return (a2r * a1r - a2i * a1i, a2r * a1i + a2i * a1r,
            a2r * x1r - a2i * x1i + x2r, a2r * x1i + a2i * x1r + x2i)


def s5_layer(u, a_re, a_im, b_re, b_im, c_re, c_im, d, log_dt, glu_w, glu_b):
    f32 = jnp.float32
    B, S, W = u.shape
    uf = u.astype(f32)
    a_re = a_re.astype(f32)
    a_im = a_im.astype(f32)
    dt = jnp.exp(log_dt.astype(f32))[:, None]
    mag = jnp.exp(dt * a_re)
    abar_re = mag * jnp.cos(dt * a_im)
    abar_im = mag * jnp.sin(dt * a_im)
    den = a_re * a_re + a_im * a_im
    f_re = ((abar_re - 1.0) * a_re + abar_im * a_im) / den
    f_im = (abar_im * a_re - (abar_re - 1.0) * a_im) / den
    b_re = b_re.astype(f32)
    b_im = b_im.astype(f32)
    bb_re = f_re[..., None] * b_re - f_im[..., None] * b_im
    bb_im = f_re[..., None] * b_im + f_im[..., None] * b_re
    ug = uf.reshape(B, S, S5_GROUPS, S5_GROUP)
    bu_re = jnp.einsum('bsgc,gnc->bsgn', ug, bb_re)
    bu_im = jnp.einsum('bsgc,gnc->bsgn', ug, bb_im)
    a_re_t = jnp.broadcast_to(abar_re, bu_re.shape)
    a_im_t = jnp.broadcast_to(abar_im, bu_re.shape)
    _, _, x_re, x_im = lax.associative_scan(_complex_linear_combine, (a_re_t, a_im_t, bu_re, bu_im), axis=1)
    y = (jnp.einsum('bsgn,gcn->bsgc', x_re, c_re.astype(f32))
         - jnp.einsum('bsgn,gcn->bsgc', x_im, c_im.astype(f32)))
    y = y.reshape(B, S, W) + d.astype(f32) * uf
    hg = jax.nn.gelu(y)
    return hg * jax.nn.sigmoid(hg @ glu_w.astype(f32) + glu_b.astype(f32))


def swiglu(x, wg, wu, wd):
    return (jax.nn.silu(x @ wg) * (x @ wu)) @ wd


def moe_swiglu(h, router_w, router_b, wg, wu, wd):
    f32 = jnp.float32
    B, S, D = h.shape
    xt = h.reshape(B * S, D)
    logits = (xt @ router_w).astype(f32) + router_b.astype(f32)
    top_v, top_i = lax.top_k(logits, TOP_K)
    top_w = jax.nn.softmax(top_v, axis=-1)
    combine = jnp.einsum('tk,tke->te', top_w, jax.nn.one_hot(top_i, N_EXPERTS, dtype=f32))
    out = jnp.zeros((B * S, D), f32)
    for e in range(N_EXPERTS):
        out = out + combine[:, e:e + 1] * swiglu(xt, wg[e], wu[e], wd[e]).astype(f32)
    return out.reshape(B, S, D).astype(h.dtype)


def setup_inputs(seed: int = 0) -> dict:
    key = jax.random.key(seed)
    ks = iter(jax.random.split(key, 64))
    f32 = jnp.float32
    L = DEPTH
    nd = (DEPTH + 1) // 2
    nm = DEPTH // 2
    G, N, C = S5_GROUPS, S5_STATE, S5_GROUP

    def nrm(shape, scale):
        return jax.random.normal(next(ks), shape, f32) * scale

    def gain(shape):
        return 1.0 + nrm(shape, 0.02)

    return {
        "x": nrm((BATCH, SEQ, D_MODEL), 1.0),
        "norm1_g": gain((L, D_MODEL)),
        "w_in": nrm((L, D_MODEL, PROJ_WIDTH), D_MODEL ** -0.5),
        "dil_qk_g": gain((L, 2, HEAD_DIM)),
        "nsa_qk_g": gain((L, 4, HEAD_DIM)),
        "nsa_cmp_pos": nrm((L, 2, NSA_CMP_LEN, HEAD_DIM), 0.02),
        "nsa_cmp_w1": nrm((L, 2, NSA_CMP_LEN * HEAD_DIM, NSA_CMP_HIDDEN), (NSA_CMP_LEN * HEAD_DIM) ** -0.5),
        "nsa_cmp_w2": nrm((L, 2, NSA_CMP_HIDDEN, HEAD_DIM), NSA_CMP_HIDDEN ** -0.5),
        "gla_wa2": nrm((L, GLA_RANK, GLA_HEADS * GLA_DK), GLA_RANK ** -0.5),
        "gla_ba": nrm((L, GLA_HEADS * GLA_DK), 0.1),
        "gla_norm_g": gain((L, GLA_DV)),
        "s5_a_re": -0.5 + nrm((L, G, N), 0.01),
        "s5_a_im": math.pi * jnp.arange(N, dtype=f32) + nrm((L, G, N), 0.01),
        "s5_b_re": nrm((L, G, N, C), (2 * C) ** -0.5),
        "s5_b_im": nrm((L, G, N, C), (2 * C) ** -0.5),
        "s5_c_re": nrm((L, G, C, N), (2 * N) ** -0.5),
        "s5_c_im": nrm((L, G, C, N), (2 * N) ** -0.5),
        "s5_d": nrm((L, GROUP_WIDTH), 1.0),
        "s5_log_dt": jax.random.uniform(next(ks), (L, G), f32, math.log(1e-3), math.log(1e-1)),
        "s5_glu_w": nrm((L, GROUP_WIDTH, GROUP_WIDTH), GROUP_WIDTH ** -0.5),
        "s5_glu_b": nrm((L, GROUP_WIDTH), 0.02),
        "out_norm_g": gain((L, MIX_WIDTH)),
        "w_out": nrm((L, MIX_WIDTH, D_MODEL), MIX_WIDTH ** -0.5),
        "norm2_g": gain((L, D_MODEL)),
        "ffn_w_gate": nrm((nd, D_MODEL, D_FF), D_MODEL ** -0.5),
        "ffn_w_up": nrm((nd, D_MODEL, D_FF), D_MODEL ** -0.5),
        "ffn_w_down": nrm((nd, D_FF, D_MODEL), D_FF ** -0.5),
        "moe_router_w": nrm((nm, D_MODEL, N_EXPERTS), D_MODEL ** -0.5),
        "moe_router_b": nrm((nm, N_EXPERTS), 0.01),
        "moe_w_gate": nrm((nm, N_EXPERTS, D_MODEL, D_FF_EXPERT), D_MODEL ** -0.5),
        "moe_w_up": nrm((nm, N_EXPERTS, D_MODEL, D_FF_EXPERT), D_MODEL ** -0.5),
        "moe_w_down": nrm((nm, N_EXPERTS, D_FF_EXPERT, D_MODEL), D_FF_EXPERT ** -0.5),
    }


def reference(x, norm1_g, w_in, dil_qk_g, nsa_qk_g, nsa_cmp_pos, nsa_cmp_w1, nsa_cmp_w2,
              gla_wa2, gla_ba, gla_norm_g, s5_a_re, s5_a_im, s5_b_re, s5_b_im, s5_c_re, s5_c_im,
              s5_d, s5_log_dt, s5_glu_w, s5_glu_b, out_norm_g, w_out, norm2_g,
              ffn_w_gate, ffn_w_up, ffn_w_down, moe_router_w, moe_router_b,
              moe_w_gate, moe_w_up, moe_w_down):
    B, S, _ = x.shape
    slopes = alibi_slopes(N_SOFTMAX_HEADS)
    dil_slopes = slopes[1::2]
    nsa_slopes = slopes[0::2]
    for l in range(DEPTH):
        h = rms_norm(x, norm1_g[l])
        (dq, dk, dv, nq, nkc, nvc, nks, nvs, nkw, nvw, ng,
         gq, gk, gv, ga, gr, su) = split_proj(h @ w_in[l])
        y_dil = from_heads(dilated_attention(
            rms_norm(to_heads(dq, DIL_HEADS), dil_qk_g[l, 0]),
            rms_norm(to_heads(dk, DIL_HEADS), dil_qk_g[l, 1]),
            to_heads(dv, DIL_HEADS), dil_slopes))
        y_nsa = nsa_attention(nq, nkc, nvc, nks, nvs, nkw, nvw, ng, nsa_qk_g[l],
                              nsa_cmp_pos[l], nsa_cmp_w1[l], nsa_cmp_w2[l], nsa_slopes)
        y_gla = gla_attention(gq, gk, gv, ga, gr, gla_wa2[l], gla_ba[l], gla_norm_g[l])
        y_s5 = s5_layer(su, s5_a_re[l], s5_a_im[l], s5_b_re[l], s5_b_im[l], s5_c_re[l], s5_c_im[l],
                        s5_d[l], s5_log_dt[l], s5_glu_w[l], s5_glu_b[l])
        mix = jnp.stack([y_dil.astype(x.dtype), y_nsa.astype(x.dtype),
                         y_gla.astype(x.dtype), y_s5.astype(x.dtype)], axis=-2)
        mix = rms_norm(mix, out_norm_g[l].reshape(N_MIXERS, GROUP_WIDTH)).reshape(B, S, MIX_WIDTH)
        x = x + mix @ w_out[l]
        h = rms_norm(x, norm2_g[l])
        if l % 2 == 0:
            i = l // 2
            x = x + swiglu(h, ffn_w_gate[i], ffn_w_up[i], ffn_w_down[i])
        else:
            i = l // 2
            x = x + moe_swiglu(h, moe_router_w[i], moe_router_b[i], moe_w_gate[i], moe_w_up[i], moe_w_down[i])
    return x
```

```cpp
#include <hip/hip_runtime.h>
#include <cstdio>
#include <cstdint>
namespace pg8 {
#define PG8_LAS __attribute__((address_space(3)))
typedef unsigned short bf16_t;
typedef short bf16x8 __attribute__((ext_vector_type(8)));
typedef float f32x4 __attribute__((ext_vector_type(4)));
typedef unsigned u32x4 __attribute__((ext_vector_type(4)));
constexpr int BM = 256, BK = 64, HALF = 128, HTB = HALF * BK * 2  , STAGE_BYTES = 8 * HTB, NXCD = 8, WGM = 8;

__host__ __device__ __forceinline__ int lds_byte(int r, int c) { const int st = (r >> 4) * 2 + (c >> 5), rr = r & 15, cc = c & 31, ob = rr * 64 + cc * 2; return st * 1024 + (ob ^ (((ob >> 9) & 1) << 5)); }
__host__ __device__ __forceinline__ void stage_rc(int b, int& R, int& C) { const int st = b / 1024, sb = b % 1024, swz = sb ^ (((sb >> 9) & 1) << 5); R = (st >> 1) * 16 + swz / 64; C = (st & 1) * 32 + (swz % 64) / 2; }
__host__ __device__ __forceinline__ int perm32(int rho) { const int n = rho >> 4, i = rho & 15; return 8 * (i >> 2) + 4 * n + (i & 3); }

struct Unit { int pm, pn; };
struct Gemm { const bf16_t* A; const bf16_t* Bt; int M, N, K; };

struct StaticOrder {
    int nM, nN, nwg, G, c;
    __host__ __device__ void init(int M, int N, int G_, int c_) { nM = M / BM; nN = N / BM; nwg = nM * nN; G = G_; c = c_; }
    __host__ __device__ bool next(int i, Unit& u) const {
        const long L = (long)i * G + c; if (L >= nwg) return false;
        int wgid = (int)L; { const int q = nwg / NXCD, r = nwg % NXCD, xcd = wgid % NXCD, off = wgid / NXCD; wgid = (xcd < r ? xcd * (q + 1) : r * (q + 1) + (xcd - r) * q) + off; }
        const int nig = WGM * nN, gid = wgid / nig, fm = gid * WGM, gsz = (nM - fm) < WGM ? (nM - fm) : WGM;
        u.pm = fm + ((wgid % nig) % gsz); u.pn = (wgid % nig) / gsz; return true;
    }
    __device__ __forceinline__ void a_ready(const Unit&) const {}
    __device__ __forceinline__ void done(const Unit&) const {}
};

__device__ __forceinline__ unsigned cvt_pk_bf16(float lo, float hi) { unsigned r; asm volatile("v_cvt_pk_bf16_f32 %0, %1, %2" : "=v"(r) : "v"(lo), "v"(hi)); return r; }
typedef float f32x2 __attribute__((ext_vector_type(2)));
__device__ __forceinline__ f32x2 gelu_pk(f32x2 v) {
    const f32x2 av = __builtin_elementwise_abs(v), d = av * 0.2316418882f + 1.0f;
    f32x2 t; t.x = __builtin_amdgcn_rcpf(d.x); t.y = __builtin_amdgcn_rcpf(d.y);
    f32x2 q = t * 0.5307027145f + (-0.7265760135f); q = q * t + 0.7107068705f; q = q * t + (-0.142248368f); q = q * t + 0.127414796f; q = q * t;
    const f32x2 s = (v * v) * (-0.72134752044f);
    f32x2 e; e.x = __builtin_amdgcn_exp2f(s.x); e.y = __builtin_amdgcn_exp2f(s.y);
    const f32x2 m = v * (q * e), r = v - m;
    f32x2 o; o.x = v.x < 0.f ? m.x : r.x; o.y = v.y < 0.f ? m.y : r.y; return o;
}


__device__ __forceinline__ float silu_f(float x) { return x * __builtin_amdgcn_rcpf(1.0f + __expf(-x)); }
struct EpiStoreBf16 {
    static constexpr bool PERM = true, AFTER_DRAIN = false;
    bf16_t* O; int ldc;
    __device__ __forceinline__ void operator()(const f32x4 (&acc)[2][2][4][2], const Unit& u, int wr, int wc, int fr, int fq) const {
        const int row0 = u.pm * BM + wr * 64 + fr, col0 = u.pn * BM + wc * 32 + 8 * fq;
#pragma unroll
        for (int ai = 0; ai < 2; ++ai)
#pragma unroll
            for (int m = 0; m < 4; ++m) { bf16_t* rowp = O + (size_t)(row0 + ai * HALF + m * 16) * ldc + col0;
#pragma unroll
                for (int bj = 0; bj < 2; ++bj) { const f32x4 v0 = acc[ai][bj][m][0], v1 = acc[ai][bj][m][1];
                    u32x4 w; w.x = cvt_pk_bf16(v0[0], v0[1]); w.y = cvt_pk_bf16(v0[2], v0[3]); w.z = cvt_pk_bf16(v1[0], v1[1]); w.w = cvt_pk_bf16(v1[2], v1[3]);
                    *(u32x4*)(rowp + bj * HALF) = w; } }
    }
};
struct EpiResF32 {
    static constexpr bool PERM = true, AFTER_DRAIN = false;
    const float* R; float* O; int ldc;
    __device__ __forceinline__ void operator()(const f32x4 (&acc)[2][2][4][2], const Unit& u, int wr, int wc, int fr, int fq) const {
        const int row0 = u.pm * BM + wr * 64 + fr, col0 = u.pn * BM + wc * 32 + 8 * fq;
#pragma unroll
        for (int ai = 0; ai < 2; ++ai)
#pragma unroll
            for (int m = 0; m < 4; ++m) { const size_t ro = (size_t)(row0 + ai * HALF + m * 16) * ldc + col0;
#pragma unroll
                for (int bj = 0; bj < 2; ++bj) { const float* rp = R + ro + bj * HALF; float* op = O + ro + bj * HALF;
                    const f32x4 r0 = *(const f32x4*)rp, r1 = *(const f32x4*)(rp + 4);
                    *(f32x4*)op = r0 + acc[ai][bj][m][0]; *(f32x4*)(op + 4) = r1 + acc[ai][bj][m][1]; } }
    }
};
struct EpiResScaledF32 {
    static constexpr bool PERM = true, AFTER_DRAIN = false;
    float* O; int ldc; const float* cw; int cws, cwo;
    __device__ __forceinline__ void operator()(const f32x4 (&acc)[2][2][4][2], const Unit& u, int wr, int wc, int fr, int fq) const {
        const int row0 = u.pm * BM + wr * 64 + fr, col0 = u.pn * BM + wc * 32 + 8 * fq;
#pragma unroll
        for (int ai = 0; ai < 2; ++ai)
#pragma unroll
            for (int m = 0; m < 4; ++m) { const int row = row0 + ai * HALF + m * 16; const size_t ro = (size_t)row * ldc + col0; const float w = cw[(size_t)row * cws + cwo];
                if (w != 0.f) {
#pragma unroll
                for (int bj = 0; bj < 2; ++bj) { float* op = O + ro + bj * HALF;
                    const f32x4 r0 = *(const f32x4*)op, r1 = *(const f32x4*)(op + 4);
                    *(f32x4*)op = r0 + acc[ai][bj][m][0] * w; *(f32x4*)(op + 4) = r1 + acc[ai][bj][m][1] * w; } } }
    }
};
struct EpiSwiglu {
    static constexpr bool PERM = true, AFTER_DRAIN = false;
    bf16_t* H; int ldh; int pn0;
    __device__ __forceinline__ void operator()(const f32x4 (&acc)[2][2][4][2], const Unit& u, int wr, int wc, int fr, int fq) const {
        const int row0 = u.pm * BM + wr * 64 + fr, col0 = (u.pn - pn0) * HALF + wc * 32 + 8 * fq;
#pragma unroll
        for (int ai = 0; ai < 2; ++ai)
#pragma unroll
            for (int m = 0; m < 4; ++m) { bf16_t* rowp = H + (size_t)(row0 + ai * HALF + m * 16) * ldh + col0;
                const f32x4 g0 = acc[ai][0][m][0], g1 = acc[ai][0][m][1], u0 = acc[ai][1][m][0], u1 = acc[ai][1][m][1];
                u32x4 w; w.x = cvt_pk_bf16(silu_f(g0[0]) * u0[0], silu_f(g0[1]) * u0[1]); w.y = cvt_pk_bf16(silu_f(g0[2]) * u0[2], silu_f(g0[3]) * u0[3]);
                w.z = cvt_pk_bf16(silu_f(g1[0]) * u1[0], silu_f(g1[1]) * u1[1]); w.w = cvt_pk_bf16(silu_f(g1[2]) * u1[2], silu_f(g1[3]) * u1[3]);
                *(u32x4*)rowp = w; }
    }
};
template <class Epi, class Sched, bool ALIGN_EPI = false, bool SP2 = false>
__device__ __forceinline__ void gemm_phase(PG8_LAS unsigned char* lds, const Gemm g, const Sched& S, const Epi& E) {
    const int tid = threadIdx.x, wid = __builtin_amdgcn_readfirstlane(tid >> 6), lane = tid & 63, wr = wid >> 2, wc = wid & 3, fr = lane & 15, fq = lane >> 4;
    const int K = g.K, nt = K / BK;
    unsigned voffA[2], voffB[2];
#pragma unroll
    for (int i = 0; i < 2; ++i) { int R, C; stage_rc(tid * 16 + i * 8192, R, C); const int Rb = Epi::PERM ? ((R & ~31) + perm32(R & 31)) : R;
        voffA[i] = (unsigned)(R * K + C) * 2u; voffB[i] = (unsigned)(Rb * K + C) * 2u; }
    const size_t kstep = (size_t)(BK * 2);
    const size_t hstep = (size_t)HALF * K * 2;
    const size_t tstep = 2 * hstep;
    const unsigned ldsw = (unsigned)wid * 1024u;
    const int aoff = lds_byte(wr * 64 + fr, fq * 8), boff = lds_byte(wc * 32 + fr, fq * 8);
#define PG8_SA(b, h) (((b) * 2 + (h)) * HTB)
#define PG8_SB(b, h) ((4 + (b) * 2 + (h)) * HTB)
#define PG8_STAGE(bufoff, gbase, voff) do { _Pragma("unroll") for (int _i = 0; _i < 2; ++_i) \
        __builtin_amdgcn_global_load_lds((const unsigned*)((const char*)(gbase) + (voff)[_i]), (PG8_LAS unsigned*)(lds + (bufoff) + ldsw + _i * 8192), 16, 0, 0); } while (0)
#define PG8_LDA(dst, b, h) do { _Pragma("unroll") for (int m = 0; m < 4; ++m) _Pragma("unroll") for (int k = 0; k < 2; ++k) dst[m][k] = *(const PG8_LAS bf16x8*)(lds + PG8_SA(b, h) + aoff + m * 2048 + k * 1024); } while (0)
#define PG8_LDB(dst, b, h) do { _Pragma("unroll") for (int n = 0; n < 2; ++n) _Pragma("unroll") for (int k = 0; k < 2; ++k) dst[n][k] = *(const PG8_LAS bf16x8*)(lds + PG8_SB(b, h) + boff + n * 2048 + k * 1024); } while (0)
#define PG8_MMA(ai, bj, At, Bt) do { __builtin_amdgcn_s_setprio(1); _Pragma("unroll") for (int m = 0; m < 4; ++m) _Pragma("unroll") for (int n = 0; n < 2; ++n) _Pragma("unroll") for (int k = 0; k < 2; ++k) \
        acc[ai][bj][m][n] = __builtin_amdgcn_mfma_f32_16x16x32_bf16(Bt[n][k], At[m][k], acc[ai][bj][m][n], 0, 0, 0); __builtin_amdgcn_s_setprio(0); } while (0)
#define PG8_WAIT_V(n) asm volatile("s_waitcnt vmcnt(" #n ")" ::: "memory")
#define PG8_WAIT_L(n) asm volatile("s_waitcnt lgkmcnt(" #n ")" ::: "memory")
#define PG8_BAR __builtin_amdgcn_s_barrier()
#define PG8_SCHED __builtin_amdgcn_sched_barrier(0)
    Unit cur, nxt; int ui = 0;
    if (!S.next(0, cur)) return;
    f32x4 acc[2][2][4][2];
#pragma unroll
    for (int a = 0; a < 2; ++a)
#pragma unroll
        for (int b = 0; b < 2; ++b)
#pragma unroll
            for (int m = 0; m < 4; ++m)
#pragma unroll
                for (int n = 0; n < 2; ++n) acc[a][b][m][n] = (f32x4){0.f, 0.f, 0.f, 0.f};
    bf16x8 At[4][2], B0[2][2], B1[2][2];
    const char* cA = (const char*)g.A + (size_t)cur.pm * tstep; const char* cB = (const char*)g.Bt + (size_t)cur.pn * tstep;
    S.a_ready(cur);
    if constexpr (SP2) {
        PG8_STAGE(PG8_SB(0, 0), cB, voffB); PG8_STAGE(PG8_SB(0, 1), cB + hstep, voffB); PG8_STAGE(PG8_SA(0, 0), cA, voffA); PG8_STAGE(PG8_SA(0, 1), cA + hstep, voffA);
        if (wr == 1) PG8_BAR;
        PG8_WAIT_V(2); PG8_BAR;
        PG8_STAGE(PG8_SB(1, 0), cB + kstep, voffB); PG8_STAGE(PG8_SA(1, 0), cA + kstep, voffA); PG8_STAGE(PG8_SB(1, 1), cB + hstep + kstep, voffB);
        PG8_WAIT_V(6); PG8_BAR;
    } else {
        PG8_STAGE(PG8_SB(0, 0), cB, voffB); PG8_STAGE(PG8_SA(0, 0), cA, voffA); PG8_STAGE(PG8_SB(0, 1), cB + hstep, voffB); PG8_STAGE(PG8_SA(0, 1), cA + hstep, voffA);
        if (wr == 1) PG8_BAR;
        PG8_WAIT_V(4); PG8_BAR;
        PG8_STAGE(PG8_SB(1, 0), cB + kstep, voffB); PG8_STAGE(PG8_SA(1, 0), cA + kstep, voffA); PG8_STAGE(PG8_SB(1, 1), cB + hstep + kstep, voffB);
        PG8_WAIT_V(6); PG8_BAR;
    }
    for (;;) {
        const bool has_next = S.next(ui + 1, nxt);
        const char* nA = has_next ? (const char*)g.A + (size_t)nxt.pm * tstep : cA; const char* nB = has_next ? (const char*)g.Bt + (size_t)nxt.pn * tstep : cB;
        for (int t = 0; t < nt; t += 2) {
            const bool last = (t == nt - 2);
            const char* a1 = cA + (size_t)(t + 1) * kstep;
            const char* a2 = last ? nA : cA + (size_t)(t + 2) * kstep; const char* b2 = last ? nB : cB + (size_t)(t + 2) * kstep;
            const char* a3 = a2 + kstep; const char* b3 = b2 + kstep;
            if (last && has_next) S.a_ready(nxt);
            if constexpr (SP2) {
            PG8_LDB(B0, 0, 0); PG8_LDB(B1, 0, 1); PG8_SCHED; PG8_LDA(At, 0, 0); PG8_STAGE(PG8_SA(1, 1), a1 + hstep, voffA);
            PG8_WAIT_V(8); PG8_WAIT_L(0); PG8_BAR; PG8_MMA(0, 0, At, B0); PG8_MMA(0, 1, At, B1); PG8_BAR; PG8_SCHED;
            PG8_LDA(At, 0, 1); PG8_STAGE(PG8_SB(0, 0), b2, voffB); PG8_STAGE(PG8_SB(0, 1), b2 + hstep, voffB); PG8_STAGE(PG8_SA(0, 0), a2, voffA);
            PG8_WAIT_V(8); PG8_WAIT_L(0); PG8_BAR; PG8_MMA(1, 0, At, B0); PG8_MMA(1, 1, At, B1); PG8_BAR; PG8_SCHED;
            PG8_LDB(B0, 1, 0); PG8_LDB(B1, 1, 1); PG8_SCHED; PG8_LDA(At, 1, 0); PG8_STAGE(PG8_SA(0, 1), a2 + hstep, voffA);
            PG8_WAIT_V(8); PG8_WAIT_L(0); PG8_BAR; PG8_MMA(0, 0, At, B0); PG8_MMA(0, 1, At, B1); PG8_BAR; PG8_SCHED;
            PG8_LDA(At, 1, 1); PG8_STAGE(PG8_SB(1, 0), b3, voffB); PG8_STAGE(PG8_SB(1, 1), b3 + hstep, voffB); PG8_STAGE(PG8_SA(1, 0), a3, voffA);
            PG8_WAIT_V(8); PG8_WAIT_L(0); PG8_BAR; PG8_MMA(1, 0, At, B0); PG8_MMA(1, 1, At, B1); PG8_BAR; PG8_SCHED;
            } else {
            PG8_LDB(B0, 0, 0); PG8_SCHED; PG8_LDA(At, 0, 0); PG8_STAGE(PG8_SA(1, 1), a1 + hstep, voffA);
            PG8_WAIT_L(8); PG8_BAR; PG8_WAIT_L(0); PG8_MMA(0, 0, At, B0); PG8_BAR; PG8_SCHED;
            PG8_LDB(B1, 0, 1); PG8_STAGE(PG8_SB(0, 0), b2, voffB);
            PG8_BAR; PG8_WAIT_L(0); PG8_MMA(0, 1, At, B1); PG8_BAR;
            PG8_LDA(At, 0, 1); PG8_STAGE(PG8_SA(0, 0), a2, voffA);
            PG8_BAR; PG8_WAIT_L(0); PG8_MMA(1, 0, At, B0); PG8_BAR; PG8_SCHED;
            PG8_STAGE(PG8_SB(0, 1), b2 + hstep, voffB);
            PG8_WAIT_V(6); PG8_BAR; PG8_MMA(1, 1, At, B1); PG8_BAR;
            PG8_LDB(B0, 1, 0); PG8_SCHED; PG8_LDA(At, 1, 0); PG8_STAGE(PG8_SA(0, 1), a2 + hstep, voffA);
            PG8_WAIT_L(8); PG8_BAR; PG8_WAIT_L(0); PG8_MMA(0, 0, At, B0); PG8_BAR; PG8_SCHED;
            PG8_LDB(B1, 1, 1); PG8_STAGE(PG8_SB(1, 0), b3, voffB);
            PG8_BAR; PG8_WAIT_L(0); PG8_MMA(0, 1, At, B1); PG8_BAR;
            PG8_LDA(At, 1, 1); PG8_STAGE(PG8_SA(1, 0), a3, voffA);
            PG8_BAR; PG8_WAIT_L(0); PG8_MMA(1, 0, At, B0); PG8_BAR; PG8_SCHED;
            PG8_STAGE(PG8_SB(1, 1), b3 + hstep, voffB);
            PG8_WAIT_V(6); PG8_BAR; PG8_MMA(1, 1, At, B1); PG8_BAR;
            }
        }
        if constexpr (ALIGN_EPI) { if (wr == 0) PG8_BAR; }
        if constexpr (!Epi::AFTER_DRAIN) { E(acc, cur, wr, wc, fr, fq); S.done(cur); }
        if (!has_next) break;
#pragma unroll
        for (int a = 0; a < 2; ++a)
#pragma unroll
            for (int b = 0; b < 2; ++b)
#pragma unroll
                for (int m = 0; m < 4; ++m)
#pragma unroll
                    for (int n = 0; n < 2; ++n) acc[a][b][m][n] = (f32x4){0.f, 0.f, 0.f, 0.f};
        cur = nxt; cA = nA; cB = nB; ++ui;
        if constexpr (ALIGN_EPI) { if (wr == 1) PG8_BAR; }
    }
    PG8_WAIT_V(0);
    if constexpr (!ALIGN_EPI) { if (wr == 0) PG8_BAR; }
    PG8_BAR;
    if constexpr (Epi::AFTER_DRAIN) { E.fused(acc, cur, wr, wc, fr, fq, lds, wid, lane); S.done(cur); }
#undef PG8_SA
#undef PG8_SB
#undef PG8_STAGE
#undef PG8_LDA
#undef PG8_LDB
#undef PG8_MMA
#undef PG8_WAIT_V
#undef PG8_WAIT_L
#undef PG8_BAR
#undef PG8_SCHED
}
}

#define GAS __attribute__((address_space(1)))
#define LAS __attribute__((address_space(3)))
typedef unsigned short bf16;
typedef unsigned v4u __attribute__((ext_vector_type(4)));
typedef unsigned v2u __attribute__((ext_vector_type(2)));
typedef float f32x4 __attribute__((ext_vector_type(4)));
typedef short bf16x8 __attribute__((ext_vector_type(8)));
typedef GAS unsigned gu32;
#define RLX_AGENT __ATOMIC_RELAXED, __HIP_MEMORY_SCOPE_AGENT
#define LDS_WAIT() asm volatile("s_waitcnt lgkmcnt(0)" ::: "memory")
#define VM_WAIT() asm volatile("s_waitcnt vmcnt(0)" ::: "memory")
__device__ __forceinline__ unsigned f2bf(float f) { unsigned u = __builtin_bit_cast(unsigned, f); return (u + 0x7fffu + ((u >> 16) & 1u)) >> 16; }
__device__ __forceinline__ unsigned pk2(float lo, float hi) { return f2bf(lo) | (f2bf(hi) << 16); }
__device__ __forceinline__ float bf2f(unsigned short v) { return __builtin_bit_cast(float, (unsigned)v << 16); }
__device__ __forceinline__ float bflo(unsigned w) { return __builtin_bit_cast(float, w << 16); }
__device__ __forceinline__ float bfhi(unsigned w) { return __builtin_bit_cast(float, w & 0xffff0000u); }
__device__ __forceinline__ float wave_sum(float v) {
#pragma unroll
    for (int o = 1; o < 64; o <<= 1) v += __shfl_xor(v, o);
    return v;
}
__device__ __forceinline__ float wave_max(float v) {
#pragma unroll
    for (int o = 1; o < 64; o <<= 1) v = fmaxf(v, __shfl_xor(v, o));
    return v;
}
__device__ __forceinline__ float gelu_tanh(float x) { const float u = 0.7978845608028654f * (x + 0.044715f * x * x * x); return 0.5f * x * (1.0f + tanhf(u)); }
__device__ __forceinline__ float sigmoid_f(float x) { return 1.0f / (1.0f + __expf(-x)); }
__device__ __forceinline__ float log_sigmoid_f(float x) { return fminf(x, 0.f) - log1pf(__expf(-fabsf(x))); }

#define XB_TMO      128
#define XB_XCNT(j)  (256  + 64 * (j))
#define XB_XSUB(j)  (1280 + 64 * (j))
#define XB_XGEN(j)  (2304 + 64 * (j))
#define XB_TOP      3328
#define XB_TOPGEN   3392
#define XCD_BAR_WORDS 3456
#define XB_SPIN_CAP (1u << 18)

__device__ __forceinline__ unsigned xb_ld(unsigned* p)              { return __hip_atomic_load(p, __ATOMIC_RELAXED, __HIP_MEMORY_SCOPE_AGENT); }
__device__ __forceinline__ unsigned xb_add(unsigned* p, unsigned v) { return __hip_atomic_fetch_add(p, v, __ATOMIC_RELAXED, __HIP_MEMORY_SCOPE_AGENT); }
__device__ __forceinline__ unsigned xb_xcc_id() { return (unsigned)__builtin_amdgcn_s_getreg((3 << 11) | 20) & 0xFu; }
#define XB_SPIN(cond, bar) do { unsigned _sp = 0; while (cond) { __builtin_amdgcn_s_sleep(1); \
    if ((++_sp & 255u) == 0u) { if (xb_ld(&(bar)[XB_TMO])) break; if (_sp > XB_SPIN_CAP) { atomicAdd(&(bar)[XB_TMO], 1u); break; } } } } while (0)

struct XcdBarrier {
    unsigned* bar; unsigned x;
    volatile LAS unsigned* st;
};

__device__ __forceinline__ XcdBarrier xcd_barrier_post(unsigned* bar, volatile LAS unsigned* st) {
    XcdBarrier b; b.bar = bar; b.x = xb_xcc_id(); b.st = st;
    if (threadIdx.x == 0) (void)xb_add(&bar[XB_XCNT(b.x)], 1u);
    return b;
}
__device__ __forceinline__ void xcd_barrier_complete(unsigned* bar, unsigned x, unsigned& nloc, unsigned& nx) {
    const unsigned G = gridDim.x * gridDim.y * gridDim.z;
    unsigned sum, cnt, mine, sp = 0u;
    for (;;) {
        sum = 0u; cnt = 0u; mine = 0u;
#pragma unroll
        for (unsigned j = 0; j < 16; ++j) { const unsigned c = xb_ld(&bar[XB_XCNT(j)]); sum += c; cnt += (c > 0u) ? 1u : 0u; mine = (j == x) ? c : mine; }
        if (sum == G) break;
        __builtin_amdgcn_s_sleep(1);
        if ((++sp & 255u) == 0u) { if (xb_ld(&bar[XB_TMO])) break; if (sp > XB_SPIN_CAP) { atomicAdd(&bar[XB_TMO], 1u); break; } }
    }
    nloc = mine > 0u ? mine : 1u; nx = cnt > 0u ? cnt : 1u;
}

__device__ __forceinline__ void xcd_barrier(const XcdBarrier& b) {
    asm volatile("s_waitcnt vmcnt(0)" ::: "memory");
    __syncthreads();
    if (threadIdx.x == 0) {
        unsigned* bar = b.bar;
        __builtin_amdgcn_s_waitcnt(0);
        unsigned nloc = b.st[0], nx = b.st[1];
        if (nloc == 0u) { xcd_barrier_complete(bar, b.x, nloc, nx); b.st[0] = nloc; b.st[1] = nx; }
        const unsigned old = xb_add(&bar[XB_XSUB(b.x)], 1u);
        const unsigned gen = old / nloc;
        if (old + 1u == (gen + 1u) * nloc) {
            __builtin_amdgcn_fence(__ATOMIC_RELEASE, "agent");
            asm volatile("s_waitcnt vmcnt(0)" ::: "memory");
            const unsigned og = xb_add(&bar[XB_TOP], 1u);
            const unsigned tg = og / nx;
            if (og + 1u == (tg + 1u) * nx) xb_add(&bar[XB_TOPGEN], 1u);
            else XB_SPIN(xb_ld(&bar[XB_TOPGEN]) == tg, bar);
            __builtin_amdgcn_fence(__ATOMIC_ACQUIRE, "agent");
            xb_add(&bar[XB_XGEN(b.x)], 1u);
            asm volatile("s_waitcnt vmcnt(0)" ::: "memory");
        } else {
            XB_SPIN(xb_ld(&bar[XB_XGEN(b.x)]) == gen, bar);
            __builtin_amdgcn_fence(__ATOMIC_ACQUIRE, "agent");
            asm volatile("s_waitcnt vmcnt(0)" ::: "memory");
        }
    }
    __syncthreads();
}


constexpr int NB = 8, SQ = 4096, NT = NB * SQ, DM = 1024;
constexpr int PW = 2560;
constexpr int P_DQ = 0, P_DK = 256, P_DV = 512, P_NQ = 768, P_KC = 1024, P_VC = 1088, P_KS = 1152, P_VS = 1216, P_KW = 1280, P_VW = 1344,
              P_GQ = 1408, P_GK = 1536, P_GV = 1664, P_GR = 1920, P_SU = 2176, P_GA = 2432, P_NG = 2448;
constexpr int PROJ_SRC = 2460;
constexpr int DFF = 2752, DFFP = 2816, DFE = 3584, NEXP = 8;
constexpr int NCMP = 255, NCMPP = 256;
__host__ __device__ __forceinline__ int inproj_src_col(int n) {
    if (n < 1408) return n;
    if (n < 1920) return n + 12;
    if (n < 2432) return n + 28;
    if (n < 2448) return n - 500;
    if (n < 2460) return n - 1040;
    return -1;
}
constexpr size_t MiB = 1u << 20;
constexpr size_t WS_CTL = 0, CTL_ZERO_BYTES = 1 * MiB;
constexpr size_t WS_WIN = 2 * MiB;
constexpr size_t WS_WOUT = 12 * MiB;
constexpr size_t WS_WFGU = 16 * MiB;
constexpr size_t WS_WFDN = 27 * MiB;
constexpr size_t WS_KC = 33 * MiB;
constexpr size_t WS_VC = WS_KC + 512 * 1024;
constexpr size_t WS_SEL = 34 * MiB;
constexpr size_t WS_CW = 34 * MiB + 512 * 1024;
constexpr size_t WS_HN = 36 * MiB;
constexpr size_t WS_PROJ = 100 * MiB;
constexpr size_t WS_MIXRAW = 260 * MiB;
constexpr size_t WS_OCMP = 388 * MiB, WS_OS = 420 * MiB, WS_OW = 452 * MiB;
constexpr size_t WS_HG = 484 * MiB;
constexpr size_t WS_FH = 100 * MiB;
constexpr size_t WS_WEGU = 100 * MiB;
constexpr size_t WS_WEDN = 114 * MiB;
constexpr size_t WS_EH = 128 * MiB;
constexpr size_t WS_END = 516 * MiB;
constexpr int CW_BAR = 4096;
constexpr int RING_OFF = 0, RING_BYTES = 131072;
constexpr int LDSCTL_OFF = RING_BYTES, MISC_OFF = LDSCTL_OFF + 320;
constexpr int LDS_BYTES = 147456;
constexpr int NWAVES = 8;

struct ConvJob { const float* src0; const float* src1; bf16* dst; int ld, Ksrc, Nsrc, Nd, Kd, mode, pad; };
__device__ __forceinline__ void conv_item(const ConvJob& J, LAS float* scr, int item, int lane) {
    const int nblk = J.Nd / 32, kb = item / nblk, nb = item % nblk, k0 = 64 * kb, n0 = 32 * nb;
    const int n = n0 + (lane & 31);
    const float* sp = nullptr;
    if (J.mode == 0) { if (n < J.Nsrc) sp = J.src0 + n; }
    else if (J.mode == 1) { const int c = inproj_src_col(n); if (c >= 0) sp = J.src0 + c; }
    else { const int pn = n >> 8, s = (n >> 7) & 1, j = 128 * pn + (n & 127); const long long d01 = (const char*)J.src1 - (const char*)J.src0;
           if (j < J.Nsrc) sp = (const float*)((const char*)J.src0 + (s ? d01 : 0ll)) + j; }
#pragma unroll 8
    for (int i = 0; i < 32; ++i) { const int kk = 2 * i + (lane >> 5); float v = 0.f; if (sp && (k0 + kk) < J.Ksrc) v = sp[(size_t)(k0 + kk) * J.ld]; scr[kk * 33 + (lane & 31)] = v; }
    LDS_WAIT(); asm volatile("" ::: "memory");
    const int c = lane & 7;
#pragma unroll
    for (int j = 0; j < 4; ++j) { const int nn = (lane >> 3) + 8 * j; const LAS float* s = scr + (8 * c) * 33 + nn;
        v4u o; o.x = pk2(s[0 * 33], s[1 * 33]); o.y = pk2(s[2 * 33], s[3 * 33]); o.z = pk2(s[4 * 33], s[5 * 33]); o.w = pk2(s[6 * 33], s[7 * 33]);
        *(GAS v4u*)(J.dst + (size_t)(n0 + nn) * J.Kd + k0 + 8 * c) = o; }
    LDS_WAIT(); asm volatile("" ::: "memory");
}
__device__ __forceinline__ void conv_run(const ConvJob& J, LAS float* scr, int gw, int ngw, int lane) {
    const int nitems = (J.Kd / 64) * (J.Nd / 32);
    for (int it = gw; it < nitems; it += ngw) conv_item(J, scr, it, lane);
}

template <bool ROUTER>
__global__ void __launch_bounds__(256) k_norm(const float* __restrict__ x, const float* __restrict__ g, bf16* __restrict__ out,
                                              const float* __restrict__ rw, const float* __restrict__ rb, float* __restrict__ cw) {
    const int row = blockIdx.x * 4 + (threadIdx.x >> 6), lane = threadIdx.x & 63;
    const f32x4* xr = (const f32x4*)(x + (size_t)row * DM) + lane;
    f32x4 v[4]; float s = 0.f;
#pragma unroll
    for (int j = 0; j < 4; ++j) { v[j] = xr[64 * j]; s += (v[j].x * v[j].x + v[j].y * v[j].y) + (v[j].z * v[j].z + v[j].w * v[j].w); }
    s = wave_sum(s);
    const float rstd = rsqrtf(s * (1.0f / DM) + 1e-6f);
    const f32x4* gr = (const f32x4*)g + lane;
    v2u* o8 = (v2u*)(out + (size_t)row * DM) + lane;
#pragma unroll
    for (int j = 0; j < 4; ++j) { const f32x4 gv = gr[64 * j]; v[j] = v[j] * rstd * gv; v2u o; o.x = pk2(v[j].x, v[j].y); o.y = pk2(v[j].z, v[j].w); o8[64 * j] = o; }
    if (ROUTER) {
        float lg[8];
#pragma unroll
        for (int e = 0; e < 8; ++e) lg[e] = 0.f;
#pragma unroll
        for (int j = 0; j < 4; ++j)
#pragma unroll
            for (int i = 0; i < 4; ++i) { const int c = 4 * lane + 256 * j + i; const f32x4 w0 = *(const f32x4*)(rw + (size_t)c * 8), w1 = *(const f32x4*)(rw + (size_t)c * 8 + 4); const float h = v[j][i];
                lg[0] += h * w0.x; lg[1] += h * w0.y; lg[2] += h * w0.z; lg[3] += h * w0.w; lg[4] += h * w1.x; lg[5] += h * w1.y; lg[6] += h * w1.z; lg[7] += h * w1.w; }
#pragma unroll
        for (int e = 0; e < 8; ++e) lg[e] = wave_sum(lg[e]) + rb[e];
        int i1 = 0; float v1 = lg[0];
#pragma unroll
        for (int e = 1; e < 8; ++e) if (lg[e] > v1) { v1 = lg[e]; i1 = e; }
        int i2 = -1; float v2 = -3.0e38f;
#pragma unroll
        for (int e = 0; e < 8; ++e) if (e != i1 && lg[e] > v2) { v2 = lg[e]; i2 = e; }
        const float e2 = __expf(v2 - v1), w1 = 1.0f / (1.0f + e2), w2 = e2 * w1;
        if (lane < 8) cw[(size_t)row * 8 + lane] = (lane == i1) ? w1 : ((lane == i2) ? w2 : 0.f);
    }
}

__global__ void __launch_bounds__(256) k_headnorm(bf16* __restrict__ proj, const float* __restrict__ dil_g  , const float* __restrict__ nsa_g  ) {
    const int row = blockIdx.x * 4 + (threadIdx.x >> 6), lane = threadIdx.x & 63;
    bf16* pr = proj + (size_t)row * PW;
#pragma unroll 1
    for (int i = 0; i < 14; ++i) {
        int off; const float* g;
        if (i < 4) { off = P_DQ + 64 * i; g = dil_g; } else if (i < 8) { off = P_DK + 64 * (i - 4); g = dil_g + 64; } else if (i < 12) { off = P_NQ + 64 * (i - 8); g = nsa_g; }
        else if (i == 12) { off = P_KS; g = nsa_g + 128; } else { off = P_KW; g = nsa_g + 192; }
        const float v = bf2f(pr[off + lane]);
        const float ss = wave_sum(v * v);
        pr[off + lane] = (bf16)f2bf(v * rsqrtf(ss * (1.0f / 64.0f) + 1e-6f) * g[lane]);
    }
}

__device__ __forceinline__ void att_key(const float (&q)[64], const bf16* __restrict__ kp, const bf16* __restrict__ vp, float bias, float& m, float& l, float (&o)[64]) {
    float dot = 0.f;
#pragma unroll
    for (int c = 0; c < 8; ++c) { const v4u kk = *(const v4u*)(kp + 8 * c);
        dot += q[8 * c + 0] * bflo(kk.x) + q[8 * c + 1] * bfhi(kk.x) + q[8 * c + 2] * bflo(kk.y) + q[8 * c + 3] * bfhi(kk.y)
             + q[8 * c + 4] * bflo(kk.z) + q[8 * c + 5] * bfhi(kk.z) + q[8 * c + 6] * bflo(kk.w) + q[8 * c + 7] * bfhi(kk.w); }
    const float s = dot * 0.125f + bias;
    const float mn = fmaxf(m, s), sc = __expf(m - mn), p = __expf(s - mn);
    l = l * sc + p; m = mn;
#pragma unroll
    for (int c = 0; c < 8; ++c) { const v4u vv = *(const v4u*)(vp + 8 * c);
        o[8 * c + 0] = o[8 * c + 0] * sc + p * bflo(vv.x); o[8 * c + 1] = o[8 * c + 1] * sc + p * bfhi(vv.x);
        o[8 * c + 2] = o[8 * c + 2] * sc + p * bflo(vv.y); o[8 * c + 3] = o[8 * c + 3] * sc + p * bfhi(vv.y);
        o[8 * c + 4] = o[8 * c + 4] * sc + p * bflo(vv.z); o[8 * c + 5] = o[8 * c + 5] * sc + p * bfhi(vv.z);
        o[8 * c + 6] = o[8 * c + 6] * sc + p * bflo(vv.w); o[8 * c + 7] = o[8 * c + 7] * sc + p * bfhi(vv.w); }
}
__device__ __forceinline__ void load_q(float (&q)[64], const bf16* qp) {
#pragma unroll
    for (int c = 0; c < 8; ++c) { const v4u kk = *(const v4u*)(qp + 8 * c);
        q[8 * c + 0] = bflo(kk.x); q[8 * c + 1] = bfhi(kk.x); q[8 * c + 2] = bflo(kk.y); q[8 * c + 3] = bfhi(kk.y);
        q[8 * c + 4] = bflo(kk.z); q[8 * c + 5] = bfhi(kk.z); q[8 * c + 6] = bflo(kk.w); q[8 * c + 7] = bfhi(kk.w); }
}
template <int MODE>
__global__ void __launch_bounds__(256) k_attn_naive(const bf16* __restrict__ proj, const unsigned long long* __restrict__ sel, float* __restrict__ out, int ldo, int ocol) {
    const int idx = blockIdx.x * 256 + threadIdx.x, h = idx / NT, r = idx % NT, b = r / SQ, t = r % SQ;
    const bf16* base = proj + (size_t)b * SQ * PW;
    float q[64], o[64];
    load_q(q, proj + (size_t)r * PW + (MODE == 0 ? P_DQ : P_NQ) + 64 * h);
#pragma unroll
    for (int d = 0; d < 64; ++d) o[d] = 0.f;
    float m = -1.0e30f, l = 0.f;
    if (MODE == 0) {
        const float slope = exp2f(-2.0f * (h + 1));
        for (int p = 0; p < 3; ++p) { const int dil = (p == 0) ? 1 : (p == 1 ? 4 : 16);
            for (int j = 0; j <= 128; ++j) { const int pos = t - j * dil; if (pos < 0) break;
                att_key(q, base + (size_t)pos * PW + P_DK + 64 * h, base + (size_t)pos * PW + P_DV + 64 * h, -slope * (float)(j * dil), m, l, o); } }
    } else if (MODE == 1) {
        const float slope = exp2f(-(2.0f * h + 1.0f));
        const unsigned long long mask = sel[r]; const int cur = t >> 6;
        for (int j = 0; j <= cur; ++j) { if (!((mask >> j) & 1ull)) continue;
            for (int oo = 0; oo < 64; ++oo) { const int pos = 64 * j + oo; if (pos > t) break;
                att_key(q, base + (size_t)pos * PW + P_KS, base + (size_t)pos * PW + P_VS, -slope * (float)(t - pos), m, l, o); } }
    } else {
        const float slope = exp2f(-(2.0f * h + 1.0f));
        const int p0 = (t - 511) > 0 ? (t - 511) : 0;
        for (int pos = p0; pos <= t; ++pos) att_key(q, base + (size_t)pos * PW + P_KW, base + (size_t)pos * PW + P_VW, -slope * (float)(t - pos), m, l, o);
    }
    const float il = 1.0f / l;
    float* op = out + (size_t)r * ldo + ocol + 64 * h;
#pragma unroll
    for (int c = 0; c < 16; ++c) *(f32x4*)(op + 4 * c) = (f32x4){o[4 * c] * il, o[4 * c + 1] * il, o[4 * c + 2] * il, o[4 * c + 3] * il};
}

__global__ void __launch_bounds__(256) k_compress(const bf16* __restrict__ proj, const float* __restrict__ pos  , const float* __restrict__ w1  ,
                                                  const float* __restrict__ w2  , const float* __restrict__ gk  , float* __restrict__ KC, float* __restrict__ VC) {
    __shared__ float in[2048]; __shared__ float hid[256];
    const int which = blockIdx.x & 1, c = (blockIdx.x >> 1) % NCMP, b = (blockIdx.x >> 1) / NCMP, tid = threadIdx.x;
    const int pc = which ? P_VC : P_KC;
    for (int i = tid; i < 2048; i += 256) { const int l = i >> 6, d = i & 63; in[i] = bf2f(proj[(size_t)(b * SQ + 16 * c + l) * PW + pc + d]) + pos[which * 2048 + i]; }
    __syncthreads();
    const float* w1p = w1 + (size_t)which * 2048 * 256 + tid;
    float a = 0.f;
    for (int i = 0; i < 2048; ++i) a += in[i] * w1p[(size_t)i * 256];
    hid[tid] = gelu_tanh(a);
    __syncthreads();
    if (tid < 64) {
        const float* w2p = w2 + (size_t)which * 256 * 64 + tid; float o = 0.f;
        for (int j = 0; j < 256; ++j) o += hid[j] * w2p[j * 64];
        if (which == 0) { const float ss = wave_sum(o * o); o = o * rsqrtf(ss * (1.0f / 64.0f) + 1e-6f) * gk[tid]; KC[((size_t)b * NCMPP + c) * 64 + tid] = o; }
        else VC[((size_t)b * NCMPP + c) * 64 + tid] = o;
    }
}

__global__ void __launch_bounds__(256) k_cmp_topk(const bf16* __restrict__ proj, const float* __restrict__ KC, const float* __restrict__ VC, float* __restrict__ ocmp, unsigned long long* __restrict__ sel) {
    __shared__ float qs[256]; __shared__ float sc[4][256]; __shared__ float impv[64];
    const int r = blockIdx.x, b = r / SQ, t = r % SQ, tid = threadIdx.x, lane = tid & 63, w = tid >> 6;
    qs[tid] = bf2f(proj[(size_t)r * PW + P_NQ + tid]);
    __syncthreads();
    {   const int c = tid; const bool valid = (c < NCMP) && (t >= 16 * c + 31);
        float s[4] = {0.f, 0.f, 0.f, 0.f};
        if (valid) { const float* kp = KC + ((size_t)b * NCMPP + c) * 64;
            for (int d = 0; d < 64; ++d) { const float kv = kp[d]; s[0] += qs[d] * kv; s[1] += qs[64 + d] * kv; s[2] += qs[128 + d] * kv; s[3] += qs[192 + d] * kv; } }
        const float dist = (float)(t - 16 * c - 31);
#pragma unroll
        for (int h = 0; h < 4; ++h) sc[h][c] = valid ? (s[h] * 0.125f - exp2f(-(2.0f * h + 1.0f)) * dist) : -1.0e30f;
    }
    __syncthreads();
    {
        float v[4]; float mx = -1.0e30f;
#pragma unroll
        for (int i = 0; i < 4; ++i) { v[i] = sc[w][lane + 64 * i]; mx = fmaxf(mx, v[i]); }
        mx = wave_max(mx);
        float sum = 0.f;
#pragma unroll
        for (int i = 0; i < 4; ++i) { v[i] = (v[i] > -1.0e29f) ? __expf(v[i] - mx) : 0.f; sum += v[i]; }
        sum = wave_sum(sum);
        const float inv = sum > 0.f ? 1.0f / sum : 0.f;
#pragma unroll
        for (int i = 0; i < 4; ++i) sc[w][lane + 64 * i] = v[i] * inv;
    }
    __syncthreads();
    {
        const int h = tid >> 6, d = tid & 63; const float* vp = VC + (size_t)b * NCMPP * 64 + d; float o = 0.f;
        const int nc = (t >= 31) ? ((t - 31) / 16 + 1) : 0;
        for (int c = 0; c < nc && c < NCMP; ++c) o += sc[h][c] * vp[c * 64];
        ocmp[(size_t)r * 256 + tid] = o;
    }
    if (tid < 64) {
        const int j = tid, cur = t >> 6; float imp = 0.f;
        for (int c = 4 * j - 1; c <= 4 * j + 3; ++c) if (c >= 0 && c < NCMP) imp += sc[0][c] + sc[1][c] + sc[2][c] + sc[3][c];
        const bool forced = (j == 0) || (j == cur) || (j == cur - 1);
        const float val = (j <= cur) ? (imp + (forced ? 1.0e4f : 0.f)) : -1.0e30f;
        impv[j] = val;
    }
    __syncthreads();
    if (tid < 64) {
        const int j = tid; const float val = impv[j]; int rank = 0;
        for (int k = 0; k < 64; ++k) { const float o = impv[k]; rank += (o > val || (o == val && k < j)) ? 1 : 0; }
        const unsigned long long mask = __ballot(rank < 16);
        if (tid == 0) sel[r] = mask;
    }
}

__global__ void __launch_bounds__(64) k_gla(const bf16* __restrict__ proj, const float* __restrict__ wa2  , const float* __restrict__ ba  , const float* __restrict__ ng  , float* __restrict__ mixraw) {
    const int b = blockIdx.x >> 2, h = blockIdx.x & 3, lane = threadIdx.x, kk = lane & 31;
    float wcol[16];
#pragma unroll
    for (int j = 0; j < 16; ++j) wcol[j] = wa2[j * 128 + h * 32 + kk];
    const float bav = ba[h * 32 + kk], gn = ng[lane];
    float S[32];
#pragma unroll
    for (int k = 0; k < 32; ++k) S[k] = 0.f;
    for (int t = 0; t < SQ; ++t) {
        const bf16* pr = proj + (size_t)(b * SQ + t) * PW;
        const float qv = bf2f(pr[P_GQ + h * 32 + kk]) * 0.17677669529663687f, kv = bf2f(pr[P_GK + h * 32 + kk]);
        const v4u a0 = *(const v4u*)(pr + P_GA), a1 = *(const v4u*)(pr + P_GA + 8);
        float z = bav;
        z += bflo(a0.x) * wcol[0] + bfhi(a0.x) * wcol[1] + bflo(a0.y) * wcol[2] + bfhi(a0.y) * wcol[3] + bflo(a0.z) * wcol[4] + bfhi(a0.z) * wcol[5] + bflo(a0.w) * wcol[6] + bfhi(a0.w) * wcol[7];
        z += bflo(a1.x) * wcol[8] + bfhi(a1.x) * wcol[9] + bflo(a1.y) * wcol[10] + bfhi(a1.y) * wcol[11] + bflo(a1.z) * wcol[12] + bfhi(a1.z) * wcol[13] + bflo(a1.w) * wcol[14] + bfhi(a1.w) * wcol[15];
        const float av = __expf(log_sigmoid_f(z) * (1.0f / 16.0f));
        const float vv = bf2f(pr[P_GV + h * 64 + lane]);
        float o = 0.f;
#pragma unroll
        for (int k = 0; k < 32; ++k) { const float ak = __shfl(av, k), kx = __shfl(kv, k), qx = __shfl(qv, k); S[k] = S[k] * ak + kx * vv; o += qx * S[k]; }
        const float ss = wave_sum(o * o);
        float y = o * rsqrtf(ss * (1.0f / 64.0f) + 1e-6f) * gn;
        const float rr = bf2f(pr[P_GR + h * 64 + lane]);
        y *= rr * sigmoid_f(rr);
        mixraw[(size_t)(b * SQ + t) * 1024 + 512 + h * 64 + lane] = y;
    }
}

__global__ void __launch_bounds__(64) k_s5(const bf16* __restrict__ proj, const float* __restrict__ a_re, const float* __restrict__ a_im, const float* __restrict__ b_re, const float* __restrict__ b_im,
                                           const float* __restrict__ c_re, const float* __restrict__ c_im, const float* __restrict__ dvec, const float* __restrict__ log_dt, float* __restrict__ hg) {
    __shared__ float xs[128];
    const int b = blockIdx.x >> 4, g = blockIdx.x & 15, lane = threadIdx.x, n = lane;
    const float dt = expf(log_dt[g]), are = a_re[g * 64 + n], aim = a_im[g * 64 + n];
    const float mag = expf(dt * are), abr = mag * cosf(dt * aim), abi = mag * sinf(dt * aim);
    const float den = are * are + aim * aim, f_re = ((abr - 1.0f) * are + abi * aim) / den, f_im = (abi * are - (abr - 1.0f) * aim) / den;
    float bbr[16], bbi[16];
#pragma unroll
    for (int c = 0; c < 16; ++c) { const float br = b_re[(size_t)(g * 64 + n) * 16 + c], bi = b_im[(size_t)(g * 64 + n) * 16 + c]; bbr[c] = f_re * br - f_im * bi; bbi[c] = f_re * bi + f_im * br; }
    const int cc = lane & 15, qq = lane >> 4;
    float cre[16], cim[16];
#pragma unroll
    for (int i = 0; i < 16; ++i) { cre[i] = c_re[(size_t)(g * 16 + cc) * 64 + qq * 16 + i]; cim[i] = c_im[(size_t)(g * 16 + cc) * 64 + qq * 16 + i]; }
    const float dco = dvec[g * 16 + cc];
    float xr = 0.f, xi = 0.f;
    for (int t = 0; t < SQ; ++t) {
        const size_t r = (size_t)b * SQ + t;
        const float uval = bf2f(proj[r * PW + P_SU + g * 16 + cc]);
        float bur = 0.f, bui = 0.f;
#pragma unroll
        for (int c = 0; c < 16; ++c) { const float uc = __shfl(uval, c); bur += bbr[c] * uc; bui += bbi[c] * uc; }
        const float nr = abr * xr - abi * xi + bur, ni = abr * xi + abi * xr + bui; xr = nr; xi = ni;
        xs[n] = xr; xs[64 + n] = xi;
        __syncthreads();
        float part = 0.f;
#pragma unroll
        for (int i = 0; i < 16; ++i) part += cre[i] * xs[qq * 16 + i] - cim[i] * xs[64 + qq * 16 + i];
        part += __shfl_xor(part, 16); part += __shfl_xor(part, 32);
        const float y = part + dco * uval;
        if (lane < 16) hg[r * 256 + g * 16 + lane] = gelu_tanh(y);
        __syncthreads();
    }
}
__global__ void __launch_bounds__(256) k_s5_glu(const float* __restrict__ hg, const float* __restrict__ gw  , const float* __restrict__ gb, float* __restrict__ mixraw) {
    __shared__ float hs[256];
    const int r = blockIdx.x, tid = threadIdx.x;
    hs[tid] = hg[(size_t)r * 256 + tid];
    __syncthreads();
    float z = gb[tid];
    for (int i = 0; i < 256; ++i) z += hs[i] * gw[i * 256 + tid];
    mixraw[(size_t)r * 1024 + 768 + tid] = hs[tid] * sigmoid_f(z);
}
__global__ void __launch_bounds__(256) k_mixfinal(const bf16* __restrict__ proj, const float* __restrict__ mixraw, const float* __restrict__ ocmp, const float* __restrict__ os, const float* __restrict__ ow,
                                                  const float* __restrict__ og  , bf16* __restrict__ mix) {
    __shared__ float red[4][4];
    const int r = blockIdx.x, tid = threadIdx.x, lane = tid & 63, w = tid >> 6;
    float v[4];
    v[0] = mixraw[(size_t)r * 1024 + tid]; v[2] = mixraw[(size_t)r * 1024 + 512 + tid]; v[3] = mixraw[(size_t)r * 1024 + 768 + tid];
    {   const bf16* gp = proj + (size_t)r * PW + P_NG + 3 * w;
        const float g0 = sigmoid_f(bf2f(gp[0])), g1 = sigmoid_f(bf2f(gp[1])), g2 = sigmoid_f(bf2f(gp[2]));
        v[1] = g0 * ocmp[(size_t)r * 256 + tid] + g1 * os[(size_t)r * 256 + tid] + g2 * ow[(size_t)r * 256 + tid]; }
#pragma unroll
    for (int gidx = 0; gidx < 4; ++gidx) { const float s = wave_sum(v[gidx] * v[gidx]); if (lane == 0) red[gidx][w] = s; }
    __syncthreads();
#pragma unroll
    for (int gidx = 0; gidx < 4; ++gidx) { const float ss = red[gidx][0] + red[gidx][1] + red[gidx][2] + red[gidx][3];
        mix[(size_t)r * 1024 + gidx * 256 + tid] = (bf16)f2bf(v[gidx] * rsqrtf(ss * (1.0f / 256.0f) + 1e-6f) * og[gidx * 256 + tid]); }
}

enum Phase { PH_CONV0 = 0, PH_INPROJ = 1, PH_OUTPROJ = 2, PH_FFN_GU = 3, PH_FFN_DN = 4, PH_MOE_CONV = 5, PH_MOE_GU = 6, PH_MOE_DN = 7 };
struct Args { const float* in[32]; float* out; unsigned char* ws; int ph, layer, expert, pad; };
__global__ void __launch_bounds__(NWAVES * 64, 2) mk_fwd(Args args) {
    extern __shared__ __attribute__((aligned(16))) unsigned char lds_raw[];
    LAS unsigned char* lds = (LAS unsigned char*)lds_raw;
    const int tid = threadIdx.x, lane = tid & 63, wave = __builtin_amdgcn_readfirstlane(tid >> 6);
    const int G = gridDim.x, gw = blockIdx.x * NWAVES + wave, ngw = G * NWAVES;
    unsigned char* ws = args.ws;
    const int ph = args.ph, L = args.layer, E = args.expert;
    bf16* HN = (bf16*)(ws + WS_HN); bf16* PROJ = (bf16*)(ws + WS_PROJ);
    LAS float* scr = (LAS float*)(lds + RING_OFF + wave * 16384);

    if (ph == PH_CONV0) {
        for (int l = 0; l < 2; ++l) {
            ConvJob j1{args.in[2] + (size_t)l * DM * PROJ_SRC, nullptr, (bf16*)(ws + WS_WIN) + (size_t)l * PW * DM, PROJ_SRC, DM, PROJ_SRC, PW, DM, 1, 0};
            conv_run(j1, scr, gw, ngw, lane);
            ConvJob j2{args.in[22] + (size_t)l * DM * DM, nullptr, (bf16*)(ws + WS_WOUT) + (size_t)l * DM * DM, DM, DM, DM, DM, DM, 0, 0};
            conv_run(j2, scr, gw, ngw, lane);
        }
        ConvJob j3{args.in[24], args.in[25], (bf16*)(ws + WS_WFGU), DFF, DM, DFF, 2 * DFFP, DM, 2, 0};
        conv_run(j3, scr, gw, ngw, lane);
        ConvJob j4{args.in[26], nullptr, (bf16*)(ws + WS_WFDN), DM, DFF, DM, DM, DFFP, 0, 0};
        conv_run(j4, scr, gw, ngw, lane);
    }
    if (ph == PH_MOE_CONV) {
        ConvJob j1{args.in[29] + (size_t)E * DM * DFE, args.in[30] + (size_t)E * DM * DFE, (bf16*)(ws + WS_WEGU), DFE, DM, DFE, 2 * DFE, DM, 2, 0};
        conv_run(j1, scr, gw, ngw, lane);
        ConvJob j2{args.in[31] + (size_t)E * DFE * DM, nullptr, (bf16*)(ws + WS_WEDN), DM, DFE, DM, DM, DFE, 0, 0};
        conv_run(j2, scr, gw, ngw, lane);
    }
    if (ph == PH_INPROJ) {
        pg8::Gemm g{HN, (bf16*)(ws + WS_WIN) + (size_t)L * PW * DM, NT, PW, DM}; pg8::StaticOrder S; S.init(NT, PW, G, (int)blockIdx.x);
        pg8::EpiStoreBf16 Ep{PROJ, PW};
        pg8::gemm_phase<pg8::EpiStoreBf16, pg8::StaticOrder, true, true>(lds + RING_OFF, g, S, Ep);
    }
    if (ph == PH_OUTPROJ) {
        pg8::Gemm g{HN  , (bf16*)(ws + WS_WOUT) + (size_t)L * DM * DM, NT, DM, DM}; pg8::StaticOrder S; S.init(NT, DM, G, (int)blockIdx.x);
        pg8::EpiResF32 Ep{L == 0 ? args.in[0] : args.out, args.out, DM};
        pg8::gemm_phase<pg8::EpiResF32, pg8::StaticOrder, true, true>(lds + RING_OFF, g, S, Ep);
    }
    if (ph == PH_FFN_GU) {
        pg8::Gemm g{HN, (bf16*)(ws + WS_WFGU), NT, 2 * DFFP, DM}; pg8::StaticOrder S; S.init(NT, 2 * DFFP, G, (int)blockIdx.x);
        pg8::EpiSwiglu Ep{(bf16*)(ws + WS_FH), DFFP, 0};
        pg8::gemm_phase<pg8::EpiSwiglu, pg8::StaticOrder, true, true>(lds + RING_OFF, g, S, Ep);
    }
    if (ph == PH_FFN_DN) {
        pg8::Gemm g{(bf16*)(ws + WS_FH), (bf16*)(ws + WS_WFDN), NT, DM, DFFP}; pg8::StaticOrder S; S.init(NT, DM, G, (int)blockIdx.x);
        pg8::EpiResF32 Ep{args.out, args.out, DM};
        pg8::gemm_phase<pg8::EpiResF32, pg8::StaticOrder, true, true>(lds + RING_OFF, g, S, Ep);
    }
    if (ph == PH_MOE_GU) {
        pg8::Gemm g{HN, (bf16*)(ws + WS_WEGU), NT, 2 * DFE, DM}; pg8::StaticOrder S; S.init(NT, 2 * DFE, G, (int)blockIdx.x);
        pg8::EpiSwiglu Ep{(bf16*)(ws + WS_EH), DFE, 0};
        pg8::gemm_phase<pg8::EpiSwiglu, pg8::StaticOrder, true, true>(lds + RING_OFF, g, S, Ep);
    }
    if (ph == PH_MOE_DN) {
        pg8::Gemm g{(bf16*)(ws + WS_EH), (bf16*)(ws + WS_WEDN), NT, DM, DFE}; pg8::StaticOrder S; S.init(NT, DM, G, (int)blockIdx.x);
        pg8::EpiResScaledF32 Ep{args.out, DM, (const float*)(ws + WS_CW), 8, E};
        pg8::gemm_phase<pg8::EpiResScaledF32, pg8::StaticOrder, true, true>(lds + RING_OFF, g, S, Ep);
    }
}

extern "C" void kernel_launch(void* const* d_in, const int* in_sizes, int n_in, void* d_out, int out_size, void* d_ws, size_t ws_size, hipStream_t stream) {
    static int grid = 0;
    if (grid == 0) {
        if (n_in != 32 || in_sizes[0] != NT * DM || out_size != NT * DM || ws_size < WS_END) { fprintf(stderr, "kernel_launch: unexpected shapes (n_in %d, in0 %d, out %d, ws %zu)\n", n_in, n_in > 0 ? in_sizes[0] : -1, out_size, ws_size); grid = -1; return; }
        int dev = 0, cus = 0;
        if (hipGetDevice(&dev) != hipSuccess || hipDeviceGetAttribute(&cus, hipDeviceAttributeMultiprocessorCount, dev) != hipSuccess) { grid = -1; return; }
        if (hipFuncSetAttribute((const void*)mk_fwd, hipFuncAttributeMaxDynamicSharedMemorySize, LDS_BYTES) != hipSuccess) { fprintf(stderr, "kernel_launch: hipFuncSetAttribute failed\n"); grid = -1; return; }
        (void)hipGetLastError();
        grid = cus;
    }
    if (grid < 0) return;
    const float* const* in = (const float* const*)d_in;
    unsigned char* ws = (unsigned char*)d_ws;
    float* out = (float*)d_out;
    bf16* HN = (bf16*)(ws + WS_HN); bf16* PROJ = (bf16*)(ws + WS_PROJ);
    float* MIXRAW = (float*)(ws + WS_MIXRAW); float* OCMP = (float*)(ws + WS_OCMP); float* OS = (float*)(ws + WS_OS); float* OW = (float*)(ws + WS_OW); float* HG = (float*)(ws + WS_HG);
    float* KC = (float*)(ws + WS_KC); float* VC = (float*)(ws + WS_VC); unsigned long long* SEL = (unsigned long long*)(ws + WS_SEL); float* CW = (float*)(ws + WS_CW);
    (void)hipMemsetAsync(ws + WS_CTL, 0, CTL_ZERO_BYTES, stream);
    Args a{};
    for (int i = 0; i < 32; ++i) a.in[i] = in[i];
    a.out = out; a.ws = ws;
#define MK(PH, LL, EE) do { a.ph = (PH); a.layer = (LL); a.expert = (EE); hipLaunchKernelGGL(mk_fwd, dim3(grid), dim3(NWAVES * 64), LDS_BYTES, stream, a); } while (0)
    MK(PH_CONV0, 0, 0);
    for (int l = 0; l < 2; ++l) {
        const float* xin = (l == 0) ? in[0] : out;
        hipLaunchKernelGGL(k_norm<false>, dim3(NT / 4), dim3(256), 0, stream, xin, in[1] + l * DM, HN, nullptr, nullptr, nullptr);
        MK(PH_INPROJ, l, 0);
        hipLaunchKernelGGL(k_headnorm, dim3(NT / 4), dim3(256), 0, stream, PROJ, in[3] + l * 128, in[4] + l * 256);
        hipLaunchKernelGGL(k_attn_naive<0>, dim3(NT * 4 / 256), dim3(256), 0, stream, PROJ, SEL, MIXRAW, 1024, 0);
        hipLaunchKernelGGL(k_compress, dim3(NB * NCMP * 2), dim3(256), 0, stream, PROJ, in[5] + l * 2 * 2048, in[6] + (size_t)l * 2 * 2048 * 256, in[7] + l * 2 * 256 * 64, in[4] + l * 256 + 64, KC, VC);
        hipLaunchKernelGGL(k_cmp_topk, dim3(NT), dim3(256), 0, stream, PROJ, KC, VC, OCMP, SEL);
        hipLaunchKernelGGL(k_attn_naive<1>, dim3(NT * 4 / 256), dim3(256), 0, stream, PROJ, SEL, OS, 256, 0);
        hipLaunchKernelGGL(k_attn_naive<2>, dim3(NT * 4 / 256), dim3(256), 0, stream, PROJ, SEL, OW, 256, 0);
        hipLaunchKernelGGL(k_gla, dim3(NB * 4), dim3(64), 0, stream, PROJ, in[8] + l * 16 * 128, in[9] + l * 128, in[10] + l * 64, MIXRAW);
        hipLaunchKernelGGL(k_s5, dim3(NB * 16), dim3(64), 0, stream, PROJ, in[11] + l * 1024, in[12] + l * 1024, in[13] + l * 16384, in[14] + l * 16384, in[15] + l * 16384, in[16] + l * 16384, in[17] + l * 256, in[18] + l * 16, HG);
        hipLaunchKernelGGL(k_s5_glu, dim3(NT), dim3(256), 0, stream, HG, in[19] + l * 65536, in[20] + l * 256, MIXRAW);
        hipLaunchKernelGGL(k_mixfinal, dim3(NT), dim3(256), 0, stream, PROJ, MIXRAW, OCMP, OS, OW, in[21] + l * 1024, HN);
        MK(PH_OUTPROJ, l, 0);
        if (l == 0) {
            hipLaunchKernelGGL(k_norm<false>, dim3(NT / 4), dim3(256), 0, stream, out, in[23] + l * DM, HN, nullptr, nullptr, nullptr);
            MK(PH_FFN_GU, 0, 0);
            MK(PH_FFN_DN, 0, 0);
        } else {
            hipLaunchKernelGGL(k_norm<true>, dim3(NT / 4), dim3(256), 0, stream, out, in[23] + l * DM, HN, in[27], in[28], CW);
            for (int e = 0; e < NEXP; ++e) { MK(PH_MOE_CONV, 1, e); MK(PH_MOE_GU, 1, e); MK(PH_MOE_DN, 1, e); }
        }
    }
#undef MK
}
```

```cpp
#include <hip/hip_runtime.h>
#include <cstdio>
#include <cstdint>
namespace pg8 {
#define PG8_LAS __attribute__((address_space(3)))
typedef unsigned short bf16_t;
typedef short bf16x8 __attribute__((ext_vector_type(8)));
typedef float f32x4 __attribute__((ext_vector_type(4)));
typedef unsigned u32x4 __attribute__((ext_vector_type(4)));
constexpr int BM = 256, BK = 64, HALF = 128, HTB = HALF * BK * 2  , STAGE_BYTES = 8 * HTB, NXCD = 8, WGM = 8;

__host__ __device__ __forceinline__ int lds_byte(int r, int c) { const int st = (r >> 4) * 2 + (c >> 5), rr = r & 15, cc = c & 31, ob = rr * 64 + cc * 2; return st * 1024 + (ob ^ (((ob >> 9) & 1) << 5)); }
__host__ __device__ __forceinline__ void stage_rc(int b, int& R, int& C) { const int st = b / 1024, sb = b % 1024, swz = sb ^ (((sb >> 9) & 1) << 5); R = (st >> 1) * 16 + swz / 64; C = (st & 1) * 32 + (swz % 64) / 2; }
__host__ __device__ __forceinline__ int perm32(int rho) { const int n = rho >> 4, i = rho & 15; return 8 * (i >> 2) + 4 * n + (i & 3); }

struct Unit { int pm, pn; };
struct Gemm { const bf16_t* A; const bf16_t* Bt; int M, N, K; int lda = 0, kstepA = 0, hiofs = 0; };

struct StaticOrder {
    int nM, nN, nwg, G, c;
    __host__ __device__ void init(int M, int N, int G_, int c_) { nM = M / BM; nN = N / BM; nwg = nM * nN; G = G_; c = c_; }
    __host__ __device__ bool next(int i, Unit& u) const {
        const long L = (long)i * G + c; if (L >= nwg) return false;
        int wgid = (int)L; { const int q = nwg / NXCD, r = nwg % NXCD, xcd = wgid % NXCD, off = wgid / NXCD; wgid = (xcd < r ? xcd * (q + 1) : r * (q + 1) + (xcd - r) * q) + off; }
        const int nig = WGM * nN, gid = wgid / nig, fm = gid * WGM, gsz = (nM - fm) < WGM ? (nM - fm) : WGM;
        u.pm = fm + ((wgid % nig) % gsz); u.pn = (wgid % nig) / gsz; return true;
    }
    __device__ __forceinline__ void a_ready(const Unit&) const {}
    __device__ __forceinline__ void done(const Unit&) const {}
};

typedef float f32x2c_t __attribute__((ext_vector_type(2))); typedef __bf16 bf16x2c_t __attribute__((ext_vector_type(2)));
__device__ __forceinline__ unsigned cvt_pk_bf16(float lo, float hi) { f32x2c_t v = {lo, hi}; bf16x2c_t b = __builtin_convertvector(v, bf16x2c_t); return __builtin_bit_cast(unsigned, b); }
typedef float f32x2 __attribute__((ext_vector_type(2)));
__device__ __forceinline__ f32x2 gelu_pk(f32x2 v) {
    const f32x2 av = __builtin_elementwise_abs(v), d = av * 0.2316418882f + 1.0f;
    f32x2 t; t.x = __builtin_amdgcn_rcpf(d.x); t.y = __builtin_amdgcn_rcpf(d.y);
    f32x2 q = t * 0.5307027145f + (-0.7265760135f); q = q * t + 0.7107068705f; q = q * t + (-0.142248368f); q = q * t + 0.127414796f; q = q * t;
    const f32x2 s = (v * v) * (-0.72134752044f);
    f32x2 e; e.x = __builtin_amdgcn_exp2f(s.x); e.y = __builtin_amdgcn_exp2f(s.y);
    const f32x2 m = v * (q * e), r = v - m;
    f32x2 o; o.x = v.x < 0.f ? m.x : r.x; o.y = v.y < 0.f ? m.y : r.y; return o;
}


__device__ __forceinline__ float silu_f(float x) { return x * __builtin_amdgcn_rcpf(1.0f + __expf(-x)); }
struct EpiStoreBf16 {
    static constexpr bool PERM = true, AFTER_DRAIN = false;
    bf16_t* O; int ldc;
    __device__ __forceinline__ void operator()(const f32x4 (&acc)[2][2][4][2], const Unit& u, int wr, int wc, int fr, int fq) const {
        const int row0 = u.pm * BM + wr * 64 + fr, col0 = u.pn * BM + wc * 32 + 8 * fq;
#pragma unroll
        for (int ai = 0; ai < 2; ++ai)
#pragma unroll
            for (int m = 0; m < 4; ++m) { bf16_t* rowp = O + (size_t)(row0 + ai * HALF + m * 16) * ldc + col0;
#pragma unroll
                for (int bj = 0; bj < 2; ++bj) { const f32x4 v0 = acc[ai][bj][m][0], v1 = acc[ai][bj][m][1];
                    u32x4 w; w.x = cvt_pk_bf16(v0[0], v0[1]); w.y = cvt_pk_bf16(v0[2], v0[3]); w.z = cvt_pk_bf16(v1[0], v1[1]); w.w = cvt_pk_bf16(v1[2], v1[3]);
                    *(u32x4*)(rowp + bj * HALF) = w; } }
    }
};
struct EpiResF32 {
    static constexpr bool PERM = true, AFTER_DRAIN = false;
    const float* R; float* O; int ldc;
    __device__ __forceinline__ void operator()(const f32x4 (&acc)[2][2][4][2], const Unit& u, int wr, int wc, int fr, int fq) const {
        const int row0 = u.pm * BM + wr * 64 + fr, col0 = u.pn * BM + wc * 32 + 8 * fq;
#pragma unroll
        for (int ai = 0; ai < 2; ++ai)
#pragma unroll
            for (int m = 0; m < 4; ++m) { const size_t ro = (size_t)(row0 + ai * HALF + m * 16) * ldc + col0;
#pragma unroll
                for (int bj = 0; bj < 2; ++bj) { const float* rp = R + ro + bj * HALF; float* op = O + ro + bj * HALF;
                    const f32x4 r0 = *(const f32x4*)rp, r1 = *(const f32x4*)(rp + 4);
                    *(f32x4*)op = r0 + acc[ai][bj][m][0]; *(f32x4*)(op + 4) = r1 + acc[ai][bj][m][1]; } }
    }
};
struct EpiResScaledF32 {
    static constexpr bool PERM = true, AFTER_DRAIN = false;
    float* O; int ldc; const float* cw; int cws, cwo;
    __device__ __forceinline__ void operator()(const f32x4 (&acc)[2][2][4][2], const Unit& u, int wr, int wc, int fr, int fq) const {
        const int row0 = u.pm * BM + wr * 64 + fr, col0 = u.pn * BM + wc * 32 + 8 * fq;
#pragma unroll
        for (int ai = 0; ai < 2; ++ai)
#pragma unroll
            for (int m = 0; m < 4; ++m) { const int row = row0 + ai * HALF + m * 16; const size_t ro = (size_t)row * ldc + col0; const float w = cw[(size_t)row * cws + cwo];
                if (w != 0.f) {
#pragma unroll
                for (int bj = 0; bj < 2; ++bj) { float* op = O + ro + bj * HALF;
                    const f32x4 r0 = *(const f32x4*)op, r1 = *(const f32x4*)(op + 4);
                    *(f32x4*)op = r0 + acc[ai][bj][m][0] * w; *(f32x4*)(op + 4) = r1 + acc[ai][bj][m][1] * w; } } }
    }
};
struct EpiSwiglu {
    static constexpr bool PERM = true, AFTER_DRAIN = false;
    bf16_t* H; int ldh; int npn;
    __device__ __forceinline__ void operator()(const f32x4 (&acc)[2][2][4][2], const Unit& u, int wr, int wc, int fr, int fq) const {
        const int row0 = u.pm * BM + wr * 64 + fr, col0 = (u.pn % npn) * HALF + wc * 32 + 8 * fq;
#pragma unroll
        for (int ai = 0; ai < 2; ++ai)
#pragma unroll
            for (int m = 0; m < 4; ++m) { bf16_t* rowp = H + (size_t)(row0 + ai * HALF + m * 16) * ldh + col0;
                const f32x4 g0 = acc[ai][0][m][0], g1 = acc[ai][0][m][1], u0 = acc[ai][1][m][0], u1 = acc[ai][1][m][1];
                u32x4 w; w.x = cvt_pk_bf16(silu_f(g0[0]) * u0[0], silu_f(g0[1]) * u0[1]); w.y = cvt_pk_bf16(silu_f(g0[2]) * u0[2], silu_f(g0[3]) * u0[3]);
                w.z = cvt_pk_bf16(silu_f(g1[0]) * u1[0], silu_f(g1[1]) * u1[1]); w.w = cvt_pk_bf16(silu_f(g1[2]) * u1[2], silu_f(g1[3]) * u1[3]);
                *(u32x4*)rowp = w; }
    }
};
struct EpiGlu {
    static constexpr bool PERM = true, AFTER_DRAIN = false;
    const bf16_t* HG; const float* gb; bf16_t* O; int ldo;
    __device__ __forceinline__ void operator()(const f32x4 (&acc)[2][2][4][2], const Unit& u, int wr, int wc, int fr, int fq) const {
        const int row0 = u.pm * BM + wr * 64 + fr, col0 = u.pn * BM + wc * 32 + 8 * fq;
#pragma unroll
        for (int ai = 0; ai < 2; ++ai)
#pragma unroll
            for (int m = 0; m < 4; ++m) { const int row = row0 + ai * HALF + m * 16;
#pragma unroll
                for (int bj = 0; bj < 2; ++bj) { const int col = col0 + bj * HALF;
                    const u32x4 hw = *(const u32x4*)(HG + (size_t)row * 256 + col);
                    const f32x4 b0 = *(const f32x4*)(gb + col), b1 = *(const f32x4*)(gb + col + 4);
                    const f32x4 z0 = acc[ai][bj][m][0] + b0, z1 = acc[ai][bj][m][1] + b1;
                    f32x4 o0, o1;
                    o0[0] = __builtin_bit_cast(float, hw.x << 16) * __builtin_amdgcn_rcpf(1.0f + __expf(-z0[0])); o0[1] = __builtin_bit_cast(float, hw.x & 0xffff0000u) * __builtin_amdgcn_rcpf(1.0f + __expf(-z0[1]));
                    o0[2] = __builtin_bit_cast(float, hw.y << 16) * __builtin_amdgcn_rcpf(1.0f + __expf(-z0[2])); o0[3] = __builtin_bit_cast(float, hw.y & 0xffff0000u) * __builtin_amdgcn_rcpf(1.0f + __expf(-z0[3]));
                    o1[0] = __builtin_bit_cast(float, hw.z << 16) * __builtin_amdgcn_rcpf(1.0f + __expf(-z1[0])); o1[1] = __builtin_bit_cast(float, hw.z & 0xffff0000u) * __builtin_amdgcn_rcpf(1.0f + __expf(-z1[1]));
                    o1[2] = __builtin_bit_cast(float, hw.w << 16) * __builtin_amdgcn_rcpf(1.0f + __expf(-z1[2])); o1[3] = __builtin_bit_cast(float, hw.w & 0xffff0000u) * __builtin_amdgcn_rcpf(1.0f + __expf(-z1[3]));
                    u32x4 w; w.x = cvt_pk_bf16(o0[0], o0[1]); w.y = cvt_pk_bf16(o0[2], o0[3]); w.z = cvt_pk_bf16(o1[0], o1[1]); w.w = cvt_pk_bf16(o1[2], o1[3]);
                    *(u32x4*)(O + (size_t)row * ldo + col) = w; } }
    }
};
template <bool ACC> struct EpiYBf16 {
    static constexpr bool PERM = true, AFTER_DRAIN = false;
    bf16_t* Y; int ldc; int npn;
    __device__ __forceinline__ void operator()(const f32x4 (&acc)[2][2][4][2], const Unit& u, int wr, int wc, int fr, int fq) const {
        const int row0 = u.pm * BM + wr * 64 + fr, col0 = (u.pn % npn) * BM + wc * 32 + 8 * fq;
#pragma unroll
        for (int ai = 0; ai < 2; ++ai)
#pragma unroll
            for (int m = 0; m < 4; ++m) { bf16_t* rowp = Y + (size_t)(row0 + ai * HALF + m * 16) * ldc + col0;
#pragma unroll
                for (int bj = 0; bj < 2; ++bj) { f32x4 v0 = acc[ai][bj][m][0], v1 = acc[ai][bj][m][1];
                    if (ACC) { const u32x4 o = *(const u32x4*)(rowp + bj * HALF);
                        v0[0] += __builtin_bit_cast(float, o.x << 16); v0[1] += __builtin_bit_cast(float, o.x & 0xffff0000u); v0[2] += __builtin_bit_cast(float, o.y << 16); v0[3] += __builtin_bit_cast(float, o.y & 0xffff0000u);
                        v1[0] += __builtin_bit_cast(float, o.z << 16); v1[1] += __builtin_bit_cast(float, o.z & 0xffff0000u); v1[2] += __builtin_bit_cast(float, o.w << 16); v1[3] += __builtin_bit_cast(float, o.w & 0xffff0000u); }
                    u32x4 w; w.x = cvt_pk_bf16(v0[0], v0[1]); w.y = cvt_pk_bf16(v0[2], v0[3]); w.z = cvt_pk_bf16(v1[0], v1[1]); w.w = cvt_pk_bf16(v1[2], v1[3]);
                    *(u32x4*)(rowp + bj * HALF) = w; } }
    }
};
struct MoeOrder {
    int nunits, npn, G, c; int ts[9];
    __device__ __forceinline__ bool next(int i, Unit& u) const {
        const int L = i * G + c; if (L >= nunits) return false;
        const int nig = 8 * npn, gid = L / nig, w = L - gid * nig, fm = gid * 8, nt = ts[8], gsz = (nt - fm) < 8 ? (nt - fm) : 8;
        const int pnl = w / gsz, tile = fm + (w - pnl * gsz); int e = 0;
#pragma unroll
        for (int k = 1; k < 8; ++k) e += (tile >= ts[k]) ? 1 : 0;
        u.pm = tile; u.pn = e * npn + pnl; return true;
    }
    __device__ __forceinline__ void a_ready(const Unit&) const {}
    __device__ __forceinline__ void done(const Unit&) const {}
};
struct EpiGeluBias {
    static constexpr bool PERM = true, AFTER_DRAIN = false;
    bf16_t* O; int ldc; const float* bias;
    __device__ __forceinline__ static float gelu_t(float x) { const float u = 0.7978845608028654f * (x + 0.044715f * x * x * x); const float e = __expf(2.0f * u); return x * (1.0f - __builtin_amdgcn_rcpf(e + 1.0f)); }
    __device__ __forceinline__ void operator()(const f32x4 (&acc)[2][2][4][2], const Unit& u, int wr, int wc, int fr, int fq) const {
        const int row0 = u.pm * BM + wr * 64 + fr, col0 = wc * 32 + 8 * fq;
#pragma unroll
        for (int ai = 0; ai < 2; ++ai)
#pragma unroll
            for (int m = 0; m < 4; ++m) { bf16_t* rowp = O + (size_t)(row0 + ai * HALF + m * 16) * ldc + col0;
#pragma unroll
                for (int bj = 0; bj < 2; ++bj) { const float* bp = bias + u.pn * BM + col0 + bj * HALF; const f32x4 b0 = *(const f32x4*)bp, b1 = *(const f32x4*)(bp + 4);
                    const f32x4 v0 = acc[ai][bj][m][0] + b0, v1 = acc[ai][bj][m][1] + b1;
                    u32x4 w; w.x = cvt_pk_bf16(gelu_t(v0[0]), gelu_t(v0[1])); w.y = cvt_pk_bf16(gelu_t(v0[2]), gelu_t(v0[3])); w.z = cvt_pk_bf16(gelu_t(v1[0]), gelu_t(v1[1])); w.w = cvt_pk_bf16(gelu_t(v1[2]), gelu_t(v1[3]));
                    *(u32x4*)(rowp + bj * HALF) = w; } }
    }
};
struct FirstNOrder {
    int n, c, pdiv;
    __device__ __forceinline__ bool next(int i, Unit& u) const { if (i != 0 || c >= n) return false; u.pm = c; u.pn = c / pdiv; return true; }
    __device__ __forceinline__ void a_ready(const Unit&) const {}
    __device__ __forceinline__ void done(const Unit&) const {}
};
struct EpiResF32N {
    static constexpr bool PERM = true, AFTER_DRAIN = false;
    const float* R; float* O; bf16_t* XB; float* SSQ;
    __device__ __forceinline__ void operator()(const f32x4 (&acc)[2][2][4][2], const Unit& u, int wr, int wc, int fr, int fq) const {
        const int row0 = u.pm * BM + wr * 64 + fr, col0 = u.pn * BM + wc * 32 + 8 * fq;
#pragma unroll
        for (int ai = 0; ai < 2; ++ai)
#pragma unroll
            for (int m = 0; m < 4; ++m) { const int row = row0 + ai * HALF + m * 16; const size_t ro = (size_t)row * 1024 + col0; float ss = 0.f;
#pragma unroll
                for (int bj = 0; bj < 2; ++bj) { const float* rp = R + ro + bj * HALF; float* op = O + ro + bj * HALF;
                    const f32x4 v0 = *(const f32x4*)rp + acc[ai][bj][m][0], v1 = *(const f32x4*)(rp + 4) + acc[ai][bj][m][1];
                    *(f32x4*)op = v0; *(f32x4*)(op + 4) = v1;
                    ss += (v0[0] * v0[0] + v0[1] * v0[1]) + (v0[2] * v0[2] + v0[3] * v0[3]) + (v1[0] * v1[0] + v1[1] * v1[1]) + (v1[2] * v1[2] + v1[3] * v1[3]);
                    u32x4 w; w.x = cvt_pk_bf16(v0[0], v0[1]); w.y = cvt_pk_bf16(v0[2], v0[3]); w.z = cvt_pk_bf16(v1[0], v1[1]); w.w = cvt_pk_bf16(v1[2], v1[3]);
                    *(u32x4*)(XB + ro + bj * HALF) = w; }
                ss += __shfl_xor(ss, 16); ss += __shfl_xor(ss, 32);
                if (fq == 0) SSQ[(size_t)row * 16 + 4 * u.pn + wc] = ss; }
    }
};
__device__ __forceinline__ float row_rstd16(const float* SSQ, int row) {
    const f32x4* p = (const f32x4*)(SSQ + (size_t)row * 16); const f32x4 a = p[0], b = p[1], c = p[2], d = p[3];
    const float s = ((a[0] + a[1]) + (a[2] + a[3])) + ((b[0] + b[1]) + (b[2] + b[3])) + ((c[0] + c[1]) + (c[2] + c[3])) + ((d[0] + d[1]) + (d[2] + d[3]));
    return __builtin_amdgcn_rsqf(s * (1.0f / 1024.0f) + 1e-6f);
}
struct EpiStoreBf16N {
    static constexpr bool PERM = true, AFTER_DRAIN = false;
    bf16_t* O; int ldc; const float* SSQ;
    __device__ __forceinline__ void operator()(const f32x4 (&acc)[2][2][4][2], const Unit& u, int wr, int wc, int fr, int fq) const {
        const int row0 = u.pm * BM + wr * 64 + fr, col0 = u.pn * BM + wc * 32 + 8 * fq;
#pragma unroll
        for (int ai = 0; ai < 2; ++ai)
#pragma unroll
            for (int m = 0; m < 4; ++m) { const int row = row0 + ai * HALF + m * 16; const float rs = row_rstd16(SSQ, row); bf16_t* rowp = O + (size_t)row * ldc + col0;
#pragma unroll
                for (int bj = 0; bj < 2; ++bj) { const f32x4 v0 = acc[ai][bj][m][0] * rs, v1 = acc[ai][bj][m][1] * rs;
                    u32x4 w; w.x = cvt_pk_bf16(v0[0], v0[1]); w.y = cvt_pk_bf16(v0[2], v0[3]); w.z = cvt_pk_bf16(v1[0], v1[1]); w.w = cvt_pk_bf16(v1[2], v1[3]);
                    *(u32x4*)(rowp + bj * HALF) = w; } }
    }
};
struct EpiSwigluN {
    static constexpr bool PERM = true, AFTER_DRAIN = false;
    bf16_t* H; int ldh; int npn; const float* SSQ;
    __device__ __forceinline__ void operator()(const f32x4 (&acc)[2][2][4][2], const Unit& u, int wr, int wc, int fr, int fq) const {
        const int row0 = u.pm * BM + wr * 64 + fr, col0 = (u.pn % npn) * HALF + wc * 32 + 8 * fq;
#pragma unroll
        for (int ai = 0; ai < 2; ++ai)
#pragma unroll
            for (int m = 0; m < 4; ++m) { const int row = row0 + ai * HALF + m * 16; const float rs = row_rstd16(SSQ, row); bf16_t* rowp = H + (size_t)row * ldh + col0;
                const f32x4 g0 = acc[ai][0][m][0] * rs, g1 = acc[ai][0][m][1] * rs, u0 = acc[ai][1][m][0] * rs, u1 = acc[ai][1][m][1] * rs;
                u32x4 w; w.x = cvt_pk_bf16(silu_f(g0[0]) * u0[0], silu_f(g0[1]) * u0[1]); w.y = cvt_pk_bf16(silu_f(g0[2]) * u0[2], silu_f(g0[3]) * u0[3]);
                w.z = cvt_pk_bf16(silu_f(g1[0]) * u1[0], silu_f(g1[1]) * u1[1]); w.w = cvt_pk_bf16(silu_f(g1[2]) * u1[2], silu_f(g1[3]) * u1[3]);
                *(u32x4*)rowp = w; }
    }
};
template <class Epi, class Sched, bool ALIGN_EPI = false, bool SP2 = false, bool GATHER = false>
__device__ __forceinline__ void gemm_phase(PG8_LAS unsigned char* lds, const Gemm g, const Sched& S, const Epi& E, const PG8_LAS unsigned short* gidx = nullptr, int wave0 = -1) {
    int tid_ = (wave0 >= 0) ? (wave0 * 64 + (int)__builtin_amdgcn_mbcnt_hi(~0u, __builtin_amdgcn_mbcnt_lo(~0u, 0u))) : (int)threadIdx.x; asm volatile("" : "+v"(tid_));
    const int tid = tid_, wid = __builtin_amdgcn_readfirstlane(tid >> 6), lane = tid & 63, wr = wid >> 2, wc = wid & 3, fr = lane & 15, fq = lane >> 4;
    const int K = g.K, nt = K / BK;
    unsigned voffA[2], voffB[2]; int RA[2], CA[2]; unsigned voffG[2][2], voffN[2][2];
#pragma unroll
    for (int i = 0; i < 2; ++i) { int R, C; stage_rc(tid * 16 + i * 8192, R, C); const int Rb = Epi::PERM ? ((R & ~31) + perm32(R & 31)) : R; RA[i] = R; CA[i] = C;
        voffA[i] = (unsigned)(R * K + C) * 2u; voffB[i] = (unsigned)(Rb * K + C) * 2u; }
#define PG8_GIDX(dst, ui_) do { _Pragma("unroll") for (int _h = 0; _h < 2; ++_h) _Pragma("unroll") for (int _i = 0; _i < 2; ++_i) \
        { const unsigned _t = gidx[(ui_) * 256 + _h * 128 + RA[_i]]; dst[_h][_i] = ((_t & 0x7fffu) * (unsigned)g.lda + (_t >> 15) * (unsigned)g.hiofs + (unsigned)CA[_i]) * 2u; } } while (0)
    if constexpr (GATHER) { PG8_GIDX(voffG, 0); PG8_GIDX(voffN, 0); }
    (void)RA; (void)CA; (void)voffG; (void)voffN; (void)voffA;
    const size_t kstep = (size_t)(BK * 2);
    const size_t kstepA = GATHER ? (size_t)g.kstepA : kstep;
    const size_t hstep = (size_t)HALF * K * 2;
    const size_t tstep = 2 * hstep;
    const unsigned ldsw = (unsigned)wid * 1024u;
    const int aoff = lds_byte(wr * 64 + fr, fq * 8), boff = lds_byte(wc * 32 + fr, fq * 8);
#define PG8_SA(b, h) (((b) * 2 + (h)) * HTB)
#define PG8_SB(b, h) ((4 + (b) * 2 + (h)) * HTB)
#define PG8_STAGE(bufoff, gbase, voff) do { _Pragma("unroll") for (int _i = 0; _i < 2; ++_i) \
        __builtin_amdgcn_global_load_lds((const unsigned*)((const char*)(gbase) + (voff)[_i]), (PG8_LAS unsigned*)(lds + (bufoff) + ldsw + _i * 8192), 16, 0, 0); } while (0)
#define PG8_STAGE_A(bufoff, aptr, hh, nx) do { if constexpr (GATHER) { _Pragma("unroll") for (int _i = 0; _i < 2; ++_i) { const unsigned _vo = (nx) ? voffN[hh][_i] : voffG[hh][_i]; \
        __builtin_amdgcn_global_load_lds((const unsigned*)((const char*)(aptr) + _vo), (PG8_LAS unsigned*)(lds + (bufoff) + ldsw + _i * 8192), 16, 0, 0); } } \
        else { PG8_STAGE(bufoff, (aptr) + ((hh) ? hstep : 0), voffA); } } while (0)
#define PG8_LDA(dst, b, h) do { _Pragma("unroll") for (int m = 0; m < 4; ++m) _Pragma("unroll") for (int k = 0; k < 2; ++k) dst[m][k] = *(const PG8_LAS bf16x8*)(lds + PG8_SA(b, h) + aoff + m * 2048 + k * 1024); } while (0)
#define PG8_LDB(dst, b, h) do { _Pragma("unroll") for (int n = 0; n < 2; ++n) _Pragma("unroll") for (int k = 0; k < 2; ++k) dst[n][k] = *(const PG8_LAS bf16x8*)(lds + PG8_SB(b, h) + boff + n * 2048 + k * 1024); } while (0)
#define PG8_MMA(ai, bj, At, Bt) do { __builtin_amdgcn_s_setprio(1); _Pragma("unroll") for (int m = 0; m < 4; ++m) _Pragma("unroll") for (int n = 0; n < 2; ++n) _Pragma("unroll") for (int k = 0; k < 2; ++k) \
        acc[ai][bj][m][n] = __builtin_amdgcn_mfma_f32_16x16x32_bf16(Bt[n][k], At[m][k], acc[ai][bj][m][n], 0, 0, 0); __builtin_amdgcn_s_setprio(0); } while (0)
#define PG8_WAIT_V(n) asm volatile("s_waitcnt vmcnt(" #n ")" ::: "memory")
#define PG8_WAIT_L(n) asm volatile("s_waitcnt lgkmcnt(" #n ")" ::: "memory")
#define PG8_BAR __builtin_amdgcn_s_barrier()
#define PG8_SCHED __builtin_amdgcn_sched_barrier(0)
    Unit cur, nxt; int ui = 0;
    if (!S.next(0, cur)) return;
    f32x4 acc[2][2][4][2];
#pragma unroll
    for (int a = 0; a < 2; ++a)
#pragma unroll
        for (int b = 0; b < 2; ++b)
#pragma unroll
            for (int m = 0; m < 4; ++m)
#pragma unroll
                for (int n = 0; n < 2; ++n) acc[a][b][m][n] = (f32x4){0.f, 0.f, 0.f, 0.f};
    bf16x8 At[4][2], B0[2][2], B1[2][2];
    const char* cA = (const char*)g.A + (GATHER ? (size_t)0 : (size_t)cur.pm * tstep); const char* cB = (const char*)g.Bt + (size_t)cur.pn * tstep;
    S.a_ready(cur);
    if constexpr (SP2) {
        PG8_STAGE(PG8_SB(0, 0), cB, voffB); PG8_STAGE(PG8_SB(0, 1), cB + hstep, voffB); PG8_STAGE_A(PG8_SA(0, 0), cA, 0, false); PG8_STAGE_A(PG8_SA(0, 1), cA, 1, false);
        if (wr == 1) PG8_BAR;
        PG8_WAIT_V(2); PG8_BAR;
        PG8_STAGE(PG8_SB(1, 0), cB + kstep, voffB); PG8_STAGE_A(PG8_SA(1, 0), cA + kstepA, 0, false); PG8_STAGE(PG8_SB(1, 1), cB + hstep + kstep, voffB);
        PG8_WAIT_V(6); PG8_BAR;
    } else {
        PG8_STAGE(PG8_SB(0, 0), cB, voffB); PG8_STAGE(PG8_SA(0, 0), cA, voffA); PG8_STAGE(PG8_SB(0, 1), cB + hstep, voffB); PG8_STAGE(PG8_SA(0, 1), cA + hstep, voffA);
        if (wr == 1) PG8_BAR;
        PG8_WAIT_V(4); PG8_BAR;
        PG8_STAGE(PG8_SB(1, 0), cB + kstep, voffB); PG8_STAGE(PG8_SA(1, 0), cA + kstep, voffA); PG8_STAGE(PG8_SB(1, 1), cB + hstep + kstep, voffB);
        PG8_WAIT_V(6); PG8_BAR;
    }
    for (;;) {
        const bool has_next = S.next(ui + 1, nxt);
        const char* nA = (has_next && !GATHER) ? (const char*)g.A + (size_t)nxt.pm * tstep : cA; const char* nB = has_next ? (const char*)g.Bt + (size_t)nxt.pn * tstep : cB;
        if constexpr (GATHER) { if (has_next) PG8_GIDX(voffN, ui + 1); }
        for (int t = 0; t < nt; t += 2) {
            const bool last = (t == nt - 2);
            const char* a1 = cA + (size_t)(t + 1) * kstepA;
            const char* a2 = last ? nA : cA + (size_t)(t + 2) * kstepA; const char* b2 = last ? nB : cB + (size_t)(t + 2) * kstep;
            const char* a3 = a2 + kstepA; const char* b3 = b2 + kstep;
            if (last && has_next) S.a_ready(nxt);
            if constexpr (SP2) {
            const bool nx = last && has_next;
            PG8_LDB(B0, 0, 0); PG8_LDB(B1, 0, 1); PG8_SCHED; PG8_LDA(At, 0, 0); PG8_STAGE_A(PG8_SA(1, 1), a1, 1, false);
            PG8_WAIT_V(8); PG8_WAIT_L(0); PG8_BAR; PG8_MMA(0, 0, At, B0); PG8_MMA(0, 1, At, B1); PG8_BAR; PG8_SCHED;
            PG8_LDA(At, 0, 1); PG8_STAGE(PG8_SB(0, 0), b2, voffB); PG8_STAGE(PG8_SB(0, 1), b2 + hstep, voffB); PG8_STAGE_A(PG8_SA(0, 0), a2, 0, nx);
            PG8_WAIT_V(8); PG8_WAIT_L(0); PG8_BAR; PG8_MMA(1, 0, At, B0); PG8_MMA(1, 1, At, B1); PG8_BAR; PG8_SCHED;
            PG8_LDB(B0, 1, 0); PG8_LDB(B1, 1, 1); PG8_SCHED; PG8_LDA(At, 1, 0); PG8_STAGE_A(PG8_SA(0, 1), a2, 1, nx);
            PG8_WAIT_V(8); PG8_WAIT_L(0); PG8_BAR; PG8_MMA(0, 0, At, B0); PG8_MMA(0, 1, At, B1); PG8_BAR; PG8_SCHED;
            PG8_LDA(At, 1, 1); PG8_STAGE(PG8_SB(1, 0), b3, voffB); PG8_STAGE(PG8_SB(1, 1), b3 + hstep, voffB); PG8_STAGE_A(PG8_SA(1, 0), a3, 0, nx);
            PG8_WAIT_V(8); PG8_WAIT_L(0); PG8_BAR; PG8_MMA(1, 0, At, B0); PG8_MMA(1, 1, At, B1); PG8_BAR; PG8_SCHED;
            } else {
            static_assert(SP2 || !GATHER, "GATHER is implemented for the SP2 loop only");
            PG8_LDB(B0, 0, 0); PG8_SCHED; PG8_LDA(At, 0, 0); PG8_STAGE(PG8_SA(1, 1), a1 + hstep, voffA);
            PG8_WAIT_L(8); PG8_BAR; PG8_WAIT_L(0); PG8_MMA(0, 0, At, B0); PG8_BAR; PG8_SCHED;
            PG8_LDB(B1, 0, 1); PG8_STAGE(PG8_SB(0, 0), b2, voffB);
            PG8_BAR; PG8_WAIT_L(0); PG8_MMA(0, 1, At, B1); PG8_BAR;
            PG8_LDA(At, 0, 1); PG8_STAGE(PG8_SA(0, 0), a2, voffA);
            PG8_BAR; PG8_WAIT_L(0); PG8_MMA(1, 0, At, B0); PG8_BAR; PG8_SCHED;
            PG8_STAGE(PG8_SB(0, 1), b2 + hstep, voffB);
            PG8_WAIT_V(6); PG8_BAR; PG8_MMA(1, 1, At, B1); PG8_BAR;
            PG8_LDB(B0, 1, 0); PG8_SCHED; PG8_LDA(At, 1, 0); PG8_STAGE(PG8_SA(0, 1), a2 + hstep, voffA);
            PG8_WAIT_L(8); PG8_BAR; PG8_WAIT_L(0); PG8_MMA(0, 0, At, B0); PG8_BAR; PG8_SCHED;
            PG8_LDB(B1, 1, 1); PG8_STAGE(PG8_SB(1, 0), b3, voffB);
            PG8_BAR; PG8_WAIT_L(0); PG8_MMA(0, 1, At, B1); PG8_BAR;
            PG8_LDA(At, 1, 1); PG8_STAGE(PG8_SA(1, 0), a3, voffA);
            PG8_BAR; PG8_WAIT_L(0); PG8_MMA(1, 0, At, B0); PG8_BAR; PG8_SCHED;
            PG8_STAGE(PG8_SB(1, 1), b3 + hstep, voffB);
            PG8_WAIT_V(6); PG8_BAR; PG8_MMA(1, 1, At, B1); PG8_BAR;
            }
        }
        if constexpr (ALIGN_EPI) { if (wr == 0) PG8_BAR; }
        if constexpr (!Epi::AFTER_DRAIN) { E(acc, cur, wr, wc, fr, fq); S.done(cur); }
        if (!has_next) break;
#pragma unroll
        for (int a = 0; a < 2; ++a)
#pragma unroll
            for (int b = 0; b < 2; ++b)
#pragma unroll
                for (int m = 0; m < 4; ++m)
#pragma unroll
                    for (int n = 0; n < 2; ++n) acc[a][b][m][n] = (f32x4){0.f, 0.f, 0.f, 0.f};
        cur = nxt; cA = nA; cB = nB; ++ui;
        if constexpr (GATHER) {
#pragma unroll
            for (int _h = 0; _h < 2; ++_h)
#pragma unroll
                for (int _i = 0; _i < 2; ++_i) voffG[_h][_i] = voffN[_h][_i]; }
        if constexpr (ALIGN_EPI) { if (wr == 1) PG8_BAR; }
    }
    PG8_WAIT_V(0);
    if constexpr (!ALIGN_EPI) { if (wr == 0) PG8_BAR; }
    PG8_BAR;
    if constexpr (Epi::AFTER_DRAIN) { E.fused(acc, cur, wr, wc, fr, fq, lds, wid, lane); S.done(cur); }
#undef PG8_SA
#undef PG8_SB
#undef PG8_STAGE
#undef PG8_STAGE_A
#undef PG8_GIDX
#undef PG8_LDA
#undef PG8_LDB
#undef PG8_MMA
#undef PG8_WAIT_V
#undef PG8_WAIT_L
#undef PG8_BAR
#undef PG8_SCHED
}
}

#define GAS __attribute__((address_space(1)))
#define LAS __attribute__((address_space(3)))
typedef unsigned short bf16;
typedef unsigned v4u __attribute__((ext_vector_type(4)));
typedef unsigned v2u __attribute__((ext_vector_type(2)));
typedef float f32x4 __attribute__((ext_vector_type(4)));
typedef short bf16x8 __attribute__((ext_vector_type(8)));
typedef GAS unsigned gu32;
#define RLX_AGENT __ATOMIC_RELAXED, __HIP_MEMORY_SCOPE_AGENT
#define LDS_WAIT() asm volatile("s_waitcnt lgkmcnt(0)" ::: "memory")
#define VM_WAIT() asm volatile("s_waitcnt vmcnt(0)" ::: "memory")
__device__ __forceinline__ unsigned f2bf(float f) { unsigned u = __builtin_bit_cast(unsigned, f); return (u + 0x7fffu + ((u >> 16) & 1u)) >> 16; }
__device__ __forceinline__ unsigned pk2(float lo, float hi) { return pg8::cvt_pk_bf16(lo, hi); }
__device__ __forceinline__ float bf2f(unsigned short v) { return __builtin_bit_cast(float, (unsigned)v << 16); }
__device__ __forceinline__ float bflo(unsigned w) { return __builtin_bit_cast(float, w << 16); }
__device__ __forceinline__ float bfhi(unsigned w) { return __builtin_bit_cast(float, w & 0xffff0000u); }
__device__ __forceinline__ float wave_sum(float v) {
#pragma unroll
    for (int o = 1; o < 64; o <<= 1) v += __shfl_xor(v, o);
    return v;
}
__device__ __forceinline__ float wave_max(float v) {
#pragma unroll
    for (int o = 1; o < 64; o <<= 1) v = fmaxf(v, __shfl_xor(v, o));
    return v;
}
__device__ __forceinline__ float gelu_tanh(float x) { const float u = 0.7978845608028654f * (x + 0.044715f * x * x * x); return 0.5f * x * (1.0f + tanhf(u)); }
__device__ __forceinline__ float sigmoid_f(float x) { return 1.0f / (1.0f + __expf(-x)); }
__device__ __forceinline__ float log_sigmoid_f(float x) { return fminf(x, 0.f) - log1pf(__expf(-fabsf(x))); }

template <int D> __device__ __forceinline__ float dpp_row_shr(float v) { return __builtin_bit_cast(float, __builtin_amdgcn_update_dpp(0, __builtin_bit_cast(int, v), 0x110 + D, 0xf, 0xf, true)); }
__device__ __forceinline__ float dpp_xor1(float v) { return __builtin_bit_cast(float, __builtin_amdgcn_update_dpp(0, __builtin_bit_cast(int, v), 0xB1, 0xf, 0xf, true)); }
__device__ __forceinline__ float dpp_xor2(float v) { return __builtin_bit_cast(float, __builtin_amdgcn_update_dpp(0, __builtin_bit_cast(int, v), 0x4E, 0xf, 0xf, true)); }
#define XB_TMO      128
#define XB_XCNT(j)  (256  + 64 * (j))
#define XB_XSUB(j)  (1280 + 64 * (j))
#define XB_XGEN(j)  (2304 + 64 * (j))
#define XB_TOP      3328
#define XB_TOPGEN   3392
#define XCD_BAR_WORDS 3456
#define XB_SPIN_CAP (1u << 18)

__device__ __forceinline__ unsigned xb_ld(unsigned* p)              { return __hip_atomic_load(p, __ATOMIC_RELAXED, __HIP_MEMORY_SCOPE_AGENT); }
__device__ __forceinline__ unsigned xb_add(unsigned* p, unsigned v) { return __hip_atomic_fetch_add(p, v, __ATOMIC_RELAXED, __HIP_MEMORY_SCOPE_AGENT); }
__device__ __forceinline__ unsigned xb_xcc_id() { return (unsigned)__builtin_amdgcn_s_getreg((3 << 11) | 20) & 0xFu; }
#define XB_SPIN(cond, bar) do { unsigned _sp = 0; while (cond) { __builtin_amdgcn_s_sleep(1); \
    if ((++_sp & 255u) == 0u) { if (xb_ld(&(bar)[XB_TMO])) break; if (_sp > XB_SPIN_CAP) { atomicAdd(&(bar)[XB_TMO], 1u); break; } } } } while (0)

struct XcdBarrier {
    unsigned* bar; unsigned x;
    volatile LAS unsigned* st;
};

__device__ __forceinline__ XcdBarrier xcd_barrier_post(unsigned* bar, volatile LAS unsigned* st) {
    XcdBarrier b; b.bar = bar; b.x = xb_xcc_id(); b.st = st;
    if (threadIdx.x == 0) (void)xb_add(&bar[XB_XCNT(b.x)], 1u);
    return b;
}
__device__ __forceinline__ void xcd_barrier_complete(unsigned* bar, unsigned x, unsigned& nloc, unsigned& nx) {
    const unsigned G = gridDim.x * gridDim.y * gridDim.z;
    unsigned sum, cnt, mine, sp = 0u;
    for (;;) {
        sum = 0u; cnt = 0u; mine = 0u;
#pragma unroll
        for (unsigned j = 0; j < 16; ++j) { const unsigned c = xb_ld(&bar[XB_XCNT(j)]); sum += c; cnt += (c > 0u) ? 1u : 0u; mine = (j == x) ? c : mine; }
        if (sum == G) break;
        __builtin_amdgcn_s_sleep(1);
        if ((++sp & 255u) == 0u) { if (xb_ld(&bar[XB_TMO])) break; if (sp > XB_SPIN_CAP) { atomicAdd(&bar[XB_TMO], 1u); break; } }
    }
    nloc = mine > 0u ? mine : 1u; nx = cnt > 0u ? cnt : 1u;
}

__device__ __forceinline__ void xcd_barrier(const XcdBarrier& b) {
    asm volatile("s_waitcnt vmcnt(0)" ::: "memory");
    __syncthreads();
    if (threadIdx.x == 0) {
        unsigned* bar = b.bar;
        __builtin_amdgcn_s_waitcnt(0);
        unsigned nloc = b.st[0], nx = b.st[1];
        if (nloc == 0u) { xcd_barrier_complete(bar, b.x, nloc, nx); b.st[0] = nloc; b.st[1] = nx; }
        const unsigned old = xb_add(&bar[XB_XSUB(b.x)], 1u);
        const unsigned gen = old / nloc;
        if (old + 1u == (gen + 1u) * nloc) {
            __builtin_amdgcn_fence(__ATOMIC_RELEASE, "agent");
            asm volatile("s_waitcnt vmcnt(0)" ::: "memory");
            const unsigned og = xb_add(&bar[XB_TOP], 1u);
            const unsigned tg = og / nx;
            if (og + 1u == (tg + 1u) * nx) xb_add(&bar[XB_TOPGEN], 1u);
            else XB_SPIN(xb_ld(&bar[XB_TOPGEN]) == tg, bar);
            __builtin_amdgcn_fence(__ATOMIC_ACQUIRE, "agent");
            xb_add(&bar[XB_XGEN(b.x)], 1u);
            asm volatile("s_waitcnt vmcnt(0)" ::: "memory");
        } else {
            XB_SPIN(xb_ld(&bar[XB_XGEN(b.x)]) == gen, bar);
            __builtin_amdgcn_fence(__ATOMIC_ACQUIRE, "agent");
            asm volatile("s_waitcnt vmcnt(0)" ::: "memory");
        }
    }
    __syncthreads();
}


constexpr int NB = 8, SQ = 4096, NT = NB * SQ, DM = 1024;
constexpr int PW = 2560;
constexpr int P_DQ = 0, P_DK = 256, P_DV = 512, P_NQ = 768, P_KC = 1024, P_VC = 1088, P_KS = 1152, P_VS = 1216, P_KW = 1280, P_VW = 1344,
              P_GQ = 1408, P_GK = 1536, P_GV = 1664, P_GR = 1920, P_SU = 2176, P_GA = 2432, P_NG = 2448;
constexpr int PROJ_SRC = 2460;
constexpr int DFF = 2752, DFFP = 2816, DFE = 3584, NEXP = 8;
constexpr int NCMP = 255, NCMPP = 256;
__host__ __device__ __forceinline__ int inproj_src_col(int n) {
    if (n < 1408) return n;
    if (n < 1920) return n + 12;
    if (n < 2432) return n + 28;
    if (n < 2448) return n - 500;
    if (n < 2460) return n - 1040;
    return -1;
}
constexpr size_t MiB = 1u << 20;
constexpr size_t WS_CTL = 0, CTL_ZERO_BYTES = 1 * MiB;
constexpr size_t WS_WIN = 2 * MiB;
constexpr size_t WS_WOUT = 12 * MiB;
constexpr size_t WS_WFGU = 16 * MiB;
constexpr size_t WS_WFDN = 27 * MiB;
constexpr size_t WS_KC = 33 * MiB;
constexpr size_t WS_VC = WS_KC + 512 * 1024;
constexpr size_t WS_SEL = 34 * MiB;
constexpr size_t WS_CW = 34 * MiB + 512 * 1024;
constexpr size_t WS_HN = 36 * MiB;
constexpr size_t WS_PROJ = 100 * MiB;
constexpr size_t WS_MIXRAW = 260 * MiB;
constexpr size_t WS_GA = 388 * MiB;
constexpr size_t WS_GLAS = 404 * MiB;
constexpr size_t WS_OS = 420 * MiB, WS_OW = 452 * MiB;
constexpr size_t WS_HG = 484 * MiB;
constexpr size_t WS_S5X = 500 * MiB;
constexpr size_t WS_GLAD = 504 * MiB;
constexpr size_t WS_XB = 324 * MiB;
constexpr size_t WS_DO1 = 324 * MiB;
constexpr size_t WS_DL1 = 356 * MiB;
constexpr size_t WS_SSQ = 513 * MiB;
constexpr size_t WS_W2T = 34 * MiB + 256 * 1024;
constexpr size_t WS_S5TAB = 33 * MiB;
constexpr size_t WS_WGLU = 35 * MiB + 512 * 1024;
constexpr size_t WS_W1CT = 505 * MiB;
constexpr size_t WS_BIASP = 509 * MiB;
constexpr size_t WS_CHID = 510 * MiB;
constexpr size_t WS_KCB = 512 * MiB;
constexpr size_t WS_VCB = 512 * MiB + 256 * 1024;
constexpr size_t WS_FH = 100 * MiB;
constexpr size_t WS_WEGU = 100 * MiB;
constexpr size_t WS_WEDN = 114 * MiB;
constexpr size_t WS_EH = 128 * MiB;
constexpr int MOE_ROWS = 2 * NT + 8 * 256, MOE_HH = DFE / 2, MOE_NPN = MOE_HH / 128;
constexpr size_t WS_MTAB = 1 * MiB;
constexpr size_t WS_WCNT = 1 * MiB + 4096;
constexpr size_t WS_TOKINFO = 1 * MiB + 128 * 1024;
constexpr size_t WS_TOPW = 1 * MiB + 256 * 1024;
constexpr size_t WS_TOKPOS = 1 * MiB + 512 * 1024;
constexpr size_t WS_ROWTOK = 1 * MiB + 768 * 1024;
constexpr size_t WS_W2H = 3 * MiB;
constexpr size_t WS_W1H = 100 * MiB;
constexpr size_t WS_MHID = 156 * MiB;
constexpr size_t WS_MY = 387 * MiB;
constexpr size_t WS_END = 519 * MiB;
constexpr int GIDX_OFF = 131072 + 1024;
constexpr int CW_BAR = 4096, CW_TAIL = 8192;
constexpr int RING_OFF = 0, RING_BYTES = 131072;
constexpr int LDSCTL_OFF = RING_BYTES, MISC_OFF = LDSCTL_OFF + 320;
constexpr int LDS_BYTES = 147456;
constexpr int NWAVES = 8;

struct ConvJob { const float* src0; const float* src1; bf16* dst; int ld, Ksrc, Nsrc, Nd, Kd, mode, pad; const float* kscale = nullptr; };
__device__ __forceinline__ void conv_item(const ConvJob& J, LAS float* scr, int item, int lane) {
    const int nblk = J.Nd / 32, kb = item / nblk, nb = item % nblk, k0 = 64 * kb, n0 = 32 * nb;
    const int n = n0 + (lane & 31);
    const float* sp = nullptr;
    if (J.mode == 0) { if (n < J.Nsrc) sp = J.src0 + n; }
    else if (J.mode == 1) { const int c = inproj_src_col(n); if (c >= 0) sp = J.src0 + c; }
    else { const int pn = n >> 8, s = (n >> 7) & 1, j = J.pad + 128 * pn + (n & 127); const long long d01 = (const char*)J.src1 - (const char*)J.src0;
           if (j < J.Nsrc) sp = (const float*)((const char*)J.src0 + (s ? d01 : 0ll)) + j; }
#pragma unroll 8
    for (int i = 0; i < 32; ++i) { const int kk = 2 * i + (lane >> 5); float v = 0.f; if (sp && (k0 + kk) < J.Ksrc) { v = sp[(size_t)(k0 + kk) * J.ld]; if (J.kscale) v *= J.kscale[k0 + kk]; } scr[kk * 33 + (lane & 31)] = v; }
    LDS_WAIT(); asm volatile("" ::: "memory");
    const int c = lane & 7;
#pragma unroll
    for (int j = 0; j < 4; ++j) { const int nn = (lane >> 3) + 8 * j; const LAS float* s = scr + (8 * c) * 33 + nn;
        v4u o; o.x = pk2(s[0 * 33], s[1 * 33]); o.y = pk2(s[2 * 33], s[3 * 33]); o.z = pk2(s[4 * 33], s[5 * 33]); o.w = pk2(s[6 * 33], s[7 * 33]);
        *(GAS v4u*)(J.dst + (size_t)(n0 + nn) * J.Kd + k0 + 8 * c) = o; }
    LDS_WAIT(); asm volatile("" ::: "memory");
}
__device__ __forceinline__ void conv_run(const ConvJob& J, LAS float* scr, int gw, int ngw, int lane) {
    const int nitems = (J.Kd / 64) * (J.Nd / 32);
    for (int it = gw; it < nitems; it += ngw) conv_item(J, scr, it, lane);
}
__device__ __forceinline__ void conv_fast_item(const ConvJob& J, int item, int lane) {
    const int nblk = J.Nd / 256, kb = item / nblk, nb = item - kb * nblk, k0 = 32 * kb, n = 256 * nb + 4 * lane;
    const float* sp = nullptr;
    if (J.mode == 0) { if (n < J.Nsrc) sp = J.src0 + n; }
    else { const int pn = n >> 8, s = (n >> 7) & 1, j = J.pad + 128 * pn + (n & 127); const long long d01 = (const char*)J.src1 - (const char*)J.src0;
           if (j < J.Nsrc) sp = (const float*)((const char*)J.src0 + (s ? d01 : 0ll)) + j; }
    const bool live = (sp != nullptr) && (k0 < J.Ksrc);
    f32x4 v[32];
#pragma unroll
    for (int i = 0; i < 32; ++i) v[i] = live ? *(const f32x4*)(sp + (size_t)(k0 + i) * J.ld) : (f32x4){0.f, 0.f, 0.f, 0.f};
    if (J.kscale && live) {
#pragma unroll
        for (int i = 0; i < 32; ++i) v[i] = v[i] * J.kscale[k0 + i]; }
#pragma unroll
    for (int j = 0; j < 4; ++j) { bf16* dp = J.dst + (size_t)(n + j) * J.Kd + k0;
#pragma unroll
        for (int q = 0; q < 4; ++q) { v4u o; o.x = pk2(v[8 * q][j], v[8 * q + 1][j]); o.y = pk2(v[8 * q + 2][j], v[8 * q + 3][j]); o.z = pk2(v[8 * q + 4][j], v[8 * q + 5][j]); o.w = pk2(v[8 * q + 6][j], v[8 * q + 7][j]);
            *(GAS v4u*)(dp + 8 * q) = o; } }
}
__device__ __forceinline__ void conv_fast(const ConvJob& J, int gw, int ngw, int lane) {
    const int nitems = (J.Kd / 32) * (J.Nd / 256);
    for (int it = gw; it < nitems; it += ngw) conv_fast_item(J, it, lane);
}

template <bool ROUTER>
__device__ __forceinline__ void k_norm(int row, int lane, const float* __restrict__ x, const float* __restrict__ g, bf16* __restrict__ out,
                                              const float* __restrict__ rw, const float* __restrict__ rb, float* __restrict__ cw) {
    const f32x4* xr = (const f32x4*)(x + (size_t)row * DM) + lane;
    f32x4 v[4]; float s = 0.f;
#pragma unroll
    for (int j = 0; j < 4; ++j) { v[j] = xr[64 * j]; s += (v[j].x * v[j].x + v[j].y * v[j].y) + (v[j].z * v[j].z + v[j].w * v[j].w); }
    s = wave_sum(s);
    const float rstd = rsqrtf(s * (1.0f / DM) + 1e-6f);
    const f32x4* gr = (const f32x4*)g + lane;
    v2u* o8 = (v2u*)(out + (size_t)row * DM) + lane;
#pragma unroll
    for (int j = 0; j < 4; ++j) { const f32x4 gv = gr[64 * j]; v[j] = v[j] * rstd * gv; v2u o; o.x = pk2(v[j].x, v[j].y); o.y = pk2(v[j].z, v[j].w); o8[64 * j] = o; }
    if (ROUTER) {
        float lg[8];
#pragma unroll
        for (int e = 0; e < 8; ++e) lg[e] = 0.f;
#pragma unroll
        for (int j = 0; j < 4; ++j)
#pragma unroll
            for (int i = 0; i < 4; ++i) { const int c = 4 * lane + 256 * j + i; const f32x4 w0 = *(const f32x4*)(rw + (size_t)c * 8), w1 = *(const f32x4*)(rw + (size_t)c * 8 + 4); const float h = v[j][i];
                lg[0] += h * w0.x; lg[1] += h * w0.y; lg[2] += h * w0.z; lg[3] += h * w0.w; lg[4] += h * w1.x; lg[5] += h * w1.y; lg[6] += h * w1.z; lg[7] += h * w1.w; }
#pragma unroll
        for (int e = 0; e < 8; ++e) lg[e] = wave_sum(lg[e]) + rb[e];
        int i1 = 0; float v1 = lg[0];
#pragma unroll
        for (int e = 1; e < 8; ++e) if (lg[e] > v1) { v1 = lg[e]; i1 = e; }
        int i2 = -1; float v2 = -3.0e38f;
#pragma unroll
        for (int e = 0; e < 8; ++e) if (e != i1 && lg[e] > v2) { v2 = lg[e]; i2 = e; }
        const float e2 = __expf(v2 - v1), w1 = 1.0f / (1.0f + e2), w2 = e2 * w1;
        if (lane < 8) cw[(size_t)row * 8 + lane] = (lane == i1) ? w1 : ((lane == i2) ? w2 : 0.f);
    }
}

__device__ __forceinline__ void k_headnorm(int row, int lane, bf16* __restrict__ proj, const float* __restrict__ dil_g  , const float* __restrict__ nsa_g  ) {
    bf16* pr = proj + (size_t)row * PW;
#pragma unroll 1
    for (int i = 0; i < 14; ++i) {
        int off; const float* g;
        if (i < 4) { off = P_DQ + 64 * i; g = dil_g; } else if (i < 8) { off = P_DK + 64 * (i - 4); g = dil_g + 64; } else if (i < 12) { off = P_NQ + 64 * (i - 8); g = nsa_g; }
        else if (i == 12) { off = P_KS; g = nsa_g + 128; } else { off = P_KW; g = nsa_g + 192; }
        const float v = bf2f(pr[off + lane]);
        const float ss = wave_sum(v * v);
        pr[off + lane] = (bf16)f2bf(v * rsqrtf(ss * (1.0f / 64.0f) + 1e-6f) * g[lane]);
    }
}

__device__ __forceinline__ void att_key(const float (&q)[64], const bf16* __restrict__ kp, const bf16* __restrict__ vp, float bias, float& m, float& l, float (&o)[64]) {
    float dot = 0.f;
#pragma unroll
    for (int c = 0; c < 8; ++c) { const v4u kk = *(const v4u*)(kp + 8 * c);
        dot += q[8 * c + 0] * bflo(kk.x) + q[8 * c + 1] * bfhi(kk.x) + q[8 * c + 2] * bflo(kk.y) + q[8 * c + 3] * bfhi(kk.y)
             + q[8 * c + 4] * bflo(kk.z) + q[8 * c + 5] * bfhi(kk.z) + q[8 * c + 6] * bflo(kk.w) + q[8 * c + 7] * bfhi(kk.w); }
    const float s = dot * 0.125f + bias;
    const float mn = fmaxf(m, s), sc = __expf(m - mn), p = __expf(s - mn);
    l = l * sc + p; m = mn;
#pragma unroll
    for (int c = 0; c < 8; ++c) { const v4u vv = *(const v4u*)(vp + 8 * c);
        o[8 * c + 0] = o[8 * c + 0] * sc + p * bflo(vv.x); o[8 * c + 1] = o[8 * c + 1] * sc + p * bfhi(vv.x);
        o[8 * c + 2] = o[8 * c + 2] * sc + p * bflo(vv.y); o[8 * c + 3] = o[8 * c + 3] * sc + p * bfhi(vv.y);
        o[8 * c + 4] = o[8 * c + 4] * sc + p * bflo(vv.z); o[8 * c + 5] = o[8 * c + 5] * sc + p * bfhi(vv.z);
        o[8 * c + 6] = o[8 * c + 6] * sc + p * bflo(vv.w); o[8 * c + 7] = o[8 * c + 7] * sc + p * bfhi(vv.w); }
}
__device__ __forceinline__ void load_q(float (&q)[64], const bf16* qp) {
#pragma unroll
    for (int c = 0; c < 8; ++c) { const v4u kk = *(const v4u*)(qp + 8 * c);
        q[8 * c + 0] = bflo(kk.x); q[8 * c + 1] = bfhi(kk.x); q[8 * c + 2] = bflo(kk.y); q[8 * c + 3] = bfhi(kk.y);
        q[8 * c + 4] = bflo(kk.z); q[8 * c + 5] = bfhi(kk.z); q[8 * c + 6] = bflo(kk.w); q[8 * c + 7] = bfhi(kk.w); }
}
template <int MODE>
__device__ __forceinline__ void k_attn_naive(int idx, const bf16* __restrict__ proj, const unsigned long long* __restrict__ sel, float* __restrict__ out, int ldo, int ocol) {
    const int h = idx / NT, r = idx % NT, b = r / SQ, t = r % SQ;
    const bf16* base = proj + (size_t)b * SQ * PW;
    float q[64], o[64];
    load_q(q, proj + (size_t)r * PW + (MODE == 0 ? P_DQ : P_NQ) + 64 * h);
#pragma unroll
    for (int d = 0; d < 64; ++d) o[d] = 0.f;
    float m = -1.0e30f, l = 0.f;
    if (MODE == 0) {
        const float slope = exp2f(-2.0f * (h + 1));
        for (int p = 0; p < 3; ++p) { const int dil = (p == 0) ? 1 : (p == 1 ? 4 : 16);
            for (int j = 0; j <= 128; ++j) { const int pos = t - j * dil; if (pos < 0) break;
                att_key(q, base + (size_t)pos * PW + P_DK + 64 * h, base + (size_t)pos * PW + P_DV + 64 * h, -slope * (float)(j * dil), m, l, o); } }
    } else if (MODE == 1) {
        const float slope = exp2f(-(2.0f * h + 1.0f));
        const unsigned long long mask = sel[r]; const int cur = t >> 6;
        for (int j = 0; j <= cur; ++j) { if (!((mask >> j) & 1ull)) continue;
            for (int oo = 0; oo < 64; ++oo) { const int pos = 64 * j + oo; if (pos > t) break;
                att_key(q, base + (size_t)pos * PW + P_KS, base + (size_t)pos * PW + P_VS, -slope * (float)(t - pos), m, l, o); } }
    } else {
        const float slope = exp2f(-(2.0f * h + 1.0f));
        const int p0 = (t - 511) > 0 ? (t - 511) : 0;
        for (int pos = p0; pos <= t; ++pos) att_key(q, base + (size_t)pos * PW + P_KW, base + (size_t)pos * PW + P_VW, -slope * (float)(t - pos), m, l, o);
    }
    const float il = 1.0f / l;
    float* op = out + (size_t)r * ldo + ocol + 64 * h;
#pragma unroll
    for (int c = 0; c < 16; ++c) *(f32x4*)(op + 4 * c) = (f32x4){o[4 * c] * il, o[4 * c + 1] * il, o[4 * c + 2] * il, o[4 * c + 3] * il};
}

__device__ __forceinline__ void k_compress(int vb, int tid, LAS float* sm, const bf16* __restrict__ proj, const float* __restrict__ pos  , const float* __restrict__ w1  ,
                                                  const float* __restrict__ w2  , const float* __restrict__ gk  , float* __restrict__ KC, float* __restrict__ VC) {
    LAS float* in = sm; LAS float* hid = sm + 2048;
    const int which = vb & 1, c = (vb >> 1) % NCMP, b = (vb >> 1) / NCMP;
    const int pc = which ? P_VC : P_KC;
    for (int i = tid; i < 2048; i += 256) { const int l = i >> 6, d = i & 63; in[i] = bf2f(proj[(size_t)(b * SQ + 16 * c + l) * PW + pc + d]) + pos[which * 2048 + i]; }
    __syncthreads();
    const float* w1p = w1 + (size_t)which * 2048 * 256 + tid;
    float a = 0.f;
    for (int i = 0; i < 2048; ++i) a += in[i] * w1p[(size_t)i * 256];
    hid[tid] = gelu_tanh(a);
    __syncthreads();
    if (tid < 64) {
        const float* w2p = w2 + (size_t)which * 256 * 64 + tid; float o = 0.f;
        for (int j = 0; j < 256; ++j) o += hid[j] * w2p[j * 64];
        if (which == 0) { const float ss = wave_sum(o * o); o = o * rsqrtf(ss * (1.0f / 64.0f) + 1e-6f) * gk[tid]; KC[((size_t)b * NCMPP + c) * 64 + tid] = o; }
        else VC[((size_t)b * NCMPP + c) * 64 + tid] = o;
    }
}

__device__ __forceinline__ void k_cmp_topk(int vb, int tid, LAS float* sm, const bf16* __restrict__ proj, const float* __restrict__ KC, const float* __restrict__ VC, float* __restrict__ ocmp, int ldoc, unsigned long long* __restrict__ sel) {
    LAS float* qs = sm; LAS float (*sc)[256] = (LAS float (*)[256])(sm + 256); LAS float* impv = sm + 1280;
    const int r = vb, b = r / SQ, t = r % SQ, lane = tid & 63, w = tid >> 6;
    qs[tid] = bf2f(proj[(size_t)r * PW + P_NQ + tid]);
    __syncthreads();
    {   const int c = tid; const bool valid = (c < NCMP) && (t >= 16 * c + 31);
        float s[4] = {0.f, 0.f, 0.f, 0.f};
        if (valid) { const float* kp = KC + ((size_t)b * NCMPP + c) * 64;
            for (int d = 0; d < 64; ++d) { const float kv = kp[d]; s[0] += qs[d] * kv; s[1] += qs[64 + d] * kv; s[2] += qs[128 + d] * kv; s[3] += qs[192 + d] * kv; } }
        const float dist = (float)(t - 16 * c - 31);
#pragma unroll
        for (int h = 0; h < 4; ++h) sc[h][c] = valid ? (s[h] * 0.125f - exp2f(-(2.0f * h + 1.0f)) * dist) : -1.0e30f;
    }
    __syncthreads();
    {
        float v[4]; float mx = -1.0e30f;
#pragma unroll
        for (int i = 0; i < 4; ++i) { v[i] = sc[w][lane + 64 * i]; mx = fmaxf(mx, v[i]); }
        mx = wave_max(mx);
        float sum = 0.f;
#pragma unroll
        for (int i = 0; i < 4; ++i) { v[i] = (v[i] > -1.0e29f) ? __expf(v[i] - mx) : 0.f; sum += v[i]; }
        sum = wave_sum(sum);
        const float inv = sum > 0.f ? 1.0f / sum : 0.f;
#pragma unroll
        for (int i = 0; i < 4; ++i) sc[w][lane + 64 * i] = v[i] * inv;
    }
    __syncthreads();
    {
        const int h = tid >> 6, d = tid & 63; const float* vp = VC + (size_t)b * NCMPP * 64 + d; float o = 0.f;
        const int nc = (t >= 31) ? ((t - 31) / 16 + 1) : 0;
        for (int c = 0; c < nc && c < NCMP; ++c) o += sc[h][c] * vp[c * 64];
        ocmp[(size_t)r * ldoc + tid] = o;
    }
    if (tid < 64) {
        const int j = tid, cur = t >> 6; float imp = 0.f;
        for (int c = 4 * j - 1; c <= 4 * j + 3; ++c) if (c >= 0 && c < NCMP) imp += sc[0][c] + sc[1][c] + sc[2][c] + sc[3][c];
        const bool forced = (j == 0) || (j == cur) || (j == cur - 1);
        const float val = (j <= cur) ? (imp + (forced ? 1.0e4f : 0.f)) : -1.0e30f;
        impv[j] = val;
    }
    __syncthreads();
    if (tid < 64) {
        const int j = tid; const float val = impv[j]; int rank = 0;
        for (int k = 0; k < 64; ++k) { const float o = impv[k]; rank += (o > val || (o == val && k < j)) ? 1 : 0; }
        const unsigned long long mask = __ballot(rank < 16);
        if (tid == 0) sel[r] = mask;
    }
}

__device__ __forceinline__ void k_gla(int vb, int lane, const bf16* __restrict__ proj, const float* __restrict__ wa2  , const float* __restrict__ ba  , const float* __restrict__ ng  , float* __restrict__ mixraw) {
    const int b = vb >> 2, h = vb & 3, kk = lane & 31;
    float wcol[16];
#pragma unroll
    for (int j = 0; j < 16; ++j) wcol[j] = wa2[j * 128 + h * 32 + kk];
    const float bav = ba[h * 32 + kk], gn = ng[lane];
    float S[32];
#pragma unroll
    for (int k = 0; k < 32; ++k) S[k] = 0.f;
    for (int t = 0; t < SQ; ++t) {
        const bf16* pr = proj + (size_t)(b * SQ + t) * PW;
        const float qv = bf2f(pr[P_GQ + h * 32 + kk]) * 0.17677669529663687f, kv = bf2f(pr[P_GK + h * 32 + kk]);
        const v4u a0 = *(const v4u*)(pr + P_GA), a1 = *(const v4u*)(pr + P_GA + 8);
        float z = bav;
        z += bflo(a0.x) * wcol[0] + bfhi(a0.x) * wcol[1] + bflo(a0.y) * wcol[2] + bfhi(a0.y) * wcol[3] + bflo(a0.z) * wcol[4] + bfhi(a0.z) * wcol[5] + bflo(a0.w) * wcol[6] + bfhi(a0.w) * wcol[7];
        z += bflo(a1.x) * wcol[8] + bfhi(a1.x) * wcol[9] + bflo(a1.y) * wcol[10] + bfhi(a1.y) * wcol[11] + bflo(a1.z) * wcol[12] + bfhi(a1.z) * wcol[13] + bflo(a1.w) * wcol[14] + bfhi(a1.w) * wcol[15];
        const float av = __expf(log_sigmoid_f(z) * (1.0f / 16.0f));
        const float vv = bf2f(pr[P_GV + h * 64 + lane]);
        float o = 0.f;
#pragma unroll
        for (int k = 0; k < 32; ++k) { const float ak = __shfl(av, k), kx = __shfl(kv, k), qx = __shfl(qv, k); S[k] = S[k] * ak + kx * vv; o += qx * S[k]; }
        const float ss = wave_sum(o * o);
        float y = o * rsqrtf(ss * (1.0f / 64.0f) + 1e-6f) * gn;
        const float rr = bf2f(pr[P_GR + h * 64 + lane]);
        y *= rr * sigmoid_f(rr);
        mixraw[(size_t)(b * SQ + t) * 1024 + 512 + h * 64 + lane] = y;
    }
}

__device__ __forceinline__ void k_s5(int vb, int lane, LAS float* xs, const bf16* __restrict__ proj, const float* __restrict__ a_re, const float* __restrict__ a_im, const float* __restrict__ b_re, const float* __restrict__ b_im,
                                           const float* __restrict__ c_re, const float* __restrict__ c_im, const float* __restrict__ dvec, const float* __restrict__ log_dt, float* __restrict__ hg) {
    const int b = vb >> 4, g = vb & 15, n = lane;
    const float dt = expf(log_dt[g]), are = a_re[g * 64 + n], aim = a_im[g * 64 + n];
    const float mag = expf(dt * are), abr = mag * cosf(dt * aim), abi = mag * sinf(dt * aim);
    const float den = are * are + aim * aim, f_re = ((abr - 1.0f) * are + abi * aim) / den, f_im = (abi * are - (abr - 1.0f) * aim) / den;
    float bbr[16], bbi[16];
#pragma unroll
    for (int c = 0; c < 16; ++c) { const float br = b_re[(size_t)(g * 64 + n) * 16 + c], bi = b_im[(size_t)(g * 64 + n) * 16 + c]; bbr[c] = f_re * br - f_im * bi; bbi[c] = f_re * bi + f_im * br; }
    const int cc = lane & 15, qq = lane >> 4;
    float cre[16], cim[16];
#pragma unroll
    for (int i = 0; i < 16; ++i) { cre[i] = c_re[(size_t)(g * 16 + cc) * 64 + qq * 16 + i]; cim[i] = c_im[(size_t)(g * 16 + cc) * 64 + qq * 16 + i]; }
    const float dco = dvec[g * 16 + cc];
    float xr = 0.f, xi = 0.f;
    for (int t = 0; t < SQ; ++t) {
        const size_t r = (size_t)b * SQ + t;
        const float uval = bf2f(proj[r * PW + P_SU + g * 16 + cc]);
        float bur = 0.f, bui = 0.f;
#pragma unroll
        for (int c = 0; c < 16; ++c) { const float uc = __shfl(uval, c); bur += bbr[c] * uc; bui += bbi[c] * uc; }
        const float nr = abr * xr - abi * xi + bur, ni = abr * xi + abi * xr + bui; xr = nr; xi = ni;
        xs[n] = xr; xs[64 + n] = xi;
        LDS_WAIT(); asm volatile("" ::: "memory");
        float part = 0.f;
#pragma unroll
        for (int i = 0; i < 16; ++i) part += cre[i] * xs[qq * 16 + i] - cim[i] * xs[64 + qq * 16 + i];
        part += __shfl_xor(part, 16); part += __shfl_xor(part, 32);
        const float y = part + dco * uval;
        if (lane < 16) hg[r * 256 + g * 16 + lane] = gelu_tanh(y);
        LDS_WAIT(); asm volatile("" ::: "memory");
    }
}
__device__ __forceinline__ void k_s5_glu(int vb, int tid, LAS float* hs, const float* __restrict__ hg, const float* __restrict__ gw  , const float* __restrict__ gb, float* __restrict__ mixraw) {
    const int r = vb;
    hs[tid] = hg[(size_t)r * 256 + tid];
    __syncthreads();
    float z = gb[tid];
    for (int i = 0; i < 256; ++i) z += hs[i] * gw[i * 256 + tid];
    mixraw[(size_t)r * 1024 + 768 + tid] = hs[tid] * sigmoid_f(z);
}
__device__ __forceinline__ void k_mixfinal(int vb, int tid, LAS float* sm, const bf16* __restrict__ proj, const float* __restrict__ mixraw, const float* __restrict__ ocmp, int ldoc, const float* __restrict__ os, const float* __restrict__ ow,
                                                  const float* __restrict__ og  , bf16* __restrict__ mix) {
    LAS float (*red)[4] = (LAS float (*)[4])sm;
    const int r = vb, lane = tid & 63, w = tid >> 6;
    float v[4];
    v[0] = mixraw[(size_t)r * 1024 + tid]; v[2] = mixraw[(size_t)r * 1024 + 512 + tid]; v[3] = mixraw[(size_t)r * 1024 + 768 + tid];
    {   const bf16* gp = proj + (size_t)r * PW + P_NG + 3 * w;
        const float g0 = sigmoid_f(bf2f(gp[0])), g1 = sigmoid_f(bf2f(gp[1])), g2 = sigmoid_f(bf2f(gp[2]));
        v[1] = g0 * ocmp[(size_t)r * ldoc + tid] + g1 * os[(size_t)r * 256 + tid] + g2 * ow[(size_t)r * 256 + tid]; }
#pragma unroll
    for (int gidx = 0; gidx < 4; ++gidx) { const float s = wave_sum(v[gidx] * v[gidx]); if (lane == 0) red[gidx][w] = s; }
    __syncthreads();
#pragma unroll
    for (int gidx = 0; gidx < 4; ++gidx) { const float ss = red[gidx][0] + red[gidx][1] + red[gidx][2] + red[gidx][3];
        mix[(size_t)r * 1024 + gidx * 256 + tid] = (bf16)f2bf(v[gidx] * rsqrtf(ss * (1.0f / 256.0f) + 1e-6f) * og[gidx * 256 + tid]); }
}

typedef short s16x4 __attribute__((ext_vector_type(4)));
constexpr float ATT_SC = 0.125f * 1.4426950408889634f;
constexpr int VROWB = 144;
struct AttSt { f32x4 o[4]; float l; };
__device__ __forceinline__ s16x4 lds_tr16(const LAS unsigned char* p) { return __builtin_bit_cast(s16x4, __builtin_amdgcn_ds_read_tr16_b64_v4i16((LAS s16x4*)p)); }
__device__ __forceinline__ unsigned cvtpk(float lo, float hi) { return pg8::cvt_pk_bf16(lo, hi); }

constexpr float ATT_REF = 16.0f;
template <int NG>
__device__ __forceinline__ void att_unit(const bf16x8 (&kf)[2][2], const LAS unsigned char* vl, const bf16x8 (&qf)[NG][2], AttSt (&st)[NG],
                                         const int (&d0)[NG], const float (&c1)[NG], const int (&dmax)[NG], int dstep, int lane) {
    const int g = lane >> 4, i16 = lane & 15;
    const LAS unsigned char* vrd = vl + (4 * g + (i16 >> 2)) * VROWB + (i16 & 3) * 8;
    bf16x8 vt[4];
#pragma unroll
    for (int db = 0; db < 4; ++db) { const s16x4 a = lds_tr16(vrd + db * 32), b = lds_tr16(vrd + 16 * VROWB + db * 32);
        vt[db] = (bf16x8){a[0], a[1], a[2], a[3], b[0], b[1], b[2], b[3]}; }
    asm volatile("s_waitcnt lgkmcnt(0)" ::: "memory");
#pragma unroll
    for (int gi = 0; gi < NG; ++gi) {
        f32x4 s0 = {0.f, 0.f, 0.f, 0.f}, s1 = {0.f, 0.f, 0.f, 0.f};
        s0 = __builtin_amdgcn_mfma_f32_16x16x32_bf16(kf[0][0], qf[gi][0], s0, 0, 0, 0);
        s0 = __builtin_amdgcn_mfma_f32_16x16x32_bf16(kf[0][1], qf[gi][1], s0, 0, 0, 0);
        s1 = __builtin_amdgcn_mfma_f32_16x16x32_bf16(kf[1][0], qf[gi][0], s1, 0, 0, 0);
        s1 = __builtin_amdgcn_mfma_f32_16x16x32_bf16(kf[1][1], qf[gi][1], s1, 0, 0, 0);
        const float cd = c1[gi] * (float)dstep, B0 = fmaf(-c1[gi], (float)d0[gi], -ATT_REF);
        float x[8];
#pragma unroll
        for (int e = 0; e < 8; ++e) { const int kq = 16 * (e >> 2) + (e & 3), dist = d0[gi] - dstep * kq; const float a = (e < 4) ? s0[e & 3] : s1[e & 3];
            const float v = __builtin_amdgcn_exp2f(fmaf(a, ATT_SC, fmaf(cd, (float)kq, B0)));
            x[e] = ((unsigned)dist <= (unsigned)dmax[gi]) ? v : 0.f; }
        st[gi].l += ((x[0] + x[1]) + (x[2] + x[3])) + ((x[4] + x[5]) + (x[6] + x[7]));
        v4u pw; pw.x = cvtpk(x[0], x[1]); pw.y = cvtpk(x[2], x[3]); pw.z = cvtpk(x[4], x[5]); pw.w = cvtpk(x[6], x[7]);
        const bf16x8 pf = __builtin_bit_cast(bf16x8, pw);
#pragma unroll
        for (int db = 0; db < 4; ++db) st[gi].o[db] = __builtin_amdgcn_mfma_f32_16x16x32_bf16(vt[db], pf, st[gi].o[db], 0, 0, 0);
    }
}
__device__ __forceinline__ void att_load_k(bf16x8 (&kf)[2][2], const bf16* kb, int pitch, int r0, int r1, int g) {
    kf[0][0] = *(const bf16x8*)(kb + (size_t)r0 * pitch + 8 * g); kf[0][1] = *(const bf16x8*)(kb + (size_t)r0 * pitch + 32 + 8 * g);
    kf[1][0] = *(const bf16x8*)(kb + (size_t)r1 * pitch + 8 * g); kf[1][1] = *(const bf16x8*)(kb + (size_t)r1 * pitch + 32 + 8 * g);
}
__device__ __forceinline__ void att_load_v(v4u (&vf)[4], const bf16* vb, int pitch, const int (&vr)[4], int lane) {
#pragma unroll
    for (int i = 0; i < 4; ++i) vf[i] = *(const v4u*)(vb + (size_t)vr[i] * pitch + 8 * (lane & 7));
}
__device__ __forceinline__ void att_store_v(LAS unsigned char* vl, const v4u (&vf)[4], int lane) {
#pragma unroll
    for (int i = 0; i < 4; ++i) *(LAS v4u*)(vl + (8 * i + (lane >> 3)) * VROWB + 16 * (lane & 7)) = vf[i];
    asm volatile("s_waitcnt lgkmcnt(0)" ::: "memory");
}
__device__ __forceinline__ void att_init(AttSt& s) {
#pragma unroll
    for (int db = 0; db < 4; ++db) s.o[db] = (f32x4){0.f, 0.f, 0.f, 0.f};
    s.l = 0.f;
}
__device__ __forceinline__ void att_load_q(bf16x8 (&q)[2], const bf16* qp  , int g) {
    q[0] = *(const bf16x8*)(qp + 8 * g); q[1] = *(const bf16x8*)(qp + 32 + 8 * g);
}
__device__ __forceinline__ void att_finish(AttSt& s) {
    float l = s.l; l += __shfl_xor(l, 16); l += __shfl_xor(l, 32);
    const float il = l > 0.f ? 1.0f / l : 0.f;
#pragma unroll
    for (int db = 0; db < 4; ++db) s.o[db] = s.o[db] * il;
}

__device__ __forceinline__ void att_store_bf16(bf16* op, const AttSt& s) {
#pragma unroll
    for (int db = 0; db < 4; ++db) { v2u w; w.x = pk2(s.o[db][0], s.o[db][1]); w.y = pk2(s.o[db][2], s.o[db][3]); *(v2u*)(op + 16 * db) = w; }
}
__device__ __forceinline__ void nsa_win_job(int job, int lane, LAS unsigned char* vl, const bf16* __restrict__ proj, bf16* __restrict__ ow) {
    const int b = job / (SQ / 8), t0 = (job % (SQ / 8)) * 8, g = lane >> 4, c = lane & 15, qi = c >> 2, h = c & 3;
    const bf16* pb = proj + (size_t)b * SQ * PW;
    bf16x8 qf[2][2]; AttSt st[2]; int tq[2], dmax[2], d0[2]; float c1[2];
#pragma unroll
    for (int gi = 0; gi < 2; ++gi) { tq[gi] = t0 + 4 * gi + qi; att_load_q(qf[gi], pb + (size_t)tq[gi] * PW + P_NQ + 64 * h, g); att_init(st[gi]);
        c1[gi] = exp2f(-(2.0f * h + 1.0f)) * 1.4426950408889634f; dmax[gi] = tq[gi] < 511 ? tq[gi] : 511; }
    const int u0 = (t0 - 511) > 0 ? ((t0 - 511) >> 5) : 0, u1 = (t0 + 7) >> 5;
    bf16x8 kf[2][2]; v4u vf[4]; int vr[4];
    {   const int p0 = 32 * u0;
#pragma unroll
        for (int i = 0; i < 4; ++i) vr[i] = p0 + 8 * i + (lane >> 3);
        att_load_k(kf, pb + P_KW, PW, p0 + c, p0 + 16 + c, g); att_load_v(vf, pb + P_VW, PW, vr, lane); }
    for (int u = u0; u <= u1; ++u) {
        bf16x8 kc[2][2];
#pragma unroll
        for (int a = 0; a < 2; ++a)
#pragma unroll
            for (int k = 0; k < 2; ++k) kc[a][k] = kf[a][k];
        att_store_v(vl, vf, lane);
        if (u < u1) { const int p1 = 32 * (u + 1);
#pragma unroll
            for (int i = 0; i < 4; ++i) vr[i] = p1 + 8 * i + (lane >> 3);
            att_load_k(kf, pb + P_KW, PW, p1 + c, p1 + 16 + c, g); att_load_v(vf, pb + P_VW, PW, vr, lane); }
#pragma unroll
        for (int gi = 0; gi < 2; ++gi) d0[gi] = tq[gi] - 32 * u - 4 * g;
        att_unit<2>(kc, vl, qf, st, d0, c1, dmax, 1, lane);
    }
#pragma unroll
    for (int gi = 0; gi < 2; ++gi) { att_finish(st[gi]);
        att_store_bf16(ow + (size_t)(b * SQ + tq[gi]) * 256 + 64 * h + 4 * g, st[gi]); }
}

__device__ __forceinline__ void nsa_sel_job(int job, int lane, LAS unsigned char* vl, const bf16* __restrict__ proj, const unsigned long long* __restrict__ sel, bf16* __restrict__ os) {
    const int b = job / (SQ / 8), t0 = (job % (SQ / 8)) * 8, g = lane >> 4, c = lane & 15, qi = c >> 2, h = c & 3;
    const bf16* pb = proj + (size_t)b * SQ * PW;
    const unsigned long long mk = sel[(size_t)b * SQ + t0 + (lane & 7)];
    const unsigned mlo = (unsigned)mk, mhi = (unsigned)(mk >> 32);
    unsigned ulo = 0u, uhi = 0u;
#pragma unroll
    for (int k = 0; k < 8; ++k) { ulo |= (unsigned)__shfl((int)mlo, k); uhi |= (unsigned)__shfl((int)mhi, k); }
    ulo = __builtin_amdgcn_readfirstlane(ulo); uhi = __builtin_amdgcn_readfirstlane(uhi);
    const int cur = t0 >> 6;
    unsigned long long rem = ((unsigned long long)uhi << 32) | ulo;
    if (cur < 63) rem &= ((2ull << cur) - 1ull);
    bf16x8 qf[2][2]; AttSt st[2]; int tq[2], dmax[2], d0[2]; float c1[2]; unsigned long long mq[2];
#pragma unroll
    for (int gi = 0; gi < 2; ++gi) { tq[gi] = t0 + 4 * gi + qi; att_load_q(qf[gi], pb + (size_t)tq[gi] * PW + P_NQ + 64 * h, g); att_init(st[gi]);
        c1[gi] = exp2f(-(2.0f * h + 1.0f)) * 1.4426950408889634f; dmax[gi] = tq[gi];
        mq[gi] = ((unsigned long long)(unsigned)__shfl((int)mhi, 4 * gi + qi) << 32) | (unsigned)__shfl((int)mlo, 4 * gi + qi); }
    int j = __builtin_ctzll(rem), hf = 0;
    bf16x8 kf[2][2]; v4u vf[4]; int vr[4];
    {   const int p0 = 64 * j;
#pragma unroll
        for (int i = 0; i < 4; ++i) vr[i] = p0 + 8 * i + (lane >> 3);
        att_load_k(kf, pb + P_KS, PW, p0 + c, p0 + 16 + c, g); att_load_v(vf, pb + P_VS, PW, vr, lane); }
    for (;;) {
        bf16x8 kc[2][2];
#pragma unroll
        for (int a = 0; a < 2; ++a)
#pragma unroll
            for (int k = 0; k < 2; ++k) kc[a][k] = kf[a][k];
        att_store_v(vl, vf, lane);
        int nj = j, nhf = hf + 1; bool has = true;
        if (nhf == 2) { rem &= rem - 1ull; if (rem == 0ull) has = false; else { nj = __builtin_ctzll(rem); nhf = 0; } }
        if (has) { const int p1 = 64 * nj + 32 * nhf;
#pragma unroll
            for (int i = 0; i < 4; ++i) vr[i] = p1 + 8 * i + (lane >> 3);
            att_load_k(kf, pb + P_KS, PW, p1 + c, p1 + 16 + c, g); att_load_v(vf, pb + P_VS, PW, vr, lane); }
#pragma unroll
        for (int gi = 0; gi < 2; ++gi) d0[gi] = ((mq[gi] >> j) & 1ull) ? (tq[gi] - (64 * j + 32 * hf) - 4 * g) : -1000000;
        att_unit<2>(kc, vl, qf, st, d0, c1, dmax, 1, lane);
        if (!has) break;
        j = nj; hf = nhf;
    }
#pragma unroll
    for (int gi = 0; gi < 2; ++gi) { att_finish(st[gi]);
        att_store_bf16(os + (size_t)(b * SQ + tq[gi]) * 256 + 64 * h + 4 * g, st[gi]); }
}

__device__ __forceinline__ void dil_job(int job, int lane, LAS unsigned char* vl, const bf16* __restrict__ proj, bf16* __restrict__ mixraw, const float* __restrict__ do1, const float* __restrict__ dl1) {
    const int r = job & 15, blk = (job >> 4) & 15, h = (job >> 8) & 3, b = job >> 10, g = lane >> 4, c = lane & 15;
    const int tb = 256 * blk + r;
    const bf16* pb = proj + (size_t)b * SQ * PW;
    bf16x8 qf[1][2]; AttSt st[1]; int dmax[1], d0[1]; float c1[1];
    const int tq = tb + 16 * c;
    att_load_q(qf[0], pb + (size_t)tq * PW + P_DQ + 64 * h, g); att_init(st[0]);
    c1[0] = exp2f(-2.0f * (h + 1)) * 1.4426950408889634f;
    const bf16* kb = pb + P_DK + 64 * h; const bf16* vb = pb + P_DV + 64 * h;
#pragma unroll 1
    for (int p = 0; p < 2; ++p) {
        const int dil = (p == 0) ? 16 : 4, win = (p == 0) ? 2048 : 512, nun = (p == 0) ? 5 : 6;
        const int pstart = tb - win;
        dmax[0] = tq < win ? tq : win;
        bf16x8 kf[2][2]; v4u vf[4]; int vr[4];
#define DIL_ROW(n) ({ int _p = pstart + dil * (n); _p = _p < 0 ? 0 : _p; _p > SQ - 1 ? SQ - 1 : _p; })
        {
#pragma unroll
            for (int i = 0; i < 4; ++i) vr[i] = DIL_ROW(8 * i + (lane >> 3));
            att_load_k(kf, kb, PW, DIL_ROW(c), DIL_ROW(16 + c), g); att_load_v(vf, vb, PW, vr, lane); }
        for (int u = 0; u < nun; ++u) {
            bf16x8 kc[2][2];
#pragma unroll
            for (int a = 0; a < 2; ++a)
#pragma unroll
                for (int k = 0; k < 2; ++k) kc[a][k] = kf[a][k];
            att_store_v(vl, vf, lane);
            if (u + 1 < nun) { const int n1 = 32 * (u + 1);
#pragma unroll
                for (int i = 0; i < 4; ++i) vr[i] = DIL_ROW(n1 + 8 * i + (lane >> 3));
                att_load_k(kf, kb, PW, DIL_ROW(n1 + c), DIL_ROW(n1 + 16 + c), g); att_load_v(vf, vb, PW, vr, lane); }
            d0[0] = tq - (pstart + dil * (32 * u + 4 * g));
            att_unit<1>(kc, vl, qf, st, d0, c1, dmax, dil, lane);
        }
#undef DIL_ROW
    }
    {   const float* op = do1 + (size_t)(b * SQ + tq) * 256 + 64 * h + 4 * g;
        f32x4 p1[4];
#pragma unroll
        for (int db = 0; db < 4; ++db) p1[db] = *(const f32x4*)(op + 16 * db);
        float l = st[0].l; l += __shfl_xor(l, 16); l += __shfl_xor(l, 32); l += dl1[(size_t)(b * SQ + tq) * 4 + h];
        const float il = 1.0f / l;
#pragma unroll
        for (int db = 0; db < 4; ++db) st[0].o[db] = (st[0].o[db] + p1[db]) * il; }
    att_store_bf16(mixraw + (size_t)(b * SQ + tq) * 1024 + 64 * h + 4 * g, st[0]);
}


__device__ __forceinline__ void dil_p1_job(int job, int lane, LAS unsigned char* vl, const bf16* __restrict__ proj, float* __restrict__ do1, float* __restrict__ dl1) {
    const int qb = job & 127, h = (job >> 7) & 3, b = job >> 9, g = lane >> 4, c = lane & 15, t0 = 32 * qb;
    const bf16* pb = proj + (size_t)b * SQ * PW; const bf16* kb = pb + P_DK + 64 * h; const bf16* vb = pb + P_DV + 64 * h;
    bf16x8 qf[2][2]; AttSt st[2]; int tq[2], dmax[2], d0[2]; float c1[2];
#pragma unroll
    for (int gi = 0; gi < 2; ++gi) { tq[gi] = t0 + 16 * gi + c; att_load_q(qf[gi], pb + (size_t)tq[gi] * PW + P_DQ + 64 * h, g); att_init(st[gi]);
        c1[gi] = exp2f(-2.0f * (h + 1)) * 1.4426950408889634f; dmax[gi] = tq[gi] < 128 ? tq[gi] : 128; }
    const int u0 = (t0 - 128) > 0 ? ((t0 - 128) >> 5) : 0, u1 = (t0 + 31) >> 5;
    bf16x8 kf[2][2]; v4u vf[4]; int vr[4];
    {   const int p0 = 32 * u0;
#pragma unroll
        for (int i = 0; i < 4; ++i) vr[i] = p0 + 8 * i + (lane >> 3);
        att_load_k(kf, kb, PW, p0 + c, p0 + 16 + c, g); att_load_v(vf, vb, PW, vr, lane); }
    for (int u = u0; u <= u1; ++u) {
        bf16x8 kc[2][2];
#pragma unroll
        for (int a = 0; a < 2; ++a)
#pragma unroll
            for (int k = 0; k < 2; ++k) kc[a][k] = kf[a][k];
        att_store_v(vl, vf, lane);
        if (u < u1) { const int p1 = 32 * (u + 1);
#pragma unroll
            for (int i = 0; i < 4; ++i) vr[i] = p1 + 8 * i + (lane >> 3);
            att_load_k(kf, kb, PW, p1 + c, p1 + 16 + c, g); att_load_v(vf, vb, PW, vr, lane); }
#pragma unroll
        for (int gi = 0; gi < 2; ++gi) d0[gi] = tq[gi] - 32 * u - 4 * g;
        att_unit<2>(kc, vl, qf, st, d0, c1, dmax, 1, lane);
    }
#pragma unroll
    for (int gi = 0; gi < 2; ++gi) { float l = st[gi].l; l += __shfl_xor(l, 16); l += __shfl_xor(l, 32);
        float* op = do1 + (size_t)(b * SQ + tq[gi]) * 256 + 64 * h + 4 * g;
#pragma unroll
        for (int db = 0; db < 4; ++db) *(f32x4*)(op + 16 * db) = st[gi].o[db];
        if (g == 0) dl1[(size_t)(b * SQ + tq[gi]) * 4 + h] = l; }
}

__device__ __forceinline__ void cmp_second_job(int jw, int lane, const bf16* __restrict__ chid, const bf16* __restrict__ w2t  , const float* __restrict__ gk, bf16* __restrict__ KCb, bf16* __restrict__ VCb) {
    const int i16 = lane & 15, g4 = lane >> 4, which = jw >> 7;
    const bf16* hp = chid + (size_t)(16 * jw + i16) * 256 + 8 * g4; const bf16* wp = w2t + (size_t)which * 64 * 256 + (size_t)i16 * 256 + 8 * g4;
    f32x4 acc[4] = {{0.f, 0.f, 0.f, 0.f}, {0.f, 0.f, 0.f, 0.f}, {0.f, 0.f, 0.f, 0.f}, {0.f, 0.f, 0.f, 0.f}};
#pragma unroll
    for (int ks = 0; ks < 8; ++ks) { const bf16x8 af = *(const bf16x8*)(hp + 32 * ks);
#pragma unroll
        for (int cb = 0; cb < 4; ++cb) { const bf16x8 bfg = *(const bf16x8*)(wp + (size_t)cb * 16 * 256 + 32 * ks); acc[cb] = __builtin_amdgcn_mfma_f32_16x16x32_bf16(af, bfg, acc[cb], 0, 0, 0); } }
    bf16* dst = which ? VCb : KCb;
#pragma unroll
    for (int r = 0; r < 4; ++r) {
        const int R = (16 * jw + 4 * g4 + r) & 2047;
        float v[4] = {acc[0][r], acc[1][r], acc[2][r], acc[3][r]};
        if (which == 0) { float ss = (v[0] * v[0] + v[1] * v[1]) + (v[2] * v[2] + v[3] * v[3]);
            ss += __shfl_xor(ss, 1); ss += __shfl_xor(ss, 2); ss += __shfl_xor(ss, 4); ss += __shfl_xor(ss, 8);
            const float rs = rsqrtf(ss * (1.0f / 64.0f) + 1e-6f);
#pragma unroll
            for (int cb = 0; cb < 4; ++cb) v[cb] *= rs * gk[16 * cb + i16]; }
        if (R < NB * NCMP) { const int b = R / NCMP, c = R - b * NCMP;
#pragma unroll
            for (int cb = 0; cb < 4; ++cb) dst[((size_t)b * 256 + c) * 64 + 16 * cb + i16] = (bf16)f2bf(v[cb]); }
        else { const int b = R - NB * NCMP;
#pragma unroll
            for (int cb = 0; cb < 4; ++cb) dst[((size_t)b * 256 + 255) * 64 + 16 * cb + i16] = 0; }
    }
}

__device__ __forceinline__ void cmp_second(int row, int lane, const bf16* __restrict__ chid, const float* __restrict__ w2  , const float* __restrict__ gk, bf16* __restrict__ KCb, bf16* __restrict__ VCb) {
    const int which = row >> 11, R = row & 2047;
    if (R >= NB * NCMP) { if (R < NB * NCMP + NB) { const int b = R - NB * NCMP; (which ? VCb : KCb)[((size_t)b * 256 + 255) * 64 + lane] = 0; } return; }
    const int b = R / NCMP, c = R - b * NCMP;
    const bf16* hp = chid + (size_t)row * 256; const float* wp = w2 + (size_t)which * 256 * 64 + lane;
    float o = 0.f;
#pragma unroll 4
    for (int j8 = 0; j8 < 32; ++j8) { const v4u hv = *(const v4u*)(hp + 8 * j8); const float* w = wp + j8 * 8 * 64;
        o += bflo(hv.x) * w[0] + bfhi(hv.x) * w[64] + bflo(hv.y) * w[128] + bfhi(hv.y) * w[192] + bflo(hv.z) * w[256] + bfhi(hv.z) * w[320] + bflo(hv.w) * w[384] + bfhi(hv.w) * w[448]; }
    if (which == 0) { const float ss = wave_sum(o * o); o = o * rsqrtf(ss * (1.0f / 64.0f) + 1e-6f) * gk[lane]; KCb[((size_t)b * 256 + c) * 64 + lane] = (bf16)f2bf(o); }
    else VCb[((size_t)b * 256 + c) * 64 + lane] = (bf16)f2bf(o);
}

__device__ __forceinline__ void nsa_cmp_job(int job, int lane, LAS unsigned char* vl, const bf16* __restrict__ proj, const bf16* __restrict__ KCb, const bf16* __restrict__ VCb,
                                            bf16* __restrict__ ocmp, int ldoc, unsigned long long* __restrict__ sel) {
    const int b = job / (SQ / 8), t0 = (job % (SQ / 8)) * 8, g = lane >> 4, c = lane & 15, qi = c >> 2, h = c & 3;
    const bf16* pb = proj + (size_t)b * SQ * PW; const bf16* kb = KCb + (size_t)b * 256 * 64; const bf16* vb = VCb + (size_t)b * 256 * 64;
    LAS float* impA = (LAS float*)(vl + 8192); LAS float* impB = impA + 8 * 64;
    bf16x8 qf[2][2]; AttSt st[2]; int tq[2], dmax[2], d0[2]; float c1[2];
#pragma unroll
    for (int gi = 0; gi < 2; ++gi) { tq[gi] = t0 + 4 * gi + qi; att_load_q(qf[gi], pb + (size_t)tq[gi] * PW + P_NQ + 64 * h, g); att_init(st[gi]);
        c1[gi] = exp2f(-(2.0f * h + 1.0f)) * 1.4426950408889634f; dmax[gi] = 1 << 20; }
    const int nun = (t0 + 7 >= 31) ? ((((t0 + 7 - 31) >> 4) >> 5) + 1) : 0;
    for (int i = lane; i < 2 * 8 * 64; i += 64) impA[i] = 0.f;
    int vr[4];
    for (int u = 0; u < nun; ++u) {
        bf16x8 kf[2][2]; v4u vf[4];
#pragma unroll
        for (int i = 0; i < 4; ++i) vr[i] = 32 * u + 8 * i + (lane >> 3);
        att_load_k(kf, kb, 64, 32 * u + c, 32 * u + 16 + c, g); att_load_v(vf, vb, 64, vr, lane);
        att_store_v(vl, vf, lane);
#pragma unroll
        for (int gi = 0; gi < 2; ++gi) d0[gi] = tq[gi] - 31 - 16 * (32 * u + 4 * g);
        att_unit<2>(kf, vl, qf, st, d0, c1, dmax, 16, lane);
    }
    float il[2];
#pragma unroll
    for (int gi = 0; gi < 2; ++gi) { float l = st[gi].l; l += __shfl_xor(l, 16); l += __shfl_xor(l, 32); il[gi] = l > 0.f ? 1.0f / l : 0.f;
        bf16* op = ocmp + (size_t)(b * SQ + tq[gi]) * ldoc + 64 * h + 4 * g;
#pragma unroll
        for (int db = 0; db < 4; ++db) { const f32x4 t = st[gi].o[db] * il[gi]; v2u w; w.x = pk2(t[0], t[1]); w.y = pk2(t[2], t[3]); *(v2u*)(op + 16 * db) = w; } }
    bf16x8 kn[2][2];
    if (nun > 0) att_load_k(kn, kb, 64, c, 16 + c, g);
    for (int u = 0; u < nun; ++u) {
        bf16x8 kf[2][2];
#pragma unroll
        for (int a_ = 0; a_ < 2; ++a_) { kf[a_][0] = kn[a_][0]; kf[a_][1] = kn[a_][1]; }
        if (u + 1 < nun) att_load_k(kn, kb, 64, 32 * (u + 1) + c, 32 * (u + 1) + 16 + c, g);
#pragma unroll
        for (int gi = 0; gi < 2; ++gi) {
            f32x4 s0 = {0.f, 0.f, 0.f, 0.f}, s1 = {0.f, 0.f, 0.f, 0.f};
            s0 = __builtin_amdgcn_mfma_f32_16x16x32_bf16(kf[0][0], qf[gi][0], s0, 0, 0, 0); s0 = __builtin_amdgcn_mfma_f32_16x16x32_bf16(kf[0][1], qf[gi][1], s0, 0, 0, 0);
            s1 = __builtin_amdgcn_mfma_f32_16x16x32_bf16(kf[1][0], qf[gi][0], s1, 0, 0, 0); s1 = __builtin_amdgcn_mfma_f32_16x16x32_bf16(kf[1][1], qf[gi][1], s1, 0, 0, 0);
            const int dd = tq[gi] - 31 - 16 * (32 * u + 4 * g);
            float S4[2], P3[2];
#pragma unroll
            for (int blk = 0; blk < 2; ++blk) { float sum = 0.f, last = 0.f;
#pragma unroll
                for (int r = 0; r < 4; ++r) { const int dist = dd - 16 * (16 * blk + r); const float a = blk ? s1[r] : s0[r];
                    const float p = (dist >= 0) ? __builtin_amdgcn_exp2f(fmaf(a, ATT_SC, fmaf(-c1[gi], (float)dist, -ATT_REF))) * il[gi] : 0.f; sum += p; last = p; }
                S4[blk] = sum; P3[blk] = last; }
#pragma unroll
            for (int blk = 0; blk < 2; ++blk) { S4[blk] += dpp_xor1(S4[blk]); S4[blk] += dpp_xor2(S4[blk]); P3[blk] += dpp_xor1(P3[blk]); P3[blk] += dpp_xor2(P3[blk]); }
            if (h == 0) {
#pragma unroll
                for (int blk = 0; blk < 2; ++blk) { const int c4 = 8 * u + 4 * blk + g, q = 4 * gi + qi; impA[q * 64 + c4] = S4[blk]; if (c4 < 63) impB[q * 64 + c4 + 1] = P3[blk]; } }
        }
    }
    asm volatile("s_waitcnt lgkmcnt(0)" ::: "memory");
    LAS float* valL = impB + 8 * 64;
    const int cur = t0 >> 6, j = lane;
#pragma unroll 1
    for (int q = 0; q < 8; ++q) {
        const float imp = impA[q * 64 + j] + impB[q * 64 + j];
        const bool forced = (j == 0) || (j == cur) || (j == cur - 1);
        const float val = (j <= cur) ? (imp + (forced ? 1.0e4f : 0.f)) : -1.0e30f;
        valL[j] = val;
        asm volatile("s_waitcnt lgkmcnt(0)" ::: "memory");
        int rank = 0;
#pragma unroll
        for (int k4 = 0; k4 < 16; ++k4) { const f32x4 o = *(const LAS f32x4*)(valL + 4 * k4);
#pragma unroll
            for (int k = 0; k < 4; ++k) rank += (o[k] > val || (o[k] == val && (4 * k4 + k) < j)) ? 1 : 0; }
        const unsigned long long mask = __ballot(rank < 16);
        if (lane == 0) sel[(size_t)b * SQ + t0 + q] = mask;
        asm volatile("s_waitcnt lgkmcnt(0)" ::: "memory");
    }
}


constexpr int SEG = 64, NSEG = SQ / SEG;
typedef float f32x2 __attribute__((ext_vector_type(2)));
__device__ __forceinline__ void gla_gate_row(int row, int lane, const bf16* __restrict__ proj, const float* __restrict__ wa2, const float* __restrict__ ba, float* __restrict__ GA) {
    const bf16* pr = proj + (size_t)row * PW + P_GA;
    const v4u a0 = *(const v4u*)pr, a1 = *(const v4u*)(pr + 8);
    float gv[16] = {bflo(a0.x), bfhi(a0.x), bflo(a0.y), bfhi(a0.y), bflo(a0.z), bfhi(a0.z), bflo(a0.w), bfhi(a0.w), bflo(a1.x), bfhi(a1.x), bflo(a1.y), bfhi(a1.y), bflo(a1.z), bfhi(a1.z), bflo(a1.w), bfhi(a1.w)};
#pragma unroll
    for (int hh = 0; hh < 2; ++hh) { const int j = lane + 64 * hh; float z = ba[j];
#pragma unroll
        for (int i = 0; i < 16; ++i) z += gv[i] * wa2[i * 128 + j];
        GA[(size_t)row * 128 + j] = log_sigmoid_f(z) * (1.0f / 16.0f); }
}
constexpr int GLA_KLROWB = 80;
template <bool OUT>
__device__ __forceinline__ void gla_seg(int job, int lane, LAS unsigned char* vl, const bf16* __restrict__ proj, const float* __restrict__ GA, float* __restrict__ Sbuf, float* __restrict__ Dbuf,
                                        const float* __restrict__ ng, bf16* __restrict__ mixraw) {
    const int seg = job % NSEG, h = (job / NSEG) & 3, b = job / (NSEG * 4), g4 = lane >> 4, i16 = lane & 15;
    LAS unsigned char* kll = vl + 16 * VROWB;
    f32x4 Sr[4][2];
    float* sp = Sbuf + (size_t)job * 2048 + lane;
#pragma unroll
    for (int vb = 0; vb < 4; ++vb)
#pragma unroll
        for (int kb = 0; kb < 2; ++kb)
#pragma unroll
            for (int r = 0; r < 4; ++r) Sr[vb][kb][r] = OUT ? sp[((vb * 2 + kb) * 4 + r) * 64] : 0.f;
    float btot[8];
#pragma unroll
    for (int jj = 0; jj < 8; ++jj) btot[jj] = 0.f;
    const size_t r0 = (size_t)b * SQ + (size_t)seg * SEG;
    const LAS unsigned char* vrd = vl + (4 * g4 + (i16 >> 2)) * VROWB + (i16 & 3) * 8;
    const LAS unsigned char* klrd = kll + (4 * g4 + (i16 >> 2)) * GLA_KLROWB + (i16 & 3) * 8;
    f32x4 nla0, nla1; v2u nkw0, nkw1, nqw0 = {0u, 0u}, nqw1 = {0u, 0u}, nrr[4] = {{0u, 0u}, {0u, 0u}, {0u, 0u}, {0u, 0u}}; v4u nv0, nv1;
#define GLA_LOADCH(ch_) do { const size_t r_ = r0 + 16 * (ch_) + i16; const bf16* pr_ = proj + r_ * PW; \
        nla0 = *(const f32x4*)(GA + r_ * 128 + 32 * h + 4 * g4); nla1 = *(const f32x4*)(GA + r_ * 128 + 32 * h + 16 + 4 * g4); \
        nkw0 = *(const v2u*)(pr_ + P_GK + 32 * h + 4 * g4); nkw1 = *(const v2u*)(pr_ + P_GK + 32 * h + 16 + 4 * g4); \
        if (OUT) { nqw0 = *(const v2u*)(pr_ + P_GQ + 32 * h + 4 * g4); nqw1 = *(const v2u*)(pr_ + P_GQ + 32 * h + 16 + 4 * g4); \
            _Pragma("unroll") for (int vb_ = 0; vb_ < 4; ++vb_) nrr[vb_] = *(const v2u*)(pr_ + P_GR + 64 * h + 16 * vb_ + 4 * g4); } \
        const size_t rr_ = r0 + 16 * (ch_) + (lane >> 3); \
        nv0 = *(const v4u*)(proj + rr_ * PW + P_GV + 64 * h + 8 * (lane & 7)); nv1 = *(const v4u*)(proj + (rr_ + 8) * PW + P_GV + 64 * h + 8 * (lane & 7)); } while (0)
    GLA_LOADCH(0);
#pragma unroll 1
    for (int ch = 0; ch < SEG / 16; ++ch) {
        const size_t r = r0 + 16 * ch + i16;
        const f32x4 la0 = nla0, la1 = nla1; const v2u kw0 = nkw0, kw1 = nkw1, qw0 = nqw0, qw1 = nqw1; const v2u rrc[4] = {nrr[0], nrr[1], nrr[2], nrr[3]};
        *(LAS v4u*)(vl + (lane >> 3) * VROWB + 16 * (lane & 7)) = nv0; *(LAS v4u*)(vl + (8 + (lane >> 3)) * VROWB + 16 * (lane & 7)) = nv1;
        if (ch + 1 < SEG / 16) GLA_LOADCH(ch + 1);
        float bc[8] = {la0[0], la0[1], la0[2], la0[3], la1[0], la1[1], la1[2], la1[3]};
#pragma unroll
        for (int jj = 0; jj < 8; ++jj) bc[jj] += dpp_row_shr<1>(bc[jj]);
#pragma unroll
        for (int jj = 0; jj < 8; ++jj) bc[jj] += dpp_row_shr<2>(bc[jj]);
#pragma unroll
        for (int jj = 0; jj < 8; ++jj) bc[jj] += dpp_row_shr<4>(bc[jj]);
#pragma unroll
        for (int jj = 0; jj < 8; ++jj) bc[jj] += dpp_row_shr<8>(bc[jj]);
        const float kf[8] = {bflo(kw0.x), bfhi(kw0.x), bflo(kw0.y), bfhi(kw0.y), bflo(kw1.x), bfhi(kw1.x), bflo(kw1.y), bfhi(kw1.y)};
        float eb[8], emb[8], e15[8], b15[8];
#pragma unroll
        for (int jj = 0; jj < 8; ++jj) { b15[jj] = __shfl(bc[jj], 16 * g4 + 15); eb[jj] = __expf(bc[jj]); emb[jj] = __builtin_amdgcn_rcpf(eb[jj]); e15[jj] = __expf(b15[jj]); btot[jj] += b15[jj]; }
        {   v2u w0, w1; w0.x = pk2(kf[0] * e15[0] * emb[0], kf[1] * e15[1] * emb[1]); w0.y = pk2(kf[2] * e15[2] * emb[2], kf[3] * e15[3] * emb[3]);
            w1.x = pk2(kf[4] * e15[4] * emb[4], kf[5] * e15[5] * emb[5]); w1.y = pk2(kf[6] * e15[6] * emb[6], kf[7] * e15[7] * emb[7]);
            *(LAS v2u*)(kll + i16 * GLA_KLROWB + 8 * g4) = w0; *(LAS v2u*)(kll + i16 * GLA_KLROWB + 32 + 8 * g4) = w1; }
        asm volatile("s_waitcnt lgkmcnt(0)" ::: "memory");
        bf16x8 vt[4], klt[2];
#pragma unroll
        for (int vb = 0; vb < 4; ++vb) { const s16x4 a = lds_tr16(vrd + vb * 32); vt[vb] = (bf16x8){a[0], a[1], a[2], a[3], 0, 0, 0, 0}; }
#pragma unroll
        for (int kb = 0; kb < 2; ++kb) { const s16x4 a = lds_tr16(klrd + kb * 32); klt[kb] = (bf16x8){a[0], a[1], a[2], a[3], 0, 0, 0, 0}; }
        asm volatile("s_waitcnt lgkmcnt(0)" ::: "memory");
        if (OUT) {
            const float qf[8] = {bflo(qw0.x), bfhi(qw0.x), bflo(qw0.y), bfhi(qw0.y), bflo(qw1.x), bfhi(qw1.x), bflo(qw1.y), bfhi(qw1.y)};
            v4u qe_w, ke_w;
            qe_w.x = pk2(qf[0] * eb[0] * 0.17677669529663687f, qf[1] * eb[1] * 0.17677669529663687f); qe_w.y = pk2(qf[2] * eb[2] * 0.17677669529663687f, qf[3] * eb[3] * 0.17677669529663687f);
            qe_w.z = pk2(qf[4] * eb[4] * 0.17677669529663687f, qf[5] * eb[5] * 0.17677669529663687f); qe_w.w = pk2(qf[6] * eb[6] * 0.17677669529663687f, qf[7] * eb[7] * 0.17677669529663687f);
            ke_w.x = pk2(kf[0] * emb[0], kf[1] * emb[1]); ke_w.y = pk2(kf[2] * emb[2], kf[3] * emb[3]); ke_w.z = pk2(kf[4] * emb[4], kf[5] * emb[5]); ke_w.w = pk2(kf[6] * emb[6], kf[7] * emb[7]);
            const bf16x8 qe = __builtin_bit_cast(bf16x8, qe_w), ke = __builtin_bit_cast(bf16x8, ke_w);
            f32x4 at = {0.f, 0.f, 0.f, 0.f};
            at = __builtin_amdgcn_mfma_f32_16x16x32_bf16(ke, qe, at, 0, 0, 0);
            v4u pw; pw.x = pk2((4 * g4 + 0 <= i16) ? at[0] : 0.f, (4 * g4 + 1 <= i16) ? at[1] : 0.f); pw.y = pk2((4 * g4 + 2 <= i16) ? at[2] : 0.f, (4 * g4 + 3 <= i16) ? at[3] : 0.f); pw.z = 0u; pw.w = 0u;
            const bf16x8 pf = __builtin_bit_cast(bf16x8, pw);
            f32x4 o[4];
#pragma unroll
            for (int vb = 0; vb < 4; ++vb) {
                v4u sw; sw.x = pk2(Sr[vb][0][0], Sr[vb][0][1]); sw.y = pk2(Sr[vb][0][2], Sr[vb][0][3]); sw.z = pk2(Sr[vb][1][0], Sr[vb][1][1]); sw.w = pk2(Sr[vb][1][2], Sr[vb][1][3]);
                o[vb] = (f32x4){0.f, 0.f, 0.f, 0.f};
                o[vb] = __builtin_amdgcn_mfma_f32_16x16x32_bf16(__builtin_bit_cast(bf16x8, sw), qe, o[vb], 0, 0, 0);
                o[vb] = __builtin_amdgcn_mfma_f32_16x16x32_bf16(vt[vb], pf, o[vb], 0, 0, 0); }
            float ss = 0.f;
#pragma unroll
            for (int vb = 0; vb < 4; ++vb) ss += (o[vb][0] * o[vb][0] + o[vb][1] * o[vb][1]) + (o[vb][2] * o[vb][2] + o[vb][3] * o[vb][3]);
            ss += __shfl_xor(ss, 16); ss += __shfl_xor(ss, 32);
            const float rstd = rsqrtf(ss * (1.0f / 64.0f) + 1e-6f);
#pragma unroll
            for (int vb = 0; vb < 4; ++vb) { const f32x4 gn = *(const f32x4*)(ng + 16 * vb + 4 * g4); const v2u rr = rrc[vb];
                const float rf[4] = {bflo(rr.x), bfhi(rr.x), bflo(rr.y), bfhi(rr.y)}; float y[4];
#pragma unroll
                for (int q = 0; q < 4; ++q) y[q] = o[vb][q] * rstd * gn[q] * rf[q] * sigmoid_f(rf[q]);
                v2u w; w.x = pk2(y[0], y[1]); w.y = pk2(y[2], y[3]); *(v2u*)(mixraw + r * 1024 + 512 + 64 * h + 16 * vb + 4 * g4) = w; }
        }
#pragma unroll
        for (int vb = 0; vb < 4; ++vb)
#pragma unroll
            for (int kb = 0; kb < 2; ++kb) { f32x4 c = Sr[vb][kb];
#pragma unroll
                for (int q = 0; q < 4; ++q) c[q] *= e15[4 * kb + q];
                Sr[vb][kb] = __builtin_amdgcn_mfma_f32_16x16x32_bf16(klt[kb], vt[vb], c, 0, 0, 0); }
    }
#undef GLA_LOADCH
    if (!OUT) {
#pragma unroll
        for (int vb = 0; vb < 4; ++vb)
#pragma unroll
            for (int kb = 0; kb < 2; ++kb)
#pragma unroll
                for (int r = 0; r < 4; ++r) sp[((vb * 2 + kb) * 4 + r) * 64] = Sr[vb][kb][r];
        if (i16 == 0) {
#pragma unroll
            for (int jj = 0; jj < 8; ++jj) Dbuf[(size_t)job * 32 + ((jj < 4) ? (4 * g4 + jj) : (16 + 4 * g4 + (jj - 4)))] = __expf(btot[jj]); }
    }
}
__device__ __forceinline__ void gla_scan(int wj, int lane, float* __restrict__ Sbuf, const float* __restrict__ Dbuf) {
    const int e8 = wj & 7, kb = e8 & 1, bh = wj >> 3, g4 = lane >> 4;
    float S[4] = {0.f, 0.f, 0.f, 0.f};
    for (int s0 = 0; s0 < NSEG; s0 += 16) {
        float L[16][4]; f32x4 Dv[16];
#pragma unroll
        for (int u = 0; u < 16; ++u) { const size_t job = (size_t)bh * NSEG + s0 + u; Dv[u] = *(const f32x4*)(Dbuf + job * 32 + 16 * kb + 4 * g4);
#pragma unroll
            for (int j = 0; j < 4; ++j) L[u][j] = Sbuf[job * 2048 + (e8 * 4 + j) * 64 + lane]; }
#pragma unroll
        for (int u = 0; u < 16; ++u) { const size_t job = (size_t)bh * NSEG + s0 + u;
#pragma unroll
            for (int j = 0; j < 4; ++j) { Sbuf[job * 2048 + (e8 * 4 + j) * 64 + lane] = S[j]; S[j] = fmaf(S[j], Dv[u][j], L[u][j]); } }
    }
}

struct S5C { float abr, abi; f32x2 bb[16]; };
__device__ __forceinline__ void s5_consts(S5C& c, int g, int n, const float* __restrict__ a_re, const float* __restrict__ a_im, const float* __restrict__ b_re, const float* __restrict__ b_im, const float* __restrict__ log_dt) {
    const float dt = expf(log_dt[g]), are = a_re[g * 64 + n], aim = a_im[g * 64 + n];
    const float mag = expf(dt * are); c.abr = mag * cosf(dt * aim); c.abi = mag * sinf(dt * aim);
    const float den = are * are + aim * aim, f_re = ((c.abr - 1.0f) * are + c.abi * aim) / den, f_im = (c.abi * are - (c.abr - 1.0f) * aim) / den;
#pragma unroll
    for (int k = 0; k < 16; ++k) { const float br = b_re[(size_t)(g * 64 + n) * 16 + k], bi = b_im[(size_t)(g * 64 + n) * 16 + k]; c.bb[k] = (f32x2){f_re * br - f_im * bi, f_re * bi + f_im * br}; }
}
__device__ __forceinline__ void s5_step(const S5C& c, const v4u u0, const v4u u1, float& xr, float& xi) {
    const float uf[16] = {bflo(u0.x), bfhi(u0.x), bflo(u0.y), bfhi(u0.y), bflo(u0.z), bfhi(u0.z), bflo(u0.w), bfhi(u0.w), bflo(u1.x), bfhi(u1.x), bflo(u1.y), bfhi(u1.y), bflo(u1.z), bfhi(u1.z), bflo(u1.w), bfhi(u1.w)};
    f32x2 bu0 = {0.f, 0.f}, bu1 = {0.f, 0.f};
#pragma unroll
    for (int k = 0; k < 16; k += 2) { bu0 = __builtin_elementwise_fma(c.bb[k], (f32x2){uf[k], uf[k]}, bu0); bu1 = __builtin_elementwise_fma(c.bb[k + 1], (f32x2){uf[k + 1], uf[k + 1]}, bu1); }
    const f32x2 bu = bu0 + bu1;
    const float nr = c.abr * xr - c.abi * xi + bu.x, ni = c.abr * xi + c.abi * xr + bu.y; xr = nr; xi = ni;
}
__device__ __forceinline__ void s5_passA(int gw, int ngw, int lane, const bf16* __restrict__ proj, const float* __restrict__ a_re, const float* __restrict__ a_im, const float* __restrict__ b_re, const float* __restrict__ b_im,
                                        const float* __restrict__ log_dt, float* __restrict__ Xbuf) {
    const int g = gw & 15;
    S5C c; s5_consts(c, g, lane, a_re, a_im, b_re, b_im, log_dt);
    for (int jr = gw >> 4; jr < NB * NSEG; jr += ngw >> 4) {
    const int b = jr / NSEG, seg = jr - b * NSEG, job = (b * 16 + g) * NSEG + seg;
    float xr = 0.f, xi = 0.f;
    const bf16* up = proj + ((size_t)b * SQ + (size_t)seg * SEG) * PW + P_SU + 16 * g;
#define S5_LOADB(U_, tb_) do { _Pragma("unroll") for (int i_ = 0; i_ < 4; ++i_) { const bf16* q_ = up + (size_t)((tb_) + i_) * PW; U_[i_][0] = *(const v4u*)q_; U_[i_][1] = *(const v4u*)(q_ + 8); } } while (0)
    v4u Ua[4][2], Ub[4][2];
    S5_LOADB(Ua, 0);
    for (int t0 = 0; t0 < SEG; t0 += 8) {
        S5_LOADB(Ub, t0 + 4);
#pragma unroll
        for (int i = 0; i < 4; ++i) s5_step(c, Ua[i][0], Ua[i][1], xr, xi);
        if (t0 + 8 < SEG) S5_LOADB(Ua, t0 + 8);
#pragma unroll
        for (int i = 0; i < 4; ++i) s5_step(c, Ub[i][0], Ub[i][1], xr, xi);
    }
    Xbuf[(size_t)job * 128 + lane] = xr; Xbuf[(size_t)job * 128 + 64 + lane] = xi;
    }
}
__device__ __forceinline__ void s5_scan(int bg, int lane, const float* __restrict__ a_re, const float* __restrict__ a_im, const float* __restrict__ log_dt, float* __restrict__ Xbuf) {
    const int g = bg & 15;
    const float dt = expf(log_dt[g]) * (float)SEG, are = a_re[g * 64 + lane], aim = a_im[g * 64 + lane];
    const float mag = expf(dt * are), pr = mag * cosf(dt * aim), pi = mag * sinf(dt * aim);
    float xr = 0.f, xi = 0.f;
    for (int s0 = 0; s0 < NSEG; s0 += 32) {
        float lr[32], li[32];
#pragma unroll
        for (int u = 0; u < 32; ++u) { const size_t job = (size_t)bg * NSEG + s0 + u; lr[u] = Xbuf[job * 128 + lane]; li[u] = Xbuf[job * 128 + 64 + lane]; }
#pragma unroll
        for (int u = 0; u < 32; ++u) { const size_t job = (size_t)bg * NSEG + s0 + u; Xbuf[job * 128 + lane] = xr; Xbuf[job * 128 + 64 + lane] = xi;
            const float nr = pr * xr - pi * xi + lr[u], ni = pr * xi + pi * xr + li[u]; xr = nr; xi = ni; }
    }
}
constexpr int S5_XROWB = 272;
struct S5O { bf16x8 cf[4]; float dco; };
__device__ __forceinline__ void s5_oconsts(S5O& o, int g, int lane, const float* __restrict__ c_re, const float* __restrict__ c_im, const float* __restrict__ dvec) {
    const int cc = lane & 15, g4 = lane >> 4;
#pragma unroll
    for (int ks = 0; ks < 4; ++ks) { v4u w;
        const int n0 = (32 * ks + 8 * g4) >> 1; const float* cr = c_re + (size_t)(g * 16 + cc) * 64 + n0; const float* ci = c_im + (size_t)(g * 16 + cc) * 64 + n0;
        w.x = pk2(cr[0], -ci[0]); w.y = pk2(cr[1], -ci[1]); w.z = pk2(cr[2], -ci[2]); w.w = pk2(cr[3], -ci[3]); o.cf[ks] = __builtin_bit_cast(bf16x8, w); }
    o.dco = dvec[g * 16 + cc];
}
__device__ __forceinline__ void s5_passC(int gw, int ngw, int lane, LAS unsigned char* xl, const bf16* __restrict__ proj, const float* __restrict__ a_re, const float* __restrict__ a_im, const float* __restrict__ b_re, const float* __restrict__ b_im,
                                        const float* __restrict__ c_re, const float* __restrict__ c_im, const float* __restrict__ dvec, const float* __restrict__ log_dt, const float* __restrict__ Xbuf, bf16* __restrict__ hg) {
    const int g = gw & 15, cc = lane & 15, g4 = lane >> 4;
    S5C c; s5_consts(c, g, lane, a_re, a_im, b_re, b_im, log_dt);
    S5O oc; s5_oconsts(oc, g, lane, c_re, c_im, dvec);
    for (int jr = gw >> 4; jr < NB * NSEG; jr += ngw >> 4) {
    const int b = jr / NSEG, seg = jr - b * NSEG, job = (b * 16 + g) * NSEG + seg;
    float xr = Xbuf[(size_t)job * 128 + lane], xi = Xbuf[(size_t)job * 128 + 64 + lane];
    const size_t r0 = (size_t)b * SQ + (size_t)seg * SEG;
    const bf16* up = proj + r0 * PW + P_SU + 16 * g;
    v4u Ua[4][2], Ub[4][2];
    S5_LOADB(Ua, 0);
    for (int t0 = 0; t0 < SEG; t0 += 16) {
        float uv[4];
#pragma unroll
        for (int q = 0; q < 4; ++q) uv[q] = bf2f(proj[(r0 + t0 + 4 * g4 + q) * PW + P_SU + 16 * g + cc]);
#pragma unroll
        for (int hb = 0; hb < 2; ++hb) {
            S5_LOADB(Ub, t0 + 8 * hb + 4);
#pragma unroll
            for (int i = 0; i < 4; ++i) { s5_step(c, Ua[i][0], Ua[i][1], xr, xi); *(LAS unsigned*)(xl + (8 * hb + i) * S5_XROWB + 4 * lane) = pk2(xr, xi); }
            if (t0 + 8 * hb + 8 < SEG) S5_LOADB(Ua, t0 + 8 * hb + 8);
#pragma unroll
            for (int i = 0; i < 4; ++i) { s5_step(c, Ub[i][0], Ub[i][1], xr, xi); *(LAS unsigned*)(xl + (8 * hb + 4 + i) * S5_XROWB + 4 * lane) = pk2(xr, xi); }
        }
        asm volatile("s_waitcnt lgkmcnt(0)" ::: "memory");
        f32x4 acc = {0.f, 0.f, 0.f, 0.f};
#pragma unroll
        for (int ks = 0; ks < 4; ++ks) { const bf16x8 xa = *(const LAS bf16x8*)(xl + cc * S5_XROWB + (32 * ks + 8 * g4) * 2);
            acc = __builtin_amdgcn_mfma_f32_16x16x32_bf16(xa, oc.cf[ks], acc, 0, 0, 0); }
        asm volatile("s_waitcnt lgkmcnt(0)" ::: "memory");
#pragma unroll
        for (int q = 0; q < 4; ++q) { const size_t r = r0 + t0 + 4 * g4 + q;
            hg[r * 256 + 16 * g + cc] = (bf16)f2bf(gelu_tanh(acc[q] + oc.dco * uv[q])); }
    }
    }
}

__device__ __forceinline__ void s5_table_item(int item, int p, const float* __restrict__ a_re, const float* __restrict__ a_im, const float* __restrict__ b_re, const float* __restrict__ b_im,
                                              const float* __restrict__ log_dt, f32x2* __restrict__ tab) {
    const int g = item >> 6;
    const float dt = expf(log_dt[g]), are = a_re[item], aim = a_im[item];
    const float lm = dt * are, th = dt * aim;
    f32x2* t = tab + (size_t)item * 48;
    {   const float mn = expf(-(float)p * lm), mp = expf((float)p * lm), cs = cosf((float)p * th), sn = sinf((float)p * th);
        t[p] = (f32x2){mn * cs, -mn * sn}; t[16 + p] = (f32x2){mp * cs, mp * sn}; }
    const float mag = expf(lm), abr = mag * cosf(th), abi = mag * sinf(th);
    const float den = are * are + aim * aim, f_re = ((abr - 1.0f) * are + abi * aim) / den, f_im = (abi * are - (abr - 1.0f) * aim) / den;
    {   const int k = p; const float br = b_re[(size_t)item * 16 + k], bi = b_im[(size_t)item * 16 + k]; t[32 + k] = (f32x2){f_re * br - f_im * bi, f_re * bi + f_im * br}; }
}
template <bool OUT>
__device__ __forceinline__ void s5_mfma_pass(int gw, int ngw, int lane, LAS unsigned char* xl, const bf16* __restrict__ proj, const f32x2* __restrict__ tabl  ,
                                             const float* __restrict__ c_re, const float* __restrict__ c_im, const float* __restrict__ dvec, float* __restrict__ Xbuf, bf16* __restrict__ hg) {
    const int g = gw & 15, i16 = lane & 15, g4 = lane >> 4;
    const f32x2* tg = tabl + (size_t)g * 64 * 48;
    LAS float* xs = (LAS float*)xl;
    LAS unsigned char* bml = xl + 512;
    f32x2 AM[4][4], AT[4][4], A1[4];
#pragma unroll
    for (int rb = 0; rb < 4; ++rb) { A1[rb] = tg[(size_t)(16 * rb + i16) * 48 + 16 + 1];
#pragma unroll
        for (int r = 0; r < 4; ++r) { AM[rb][r] = tg[(size_t)(16 * rb + i16) * 48 + (4 * g4 + r)]; AT[rb][r] = tg[(size_t)(16 * rb + 4 * g4 + r) * 48 + 16 + i16]; } }
#pragma unroll
    for (int rb8 = 0; rb8 < 8; ++rb8) { v4u w = {0u, 0u, 0u, 0u};
        if (g4 < 2) { const f32x2* bp = tg + (size_t)(16 * (rb8 & 3) + i16) * 48 + 32 + 8 * g4; const int im = rb8 >> 2;
            w.x = pk2(bp[0][im], bp[1][im]); w.y = pk2(bp[2][im], bp[3][im]); w.z = pk2(bp[4][im], bp[5][im]); w.w = pk2(bp[6][im], bp[7][im]); }
        *(LAS v4u*)(bml + (rb8 * 64 + lane) * 16) = w; }
    v4u lfw;
    {   const unsigned one = 0x3f80u; unsigned e[4];
#pragma unroll
        for (int jj = 0; jj < 4; ++jj) e[jj] = (4 * g4 + jj <= i16) ? one : 0u;
        lfw.x = e[0] | (e[1] << 16); lfw.y = e[2] | (e[3] << 16); lfw.z = (g4 == 0) ? one : 0u; lfw.w = 0u; }
    const bf16x8 Lf = __builtin_bit_cast(bf16x8, lfw);
    bf16x8 Cm[4]; f32x4 dco4 = {0.f, 0.f, 0.f, 0.f};
    if (OUT) {
#pragma unroll
        for (int ks = 0; ks < 4; ++ks) { float cv[8];
#pragma unroll
            for (int jj = 0; jj < 8; ++jj) { const int np = 16 * (2 * ks + (jj >> 2)) + 4 * g4 + (jj & 3);
                cv[jj] = (np < 64) ? c_re[(size_t)(g * 16 + i16) * 64 + np] : -c_im[(size_t)(g * 16 + i16) * 64 + (np - 64)]; }
            v4u w; w.x = pk2(cv[0], cv[1]); w.y = pk2(cv[2], cv[3]); w.z = pk2(cv[4], cv[5]); w.w = pk2(cv[6], cv[7]); Cm[ks] = __builtin_bit_cast(bf16x8, w); }
        dco4 = *(const f32x4*)(dvec + g * 16 + 4 * g4);
    }
    asm volatile("s_waitcnt lgkmcnt(0)" ::: "memory");
    for (int jr = gw >> 4; jr < NB * NSEG; jr += ngw >> 4) {
        const int b = jr / NSEG, seg = jr - b * NSEG, job = (b * 16 + g) * NSEG + seg;
        const size_t r0 = (size_t)b * SQ + (size_t)seg * SEG;
        float xinr[4], xini[4];
#pragma unroll
        for (int rb = 0; rb < 4; ++rb) { xinr[rb] = OUT ? Xbuf[(size_t)job * 128 + 16 * rb + i16] : 0.f; xini[rb] = OUT ? Xbuf[(size_t)job * 128 + 64 + 16 * rb + i16] : 0.f; }
        f32x4 xr[4], xi[4];
        v4u nuw; v2u nue = {0u, 0u};
        {   const bf16* pr0 = proj + (r0 + i16) * PW + P_SU + 16 * g; nuw = *(const v4u*)(pr0 + 8 * (g4 & 1)); if (OUT) nue = *(const v2u*)(pr0 + 4 * g4); }
#pragma unroll 1
        for (int ch = 0; ch < SEG / 16; ++ch) {
            const v4u uw = nuw; const v2u ue = nue;
            if (ch + 1 < SEG / 16) { const bf16* pr1 = proj + (r0 + 16 * (ch + 1) + i16) * PW + P_SU + 16 * g; nuw = *(const v4u*)(pr1 + 8 * (g4 & 1)); if (OUT) nue = *(const v2u*)(pr1 + 4 * g4); }
            const bf16x8 uf = __builtin_bit_cast(bf16x8, uw);
            f32x4 bu[8];
#pragma unroll
            for (int rb8 = 0; rb8 < 8; ++rb8) { const bf16x8 bm = *(const LAS bf16x8*)(bml + (rb8 * 64 + lane) * 16);
                bu[rb8] = (f32x4){0.f, 0.f, 0.f, 0.f}; bu[rb8] = __builtin_amdgcn_mfma_f32_16x16x32_bf16(uf, bm, bu[rb8], 0, 0, 0); }
            v4u fz[8];
#pragma unroll
            for (int rb = 0; rb < 4; ++rb) { float zr[4], zi[4];
#pragma unroll
                for (int r = 0; r < 4; ++r) { zr[r] = bu[rb][r] * AM[rb][r].x - bu[rb + 4][r] * AM[rb][r].y; zi[r] = bu[rb][r] * AM[rb][r].y + bu[rb + 4][r] * AM[rb][r].x; }
                const float wr = A1[rb].x * xinr[rb] - A1[rb].y * xini[rb], wi = A1[rb].x * xini[rb] + A1[rb].y * xinr[rb];
                fz[rb].x = pk2(zr[0], zr[1]); fz[rb].y = pk2(zr[2], zr[3]); fz[rb].z = pk2(wr, 0.f); fz[rb].w = 0u;
                fz[rb + 4].x = pk2(zi[0], zi[1]); fz[rb + 4].y = pk2(zi[2], zi[3]); fz[rb + 4].z = pk2(wi, 0.f); fz[rb + 4].w = 0u; }
            f32x4 P[8];
#pragma unroll
            for (int rb8 = 0; rb8 < 8; ++rb8) { P[rb8] = (f32x4){0.f, 0.f, 0.f, 0.f}; P[rb8] = __builtin_amdgcn_mfma_f32_16x16x32_bf16(__builtin_bit_cast(bf16x8, fz[rb8]), Lf, P[rb8], 0, 0, 0); }
#pragma unroll
            for (int rb = 0; rb < 4; ++rb)
#pragma unroll
                for (int r = 0; r < 4; ++r) { xr[rb][r] = P[rb][r] * AT[rb][r].x - P[rb + 4][r] * AT[rb][r].y; xi[rb][r] = P[rb][r] * AT[rb][r].y + P[rb + 4][r] * AT[rb][r].x; }
            f32x4 y = {0.f, 0.f, 0.f, 0.f};
            if (OUT) {
#pragma unroll
                for (int ks = 0; ks < 4; ++ks) { const f32x4 lo = (ks < 2) ? xr[2 * ks] : xi[2 * ks - 4], hi = (ks < 2) ? xr[2 * ks + 1] : xi[2 * ks - 3];
                    v4u w; w.x = pk2(lo[0], lo[1]); w.y = pk2(lo[2], lo[3]); w.z = pk2(hi[0], hi[1]); w.w = pk2(hi[2], hi[3]);
                    y = __builtin_amdgcn_mfma_f32_16x16x32_bf16(Cm[ks], __builtin_bit_cast(bf16x8, w), y, 0, 0, 0); }
            }
            if (i16 == 15) {
#pragma unroll
                for (int rb = 0; rb < 4; ++rb) { *(LAS f32x4*)(xs + 16 * rb + 4 * g4) = xr[rb]; *(LAS f32x4*)(xs + 64 + 16 * rb + 4 * g4) = xi[rb]; } }
            asm volatile("s_waitcnt lgkmcnt(0)" ::: "memory");
#pragma unroll
            for (int rb = 0; rb < 4; ++rb) { xinr[rb] = xs[16 * rb + i16]; xini[rb] = xs[64 + 16 * rb + i16]; }
            asm volatile("s_waitcnt lgkmcnt(0)" ::: "memory");
            if (OUT) {
                const float uv[4] = {bflo(ue.x), bfhi(ue.x), bflo(ue.y), bfhi(ue.y)};
                v2u o; o.x = pk2(gelu_tanh(y[0] + dco4[0] * uv[0]), gelu_tanh(y[1] + dco4[1] * uv[1])); o.y = pk2(gelu_tanh(y[2] + dco4[2] * uv[2]), gelu_tanh(y[3] + dco4[3] * uv[3]));
                *(v2u*)(hg + (r0 + 16 * ch + i16) * 256 + 16 * g + 4 * g4) = o;
            }
        }
        if (!OUT && i16 == 15) {
#pragma unroll
            for (int rb = 0; rb < 4; ++rb) { *(f32x4*)(Xbuf + (size_t)job * 128 + 16 * rb + 4 * g4) = xr[rb]; *(f32x4*)(Xbuf + (size_t)job * 128 + 64 + 16 * rb + 4 * g4) = xi[rb]; } }
    }
}

__device__ __forceinline__ void headnorm8(int row0, int lane, bf16* __restrict__ proj, const float* __restrict__ dil_g  , const float* __restrict__ nsa_g  ) {
    bf16* pr = proj + (size_t)(row0 + (lane >> 3)) * PW + 8 * (lane & 7);
#pragma unroll
    for (int i = 0; i < 14; ++i) {
        const int off = (i < 4) ? (P_DQ + 64 * i) : (i < 8) ? (P_DK + 64 * (i - 4)) : (i < 12) ? (P_NQ + 64 * (i - 8)) : (i == 12) ? P_KS : P_KW;
        const float* gp = ((i < 4) ? dil_g : (i < 8) ? (dil_g + 64) : (i < 12) ? nsa_g : (i == 12) ? (nsa_g + 128) : (nsa_g + 192)) + 8 * (lane & 7);
        const v4u w = *(const v4u*)(pr + off);
        float v[8] = {bflo(w.x), bfhi(w.x), bflo(w.y), bfhi(w.y), bflo(w.z), bfhi(w.z), bflo(w.w), bfhi(w.w)};
        float ss = 0.f;
#pragma unroll
        for (int k = 0; k < 8; ++k) ss += v[k] * v[k];
        ss += __shfl_xor(ss, 1); ss += __shfl_xor(ss, 2); ss += __shfl_xor(ss, 4);
        const float rs = rsqrtf(ss * (1.0f / 64.0f) + 1e-6f);
        const f32x4 g0 = *(const f32x4*)gp, g1 = *(const f32x4*)(gp + 4);
        v4u o; o.x = pk2(v[0] * rs * g0.x, v[1] * rs * g0.y); o.y = pk2(v[2] * rs * g0.z, v[3] * rs * g0.w); o.z = pk2(v[4] * rs * g1.x, v[5] * rs * g1.y); o.w = pk2(v[6] * rs * g1.z, v[7] * rs * g1.w);
        *(v4u*)(pr + off) = o;
    }
}
__device__ __forceinline__ f32x4 ld4bf(const bf16* p) { const v2u w = *(const v2u*)p; return (f32x4){bflo(w.x), bfhi(w.x), bflo(w.y), bfhi(w.y)}; }
__device__ __forceinline__ void mixfinal_row(int r, int lane, const bf16* __restrict__ proj, const bf16* __restrict__ mixraw, const bf16* __restrict__ os, const bf16* __restrict__ ow,
                                             const float* __restrict__ og  , bf16* __restrict__ mix) {
    const bf16* mr = mixraw + (size_t)r * 1024 + 4 * lane;
    f32x4 v[4];
    v[0] = ld4bf(mr); v[2] = ld4bf(mr + 512); v[3] = ld4bf(mr + 768);
    {   const f32x4 oc = ld4bf(mr + 256), s = ld4bf(os + (size_t)r * 256 + 4 * lane), w = ld4bf(ow + (size_t)r * 256 + 4 * lane);
        const bf16* gp = proj + (size_t)r * PW + P_NG + 3 * (lane >> 4);
        const float g0 = sigmoid_f(bf2f(gp[0])), g1 = sigmoid_f(bf2f(gp[1])), g2 = sigmoid_f(bf2f(gp[2]));
        v[1] = oc * g0 + s * g1 + w * g2; }
#pragma unroll
    for (int gi = 0; gi < 4; ++gi) {
        float ss = (v[gi].x * v[gi].x + v[gi].y * v[gi].y) + (v[gi].z * v[gi].z + v[gi].w * v[gi].w);
        ss = wave_sum(ss);
        const float rs = rsqrtf(ss * (1.0f / 256.0f) + 1e-6f);
        const f32x4 g = *(const f32x4*)(og + 256 * gi + 4 * lane);
        v2u o; o.x = pk2(v[gi].x * rs * g.x, v[gi].y * rs * g.y); o.y = pk2(v[gi].z * rs * g.z, v[gi].w * rs * g.w);
        *(v2u*)(mix + (size_t)r * 1024 + 256 * gi + 4 * lane) = o;
    }
}


__device__ __forceinline__ void moe_route(int vb, int wave, int lane, const float* __restrict__ x, const float* __restrict__ g, const float* __restrict__ rw, const float* __restrict__ rb,
                                          bf16* __restrict__ hn, unsigned* __restrict__ tokinfo, float* __restrict__ topw, int* __restrict__ wcnt) {
    int c[8];
#pragma unroll
    for (int e = 0; e < 8; ++e) c[e] = 0;
    const f32x4* gr = (const f32x4*)g + lane;
    f32x4 nv[4];
    {   const f32x4* xr0 = (const f32x4*)(x + (size_t)(128 * vb + 16 * wave) * DM) + lane;
#pragma unroll
        for (int j = 0; j < 4; ++j) nv[j] = xr0[64 * j]; }
#pragma unroll 1
    for (int i = 0; i < 16; ++i) {
        const int row = 128 * vb + 16 * wave + i;
        f32x4 v[4]; float s = 0.f;
#pragma unroll
        for (int j = 0; j < 4; ++j) v[j] = nv[j];
        {   const f32x4* xn = (const f32x4*)(x + (size_t)(row + (i < 15 ? 1 : 0)) * DM) + lane;
#pragma unroll
            for (int j = 0; j < 4; ++j) nv[j] = xn[64 * j]; }
#pragma unroll
        for (int j = 0; j < 4; ++j) s += (v[j].x * v[j].x + v[j].y * v[j].y) + (v[j].z * v[j].z + v[j].w * v[j].w);
        s = wave_sum(s);
        const float rstd = rsqrtf(s * (1.0f / DM) + 1e-6f);
        v2u* o8 = (v2u*)(hn + (size_t)row * DM) + lane;
#pragma unroll
        for (int j = 0; j < 4; ++j) { const f32x4 gv = gr[64 * j]; v[j] = v[j] * rstd * gv; v2u o; o.x = pk2(v[j].x, v[j].y); o.y = pk2(v[j].z, v[j].w); o8[64 * j] = o; }
        float lg[8];
#pragma unroll
        for (int e = 0; e < 8; ++e) lg[e] = 0.f;
#pragma unroll
        for (int j = 0; j < 4; ++j)
#pragma unroll
            for (int k = 0; k < 4; ++k) { const int col = 4 * lane + 256 * j + k; const f32x4 w0 = *(const f32x4*)(rw + (size_t)col * 8), w1 = *(const f32x4*)(rw + (size_t)col * 8 + 4); const float h = v[j][k];
                lg[0] += h * w0.x; lg[1] += h * w0.y; lg[2] += h * w0.z; lg[3] += h * w0.w; lg[4] += h * w1.x; lg[5] += h * w1.y; lg[6] += h * w1.z; lg[7] += h * w1.w; }
#pragma unroll
        for (int e = 0; e < 8; ++e) lg[e] = wave_sum(lg[e]) + rb[e];
        int i1 = 0; float v1 = lg[0];
#pragma unroll
        for (int e = 1; e < 8; ++e) if (lg[e] > v1) { v1 = lg[e]; i1 = e; }
        int i2 = -1; float v2 = -3.0e38f;
#pragma unroll
        for (int e = 0; e < 8; ++e) if (e != i1 && lg[e] > v2) { v2 = lg[e]; i2 = e; }
        i1 = __builtin_amdgcn_readfirstlane(i1); i2 = __builtin_amdgcn_readfirstlane(i2);
        const float e2 = __expf(v2 - v1), w1 = 1.0f / (1.0f + e2), w2 = e2 * w1;
        int r1 = 0, r2 = 0;
#pragma unroll
        for (int e = 0; e < 8; ++e) { if (e == i1) { r1 = c[e]; c[e] += 1; } if (e == i2) { r2 = c[e]; c[e] += 1; } }
        if (lane == 0) { tokinfo[row] = (unsigned)i1 | ((unsigned)i2 << 3) | ((unsigned)r1 << 6) | ((unsigned)r2 << 11); topw[(size_t)row * 2] = w1; topw[(size_t)row * 2 + 1] = w2; }
    }
    int cv = 0;
#pragma unroll
    for (int e = 0; e < 8; ++e) cv = (lane == e) ? c[e] : cv;
    if (lane < 8) wcnt[(vb * 8 + wave) * 8 + lane] = cv;
}
__device__ __forceinline__ void moe_assign(int vb, int tid, LAS int* sm, const int* __restrict__ wcnt, const unsigned* __restrict__ tokinfo, unsigned short* __restrict__ rowtok, int* __restrict__ tokpos, int* __restrict__ mtab) {
    const int wave = tid >> 6, lane = tid & 63;
    {   const int e = tid & 7, part = tid >> 3; int s = 0;
        for (int b = 4 * part; b < 4 * part + 4; ++b)
#pragma unroll
            for (int w = 0; w < 8; ++w) s += wcnt[(b * 8 + w) * 8 + e];
        sm[part * 8 + e] = s; }
    __syncthreads();
    if (tid < 8) { const int e = tid; int total = 0, base = 0;
        for (int p = 0; p < 64; ++p) { const int s = sm[p * 8 + e]; total += s; if (4 * p + 4 <= vb) base += s; }
        for (int b = (vb >> 2) << 2; b < vb; ++b)
#pragma unroll
            for (int w = 0; w < 8; ++w) base += wcnt[(b * 8 + w) * 8 + e];
        sm[512 + e] = total; sm[520 + e] = base; }
    __syncthreads();
    if (tid == 0) { int acc = 0; sm[528] = 0;
        for (int e = 0; e < 8; ++e) { acc += (sm[512 + e] + 255) >> 8; sm[529 + e] = acc; }
        if (vb == 0) { for (int e = 0; e < 9; ++e) mtab[e] = sm[528 + e]; } }
    __syncthreads();
    if (lane < 16) {
        const int row = 128 * vb + 16 * wave + lane; const unsigned info = tokinfo[row];
        const int e1 = info & 7, e2 = (info >> 3) & 7, r1 = (info >> 6) & 31, r2 = (info >> 11) & 31;
        int wb1 = 0, wb2 = 0;
        for (int w = 0; w < wave; ++w) { wb1 += wcnt[(vb * 8 + w) * 8 + e1]; wb2 += wcnt[(vb * 8 + w) * 8 + e2]; }
        const int p1 = 256 * sm[528 + e1] + sm[520 + e1] + wb1 + r1, p2 = 256 * sm[528 + e2] + sm[520 + e2] + wb2 + r2;
        rowtok[p1] = (unsigned short)row; rowtok[p2] = (unsigned short)row; tokpos[(size_t)row * 2] = p1; tokpos[(size_t)row * 2 + 1] = p2;
    }
    if (vb < 8) { const int e = vb; for (int p = 256 * sm[528 + e] + sm[512 + e] + tid; p < 256 * sm[529 + e]; p += 512) rowtok[p] = 0; }
    __syncthreads();
}
template <bool EARLY>
__device__ __forceinline__ void moe_combine(int row, int lane, float* __restrict__ out, const bf16* __restrict__ Y, const int* __restrict__ tokpos, const float* __restrict__ topw, int tail0) {
    const int p0 = tokpos[(size_t)row * 2], p1 = tokpos[(size_t)row * 2 + 1];
    if (((p0 < tail0) && (p1 < tail0)) != EARLY) return;
    const float w0 = topw[(size_t)row * 2], w1 = topw[(size_t)row * 2 + 1];
    f32x4* xr = (f32x4*)(out + (size_t)row * DM) + lane; const v2u* y0 = (const v2u*)(Y + (size_t)p0 * DM) + lane; const v2u* y1 = (const v2u*)(Y + (size_t)p1 * DM) + lane;
#pragma unroll
    for (int j = 0; j < 4; ++j) { f32x4 v = xr[64 * j]; const v2u a = y0[64 * j], b = y1[64 * j];
        v.x += w0 * bflo(a.x) + w1 * bflo(b.x); v.y += w0 * bfhi(a.x) + w1 * bfhi(b.x); v.z += w0 * bflo(a.y) + w1 * bflo(b.y); v.w += w0 * bfhi(a.y) + w1 * bfhi(b.y); xr[64 * j] = v; }
}
__device__ __forceinline__ void moe_combine_late16(int row0, int lane, float* __restrict__ out, const bf16* __restrict__ Y, const int* __restrict__ tokpos, const float* __restrict__ topw, int tail0) {
    bool late = false;
    if (lane < 16) { const int p0 = tokpos[(size_t)(row0 + lane) * 2], p1 = tokpos[(size_t)(row0 + lane) * 2 + 1]; late = !((p0 < tail0) && (p1 < tail0)); }
    unsigned long long m = __ballot(late);
    while (m) { const int i = __builtin_ctzll(m); m &= m - 1; moe_combine<false>(row0 + i, lane, out, Y, tokpos, topw, tail0); }
}

constexpr int NPH = 16;
struct Args { const float* in[32]; float* out; unsigned char* ws; int ph_lo, ph_hi; };
typedef const __attribute__((address_space(4))) Args* KArgs;
__device__ __forceinline__ KArgs get_args() { KArgs p = (KArgs)__builtin_amdgcn_kernarg_segment_ptr(); asm volatile("" : "+s"(p)); return p; }
#define LOCALS  int tid = wave0 * 64 + (int)__builtin_amdgcn_mbcnt_hi(~0u, __builtin_amdgcn_mbcnt_lo(~0u, 0u)); asm volatile("" : "+v"(tid)); const int lane = tid & 63, wave = __builtin_amdgcn_readfirstlane(tid >> 6), gw = blockIdx.x * NWAVES + wave, gx = (((G & 7) == 0) ? ((int)(blockIdx.x & 7) * (G >> 3) + (int)(blockIdx.x >> 3)) : (int)blockIdx.x) * NWAVES + wave  , ngw = G * NWAVES, half = tid >> 8, htid = tid & 255; \
    LAS float* scr = (LAS float*)(lds + RING_OFF + wave * 16384); LAS float* hsm = (LAS float*)(lds + RING_OFF + half * 32768); (void)lane; (void)gw; (void)gx; (void)ngw; (void)htid; (void)scr; (void)hsm; \
    KArgs A_ = get_args(); unsigned char* ws = A_->ws; float* out = A_->out; \
    bf16* HN = (bf16*)(ws + WS_HN); bf16* PROJ = (bf16*)(ws + WS_PROJ); \
    bf16* MIXRAW = (bf16*)(ws + WS_MIXRAW); bf16* OCMP = MIXRAW + 256; bf16* OS = (bf16*)(ws + WS_OS); bf16* OW = (bf16*)(ws + WS_OW); bf16* HG = (bf16*)(ws + WS_HG); float* GA = (float*)(ws + WS_GA); float* GLAS = (float*)(ws + WS_GLAS); float* GLAD = (float*)(ws + WS_GLAD); float* S5X = (float*)(ws + WS_S5X); \
    float* KC = (float*)(ws + WS_KC); float* VC = (float*)(ws + WS_VC); unsigned long long* SEL = (unsigned long long*)(ws + WS_SEL); float* CW = (float*)(ws + WS_CW); \
    (void)GA; (void)GLAS; (void)GLAD; (void)S5X; (void)out; (void)HN; (void)PROJ; (void)MIXRAW; (void)OCMP; (void)OS; (void)OW; (void)HG; (void)KC; (void)VC; (void)SEL; (void)CW;
#define IN(i) (A_->in[i])
__global__ void __launch_bounds__(NWAVES * 64, 2) mk_fwd(Args args) {
    extern __shared__ __attribute__((aligned(16))) unsigned char lds_raw[];
    LAS unsigned char* lds = (LAS unsigned char*)lds_raw;
    const int G = gridDim.x;
    const int wave0 = __builtin_amdgcn_readfirstlane(threadIdx.x >> 6);
    for (int u = threadIdx.x; u < (LDS_BYTES - LDSCTL_OFF) / 4; u += NWAVES * 64) ((LAS unsigned*)(lds + LDSCTL_OFF))[u] = 0u;
    __syncthreads();
    volatile LAS unsigned* MISC = (volatile LAS unsigned*)(lds + MISC_OFF);
    XcdBarrier bar = xcd_barrier_post((unsigned*)(args.ws + WS_CTL) + CW_BAR, MISC + 8);
    const int lo = args.ph_lo, hi = args.ph_hi;
#ifndef PROBE_DUP
#define PROBE_DUP -1
#endif
#ifndef PROBE_SUB
#define PROBE_SUB -1
#endif
#define SUBREP(id) _Pragma("unroll") for (int rep2_ = 0; rep2_ < (((id) == PROBE_SUB) ? 2 : 1); ++rep2_)
#define PH(k) const int pc##k = l * NPH + (k); _Pragma("unroll") for (int rep_ = 0; rep_ < (((k) == PROBE_DUP) ? 2 : 1); ++rep_) if (lo <= pc##k && pc##k < hi)
#define SEAM(k) do { if (pc##k + 1 < hi) xcd_barrier(bar); } while (0)

    {   const int l = -1;
        PH(15) { LOCALS
            for (int ll = 0; ll < 2; ++ll) {
                ConvJob j1{IN(2) + (size_t)ll * DM * PROJ_SRC, nullptr, (bf16*)(ws + WS_WIN) + (size_t)ll * PW * DM, PROJ_SRC, DM, PROJ_SRC, PW, DM, 1, 0, ll == 1 ? IN(1) + DM : nullptr};
                conv_run(j1, scr, gw, ngw, lane);
                ConvJob j2{IN(22) + (size_t)ll * DM * DM, nullptr, (bf16*)(ws + WS_WOUT) + (size_t)ll * DM * DM, DM, DM, DM, DM, DM, 0, 0};
                conv_fast(j2, gw, ngw, lane);
                for (int wh = 0; wh < 2; ++wh) { ConvJob j6{IN(6) + (size_t)(ll * 2 + wh) * 2048 * 256, nullptr, (bf16*)(ws + WS_W1CT) + (size_t)(ll * 2 + wh) * 256 * 2048, 256, 2048, 256, 256, 2048, 0, 0};
                    conv_fast(j6, gw, ngw, lane); }
                for (int wh = 0; wh < 2; ++wh) { ConvJob j7{IN(7) + (size_t)(ll * 2 + wh) * 256 * 64, nullptr, (bf16*)(ws + WS_W2T) + (size_t)(ll * 2 + wh) * 64 * 256, 64, 256, 64, 64, 256, 0, 0};
                    conv_run(j7, scr, gw, ngw, lane); }
                ConvJob j5{IN(19) + (size_t)ll * 65536, nullptr, (bf16*)(ws + WS_WGLU) + (size_t)ll * 65536, 256, 256, 256, 256, 256, 0, 0};
                conv_fast(j5, gw, ngw, lane);
            }
            {   const int o = blockIdx.x * 512 + tid;
                if (o < 1024) { const float* pp = IN(5) + (size_t)(o >> 8) * 2048; const float* wp = IN(6) + (size_t)(o >> 8) * 2048 * 256 + (o & 255); float a = 0.f;
                    _Pragma("unroll 64") for (int i = 0; i < 2048; ++i) a += pp[i] * wp[(size_t)i * 256];
                    ((float*)(ws + WS_BIASP))[o] = a; } }
            for (int it = blockIdx.x * 512 + tid; it < 2 * 1024 * 16; it += G * 512) { const int ll = it >> 14, gn = (it >> 4) & 1023;
                s5_table_item(gn, it & 15, IN(11) + ll * 1024, IN(12) + ll * 1024, IN(13) + ll * 16384, IN(14) + ll * 16384, IN(18) + ll * 16, (f32x2*)(ws + WS_S5TAB) + (size_t)ll * 1024 * 48); }
        }
    }
#pragma clang loop unroll(full)
    for (int l = 0; l < 2; ++l) {
        PH(0) { LOCALS
            if (l == 0) { for (int row = gw; row < NT; row += ngw) k_norm<false>(row, lane, IN(0), IN(1), HN, nullptr, nullptr, nullptr);
                SEAM(0); }
        }
        PH(1) { LOCALS
            pg8::StaticOrder S; S.init(NT, PW, G, (int)blockIdx.x);
            if (l == 0) { pg8::Gemm g{HN, (bf16*)(ws + WS_WIN), NT, PW, DM}; pg8::EpiStoreBf16 Ep{PROJ, PW};
                pg8::gemm_phase<pg8::EpiStoreBf16, pg8::StaticOrder, false, true>(lds + RING_OFF, g, S, Ep, nullptr, wave0); }
            else { pg8::Gemm g{(bf16*)(ws + WS_XB), (bf16*)(ws + WS_WIN) + (size_t)PW * DM, NT, PW, DM}; pg8::EpiStoreBf16N Ep{PROJ, PW, (const float*)(ws + WS_SSQ)};
                pg8::gemm_phase<pg8::EpiStoreBf16N, pg8::StaticOrder, false, true>(lds + RING_OFF, g, S, Ep, nullptr, wave0); }
            SEAM(1);
        }
        PH(2) { LOCALS
            if (blockIdx.x < 16) {
                LAS unsigned short* gidx = (LAS unsigned short*)(lds + GIDX_OFF);
                if (tid < 256) { int R = 256 * (blockIdx.x & 7) + tid; R = R < NB * NCMP ? R : NB * NCMP - 1; const int bb = R / NCMP, cc = R - bb * NCMP;
                    gidx[tid] = (unsigned short)((bb * SQ + 16 * cc) | ((blockIdx.x >> 3) << 15)); }
                __syncthreads();
                pg8::Gemm g{PROJ + P_KC, (bf16*)(ws + WS_W1CT) + (size_t)l * 512 * 2048, 4096, 512, 2048, PW, PW * 2, P_VC - P_KC};
                pg8::FirstNOrder S{16, (int)blockIdx.x, 8}; pg8::EpiGeluBias Ep{(bf16*)(ws + WS_CHID), 256, (const float*)(ws + WS_BIASP) + l * 512};
                pg8::gemm_phase<pg8::EpiGeluBias, pg8::FirstNOrder, true, true, true>(lds + RING_OFF, g, S, Ep, gidx, wave0);
            }
            if (G > 32) {
                if (blockIdx.x >= 16) { const int gw2 = gw - 16 * NWAVES, ngw2 = ngw - 16 * NWAVES;
                    if (wave & 4) s5_mfma_pass<false>(gw2, ngw2, lane, (LAS unsigned char*)scr, PROJ, (const f32x2*)(ws + WS_S5TAB) + (size_t)l * 1024 * 48, nullptr, nullptr, nullptr, S5X, nullptr);
                    for (int r8 = gw2; r8 < NT / 8; r8 += ngw2) headnorm8(8 * r8, lane, PROJ, IN(3) + l * 128, IN(4) + l * 256);
                    for (int row = gw2; row < NT; row += ngw2) gla_gate_row(row, lane, PROJ, IN(8) + l * 16 * 128, IN(9) + l * 128, GA);
                    if (!(wave & 4)) s5_mfma_pass<false>(gw2, ngw2, lane, (LAS unsigned char*)scr, PROJ, (const f32x2*)(ws + WS_S5TAB) + (size_t)l * 1024 * 48, nullptr, nullptr, nullptr, S5X, nullptr); }
            } else {
                for (int r8 = gw; r8 < NT / 8; r8 += ngw) headnorm8(8 * r8, lane, PROJ, IN(3) + l * 128, IN(4) + l * 256);
                for (int row = gw; row < NT; row += ngw) gla_gate_row(row, lane, PROJ, IN(8) + l * 16 * 128, IN(9) + l * 128, GA);
            }
            SEAM(2);
        }
        PH(3) { LOCALS
            if (wave & 4) { for (int job = gx; job < NB * 4 * NSEG; job += ngw) gla_seg<false>(job, lane, (LAS unsigned char*)scr, PROJ, GA, GLAS, GLAD, nullptr, nullptr); }
            SUBREP(35) for (int jw = gw; jw < 256; jw += ngw) cmp_second_job(jw, lane, (const bf16*)(ws + WS_CHID), (const bf16*)(ws + WS_W2T) + (size_t)l * 2 * 64 * 256, IN(4) + l * 256 + 64, (bf16*)(ws + WS_KCB), (bf16*)(ws + WS_VCB));
            SUBREP(31) for (int job = gx; job < NB * 4 * 128; job += ngw) dil_p1_job(job, lane, (LAS unsigned char*)scr, PROJ, (float*)(ws + WS_DO1), (float*)(ws + WS_DL1));
            SUBREP(32) for (int rnd = 0, job; rnd * ngw < NT / 8; ++rnd) if ((job = rnd * ngw + ((rnd & 1) ? (ngw - 1 - gx) : gx)) < NT / 8) nsa_win_job(job, lane, (LAS unsigned char*)scr, PROJ, OW);
            if (!(wave & 4)) { for (int job = gx; job < NB * 4 * NSEG; job += ngw) gla_seg<false>(job, lane, (LAS unsigned char*)scr, PROJ, GA, GLAS, GLAD, nullptr, nullptr); }
            if (G <= 32) { SUBREP(34) s5_mfma_pass<false>(gx, ngw, lane, (LAS unsigned char*)scr, PROJ, (const f32x2*)(ws + WS_S5TAB) + (size_t)l * 1024 * 48, nullptr, nullptr, nullptr, S5X, nullptr); }
            SEAM(3);
        }
        PH(4) { LOCALS
            { LOCALS
              if (G >= NB * 4 * 8) {
                  if (wave == 7 && (int)blockIdx.x < NB * 4 * 8) gla_scan((int)blockIdx.x, lane, GLAS, GLAD);
                  else if (wave == 6 && (int)blockIdx.x < NB * 16) s5_scan((int)blockIdx.x, lane, IN(11) + l * 1024, IN(12) + l * 1024, IN(18) + l * 16, S5X);
              } else {
                  if (gw < NB * 4 * 8) gla_scan(gw, lane, GLAS, GLAD);
                  else if (gw < NB * 4 * 8 + NB * 16) s5_scan(gw - NB * 4 * 8, lane, IN(11) + l * 1024, IN(12) + l * 1024, IN(18) + l * 16, S5X); } }
            { LOCALS
            SUBREP(41) for (int rnd = 0, job; rnd * ngw < NT / 8; ++rnd) if ((job = rnd * ngw + ((rnd & 1) ? (ngw - 1 - gx) : gx)) < NT / 8) nsa_cmp_job(job, lane, (LAS unsigned char*)scr, PROJ, (const bf16*)(ws + WS_KCB), (const bf16*)(ws + WS_VCB), OCMP, 1024, SEL);
            SUBREP(42) for (int job = gx; job < NB * 4 * 16 * 16; job += ngw) dil_job(job, lane, (LAS unsigned char*)scr, PROJ, MIXRAW, (const float*)(ws + WS_DO1), (const float*)(ws + WS_DL1)); }
            SEAM(4);
        }
        PH(5) { LOCALS
            if (wave & 4) { for (int job = gx; job < NB * 4 * NSEG; job += ngw) gla_seg<true>(job, lane, (LAS unsigned char*)scr, PROJ, GA, GLAS, GLAD, IN(10) + l * 64, MIXRAW);
                s5_mfma_pass<true>(gx, ngw, lane, (LAS unsigned char*)scr, PROJ, (const f32x2*)(ws + WS_S5TAB) + (size_t)l * 1024 * 48, IN(15) + l * 16384, IN(16) + l * 16384, IN(17) + l * 256, S5X, HG); }
            SUBREP(51) for (int rnd = 0, job; rnd * ngw < NT / 8; ++rnd) if ((job = rnd * ngw + ((rnd & 1) ? (ngw - 1 - gx) : gx)) < NT / 8) nsa_sel_job(job, lane, (LAS unsigned char*)scr, PROJ, SEL, OS);
            if (!(wave & 4)) { for (int job = gx; job < NB * 4 * NSEG; job += ngw) gla_seg<true>(job, lane, (LAS unsigned char*)scr, PROJ, GA, GLAS, GLAD, IN(10) + l * 64, MIXRAW);
                s5_mfma_pass<true>(gx, ngw, lane, (LAS unsigned char*)scr, PROJ, (const f32x2*)(ws + WS_S5TAB) + (size_t)l * 1024 * 48, IN(15) + l * 16384, IN(16) + l * 16384, IN(17) + l * 256, S5X, HG); }
            SEAM(5);
        }
        PH(6) { LOCALS
            pg8::Gemm g{HG, (bf16*)(ws + WS_WGLU) + (size_t)l * 65536, NT, 256, 256}; pg8::StaticOrder S; S.init(NT, 256, G, (int)blockIdx.x);
            pg8::EpiGlu Ep{HG, IN(20) + l * 256, MIXRAW + 768, 1024};
            pg8::gemm_phase<pg8::EpiGlu, pg8::StaticOrder, true, true>(lds + RING_OFF, g, S, Ep, nullptr, wave0);
            {   const int c0 = (G > 128) ? 128 : 0;
                if ((int)blockIdx.x >= c0) { const int gw2 = gw - c0 * NWAVES, ngw2 = ngw - c0 * NWAVES;
                    if (l == 0) {
                        ConvJob j3{IN(24), IN(25), (bf16*)(ws + WS_WFGU), DFF, DM, DFF, 2 * DFFP, DM, 2, 0, IN(23)};
                        conv_fast(j3, gw2, ngw2, lane);
                        ConvJob j4{IN(26), nullptr, (bf16*)(ws + WS_WFDN), DM, DFF, DM, DM, DFFP, 0, 0};
                        conv_fast(j4, gw2, ngw2, lane);
                    } else {
                        constexpr int NIT = (MOE_HH / 32) * (DM / 256);
                        for (int git = 4 * NIT + gw2; git < NEXP * NIT; git += ngw2) { const int e = git / NIT;
                            ConvJob j2{IN(31) + (size_t)e * DFE * DM, nullptr, (bf16*)(ws + WS_W2H) + (size_t)e * DM * MOE_HH, DM, MOE_HH, DM, DM, MOE_HH, 0, 0};
                            conv_fast_item(j2, git - e * NIT, lane); } } } }
            SEAM(6);
        }
        PH(7) { LOCALS
            for (int row = gw; row < NT; row += ngw) mixfinal_row(row, lane, PROJ, MIXRAW, OS, OW, IN(21) + l * 1024, HN);
            SEAM(7);
        }
        PH(8) { LOCALS
            pg8::Gemm g{HN, (bf16*)(ws + WS_WOUT) + (size_t)l * DM * DM, NT, DM, DM}; pg8::StaticOrder S; S.init(NT, DM, G, (int)blockIdx.x);
            if (l == 0) { pg8::EpiResF32N Ep{IN(0), out, (bf16*)(ws + WS_XB), (float*)(ws + WS_SSQ)};
                pg8::gemm_phase<pg8::EpiResF32N, pg8::StaticOrder, true, true>(lds + RING_OFF, g, S, Ep, nullptr, wave0); }
            else { pg8::EpiResF32 Ep{(const float*)out, out, DM};
                pg8::gemm_phase<pg8::EpiResF32, pg8::StaticOrder, true, true>(lds + RING_OFF, g, S, Ep, nullptr, wave0); }
            SEAM(8);
        }
#define MOE_VCU ((((G & 7) == 0) ? ((int)(blockIdx.x & 7) * (G >> 3) + (int)(blockIdx.x >> 3)) : (int)blockIdx.x))
#define MOE_CONV_W1(hf, c0) do { constexpr int NIT = (DM / 32) * (MOE_NPN * 256 / 256); if (MOE_VCU >= (c0)) for (int git = (MOE_VCU - (c0)) * NWAVES + wave; git < NEXP * NIT; git += ngw - (c0) * NWAVES) { const int e = git / NIT; \
                ConvJob j1{IN(29) + (size_t)e * DM * DFE, IN(30) + (size_t)e * DM * DFE, (bf16*)(ws + WS_W1H) + (size_t)e * MOE_NPN * 256 * DM, DFE, DM, DFE, MOE_NPN * 256, DM, 2, (hf) * MOE_HH}; \
                conv_fast_item(j1, git - e * NIT, lane); } } while (0)
#define MOE_CONV_W2(hf, c0, ne) do { constexpr int NIT = (MOE_HH / 32) * (DM / 256); if (MOE_VCU >= (c0)) for (int git = (MOE_VCU - (c0)) * NWAVES + wave; git < (ne) * NIT; git += ngw - (c0) * NWAVES) { const int e = git / NIT; \
                ConvJob j2{IN(31) + (size_t)e * DFE * DM + (size_t)(hf) * MOE_HH * DM, nullptr, (bf16*)(ws + WS_W2H) + (size_t)e * DM * MOE_HH, DM, MOE_HH, DM, DM, MOE_HH, 0, 0}; \
                conv_fast_item(j2, git - e * NIT, lane); } } while (0)
        PH(9) { LOCALS
            if (l == 1) { if (wave & 1) MOE_CONV_W1(0, 0);
                for (int vb = blockIdx.x; vb < 256; vb += G) moe_route(vb, wave, lane, out, IN(23) + l * DM, IN(27), IN(28), HN, (unsigned*)(ws + WS_TOKINFO), (float*)(ws + WS_TOPW), (int*)(ws + WS_WCNT));
                if (!(wave & 1)) MOE_CONV_W1(0, 0);
                SEAM(9); }
        }
        if (l == 0) {
            PH(10) { LOCALS
                {   pg8::Gemm g{(bf16*)(ws + WS_XB), (bf16*)(ws + WS_WFGU), NT, 2 * DFFP, DM}; pg8::StaticOrder S; S.init(NT, 2 * DFFP, G, (int)blockIdx.x);
                    pg8::EpiSwigluN Ep{(bf16*)(ws + WS_FH), DFFP, 1 << 20, (const float*)(ws + WS_SSQ)};
                    pg8::gemm_phase<pg8::EpiSwigluN, pg8::StaticOrder, true, true>(lds + RING_OFF, g, S, Ep, nullptr, wave0); }
                xcd_barrier(bar);
                {   pg8::Gemm g{(bf16*)(ws + WS_FH), (bf16*)(ws + WS_WFDN), NT, DM, DFFP}; pg8::StaticOrder S; S.init(NT, DM, G, (int)blockIdx.x);
                    pg8::EpiResF32N Ep{out, out, (bf16*)(ws + WS_XB), (float*)(ws + WS_SSQ)};
                    pg8::gemm_phase<pg8::EpiResF32N, pg8::StaticOrder, true, true>(lds + RING_OFF, g, S, Ep, nullptr, wave0); }
                SEAM(10);
            }
        } else {
#define MOE_ORDER(S, NPNL) pg8::MoeOrder S; { const int* mt = (const int*)(ws + WS_MTAB); _Pragma("unroll") for (int e = 0; e < 9; ++e) S.ts[e] = __builtin_amdgcn_readfirstlane(mt[e]); S.npn = (NPNL); S.nunits = S.ts[8] * (NPNL); S.G = G; S.c = ((G & 7) == 0) ? ((int)(blockIdx.x & 7) * (G >> 3) + (int)(blockIdx.x >> 3)) : (int)blockIdx.x; }
#define MOE_GU() do { MOE_ORDER(S, MOE_NPN); \
                LAS unsigned short* gidx = (LAS unsigned short*)(lds + GIDX_OFF); const unsigned short* rowtok = (const unsigned short*)(ws + WS_ROWTOK); \
                { pg8::Unit u; for (int i = 0; S.next(i, u); ++i) { if (tid < 256) gidx[i * 256 + tid] = rowtok[u.pm * 256 + tid]; } } \
                __syncthreads(); \
                pg8::Gemm g{HN, (bf16*)(ws + WS_W1H), NT, NEXP * MOE_NPN * 256, DM, DM, 128, 0}; pg8::EpiSwiglu Ep{(bf16*)(ws + WS_MHID), MOE_HH, MOE_NPN}; \
                pg8::gemm_phase<pg8::EpiSwiglu, pg8::MoeOrder, true, true, true>(lds + RING_OFF, g, S, Ep, gidx, wave0); } while (0)
            PH(10) { LOCALS
                for (int vb = blockIdx.x; vb < 256; vb += G) moe_assign(vb, tid, (LAS int*)(lds + RING_OFF + 65536), (const int*)(ws + WS_WCNT), (const unsigned*)(ws + WS_TOKINFO), (unsigned short*)(ws + WS_ROWTOK), (int*)(ws + WS_TOKPOS), (int*)(ws + WS_MTAB));
                SEAM(10);
            }
            PH(11) { LOCALS
                MOE_GU();
                { const int* mt = (const int*)(ws + WS_MTAB); const int rem = (__builtin_amdgcn_readfirstlane(mt[8]) * MOE_NPN) % G; const int c0 = (rem <= G / 2) ? rem : 0;
                  MOE_CONV_W2(0, c0, 4); }
                SEAM(11);
            }
            PH(12) { LOCALS
                {   MOE_ORDER(S, 4);
                    pg8::Gemm g{(bf16*)(ws + WS_MHID), (bf16*)(ws + WS_W2H), MOE_ROWS, NEXP * DM, MOE_HH}; pg8::EpiYBf16<false> Ep{(bf16*)(ws + WS_MY), DM, 4};
                    pg8::gemm_phase<pg8::EpiYBf16<false>, pg8::MoeOrder, true, true>(lds + RING_OFF, g, S, Ep, nullptr, wave0); }
                { const int* mt = (const int*)(ws + WS_MTAB); const int rem = (__builtin_amdgcn_readfirstlane(mt[8]) * 4) % G; const int c0 = (rem <= G / 2) ? rem : 0;
                  MOE_CONV_W1(1, c0); }
                SEAM(12);
            }
            PH(13) { LOCALS
                MOE_GU();
                { const int* mt = (const int*)(ws + WS_MTAB); const int rem = (__builtin_amdgcn_readfirstlane(mt[8]) * MOE_NPN) % G; const int c0 = (rem <= G / 2) ? rem : 0;
                  MOE_CONV_W2(1, c0, NEXP); }
                SEAM(13);
            }
            PH(14) {
                int tail0 = 0x7fffffff, rem = 0, vc = 0;
                {   LOCALS MOE_ORDER(S, 4);
                    const int nun = S.nunits, nfull0 = (nun / G) * G, rem0 = nun - nfull0; const bool split = (rem0 > 0) && (rem0 * 4 <= G) && ((nfull0 & 31) == 0);
                    if (split) { S.nunits = nfull0; rem = rem0; tail0 = (nfull0 >> 2) * 256; }
                    vc = S.c;
                    pg8::Gemm g{(bf16*)(ws + WS_MHID), (bf16*)(ws + WS_W2H), MOE_ROWS, NEXP * DM, MOE_HH}; pg8::EpiYBf16<true> Ep{(bf16*)(ws + WS_MY), DM, 4};
                    pg8::gemm_phase<pg8::EpiYBf16<true>, pg8::MoeOrder, true, true>(lds + RING_OFF, g, S, Ep, nullptr, wave0); }
                xcd_barrier(bar);
                if (vc < rem) { LOCALS MOE_ORDER(S, 4);
                    S.c = (S.nunits / G) * G + S.c; S.G = 1 << 24;
                    pg8::Gemm g{(bf16*)(ws + WS_MHID), (bf16*)(ws + WS_W2H), MOE_ROWS, NEXP * DM, MOE_HH}; pg8::EpiYBf16<true> Ep{(bf16*)(ws + WS_MY), DM, 4};
                    pg8::gemm_phase<pg8::EpiYBf16<true>, pg8::MoeOrder, true, true>(lds + RING_OFF, g, S, Ep, nullptr, wave0);
                    asm volatile("s_waitcnt vmcnt(0)" ::: "memory"); __syncthreads();
                    if (threadIdx.x == 0) { unsigned* tb = (unsigned*)(ws + WS_CTL) + CW_TAIL;
                        __builtin_amdgcn_fence(__ATOMIC_RELEASE, "agent"); asm volatile("s_waitcnt vmcnt(0)" ::: "memory");
                        (void)xb_add(tb, 1u);
                        XB_SPIN(xb_ld(tb) < (unsigned)rem, bar.bar);
                        __builtin_amdgcn_fence(__ATOMIC_ACQUIRE, "agent"); asm volatile("s_waitcnt vmcnt(0)" ::: "memory"); }
                    __syncthreads();
                    { LOCALS
                      for (int r16 = vc * NWAVES + wave; r16 < NT / 16; r16 += rem * NWAVES) moe_combine_late16(16 * r16, lane, out, (const bf16*)(ws + WS_MY), (const int*)(ws + WS_TOKPOS), (const float*)(ws + WS_TOPW), tail0); }
                } else { LOCALS
                    for (int row = (vc - rem) * NWAVES + wave; row < NT; row += (G - rem) * NWAVES) moe_combine<true>(row, lane, out, (const bf16*)(ws + WS_MY), (const int*)(ws + WS_TOKPOS), (const float*)(ws + WS_TOPW), tail0); }
            }
#undef MOE_VCU
#undef MOE_CONV_W1
#undef MOE_CONV_W2
#undef MOE_ORDER
#undef MOE_GU
        }
    }
#undef PH
#undef SEAM
}

#ifndef MK_SPLIT
#define MK_SPLIT 0
#endif
extern "C" void kernel_launch(void* const* d_in, const int* in_sizes, int n_in, void* d_out, int out_size, void* d_ws, size_t ws_size, hipStream_t stream) {
    static int grid = 0;
    if (grid == 0) {
        if (n_in != 32 || in_sizes[0] != NT * DM || out_size != NT * DM || ws_size < WS_END) { fprintf(stderr, "kernel_launch: unexpected shapes (n_in %d, in0 %d, out %d, ws %zu)\n", n_in, n_in > 0 ? in_sizes[0] : -1, out_size, ws_size); grid = -1; return; }
        int dev = 0, cus = 0, per_cu = 0;
        if (hipGetDevice(&dev) != hipSuccess || hipDeviceGetAttribute(&cus, hipDeviceAttributeMultiprocessorCount, dev) != hipSuccess) { grid = -1; return; }
        if (hipFuncSetAttribute((const void*)mk_fwd, hipFuncAttributeMaxDynamicSharedMemorySize, LDS_BYTES) != hipSuccess) { fprintf(stderr, "kernel_launch: hipFuncSetAttribute failed\n"); grid = -1; return; }
        if (hipOccupancyMaxActiveBlocksPerMultiprocessor(&per_cu, (const void*)mk_fwd, NWAVES * 64, LDS_BYTES) != hipSuccess || per_cu < 1) { fprintf(stderr, "kernel_launch: occupancy query says %d blocks per CU\n", per_cu); }
        (void)hipGetLastError();
        grid = cus;
    }
    if (grid < 0) return;
    (void)hipMemsetAsync((unsigned char*)d_ws + WS_CTL, 0, CTL_ZERO_BYTES, stream);
    Args a{};
    for (int i = 0; i < 32; ++i) a.in[i] = (const float*)d_in[i];
    a.out = (float*)d_out; a.ws = (unsigned char*)d_ws;
#if MK_SPLIT
    for (int pc = -1; pc < 2 * NPH; ++pc) { const int k = (pc < 0) ? 15 : pc % NPH; if (pc >= 0 && pc < NPH && k > 10) continue; a.ph_lo = pc; a.ph_hi = pc + 1; hipLaunchKernelGGL(mk_fwd, dim3(grid), dim3(NWAVES * 64), LDS_BYTES, stream, a); }
#else
    a.ph_lo = -1; a.ph_hi = 2 * NPH;
    hipLaunchKernelGGL(mk_fwd, dim3(grid), dim3(NWAVES * 64), LDS_BYTES, stream, a);
#endif
}
```

```cpp
#include <hip/hip_runtime.h>
#include <cstdio>
#include <cstdint>
namespace pg8 {
#define PG8_LAS __attribute__((address_space(3)))
typedef unsigned short bf16_t;
typedef short bf16x8 __attribute__((ext_vector_type(8)));
typedef float f32x4 __attribute__((ext_vector_type(4)));
typedef unsigned u32x4 __attribute__((ext_vector_type(4)));
constexpr int BM = 256, BK = 64, HALF = 128, HTB = HALF * BK * 2  , STAGE_BYTES = 8 * HTB, NXCD = 8, WGM = 8;

__host__ __device__ __forceinline__ int lds_byte(int r, int c) { const int st = (r >> 4) * 2 + (c >> 5), rr = r & 15, cc = c & 31, ob = rr * 64 + cc * 2; return st * 1024 + (ob ^ (((ob >> 9) & 1) << 5)); }
__host__ __device__ __forceinline__ void stage_rc(int b, int& R, int& C) { const int st = b / 1024, sb = b % 1024, swz = sb ^ (((sb >> 9) & 1) << 5); R = (st >> 1) * 16 + swz / 64; C = (st & 1) * 32 + (swz % 64) / 2; }
__host__ __device__ __forceinline__ int perm32(int rho) { const int n = rho >> 4, i = rho & 15; return 8 * (i >> 2) + 4 * n + (i & 3); }

struct Unit { int pm, pn; };
struct Gemm { const bf16_t* A; const bf16_t* Bt; int M, N, K; int lda = 0, kstepA = 0, hiofs = 0; };

struct StaticOrder {
    int nM, nN, nwg, G, c;
    __host__ __device__ void init(int M, int N, int G_, int c_) { nM = M / BM; nN = N / BM; nwg = nM * nN; G = G_; c = c_; }
    __host__ __device__ bool next(int i, Unit& u) const {
        const long L = (long)i * G + c; if (L >= nwg) return false;
        int wgid = (int)L; { const int q = nwg / NXCD, r = nwg % NXCD, xcd = wgid % NXCD, off = wgid / NXCD; wgid = (xcd < r ? xcd * (q + 1) : r * (q + 1) + (xcd - r) * q) + off; }
        const int nig = WGM * nN, gid = wgid / nig, fm = gid * WGM, gsz = (nM - fm) < WGM ? (nM - fm) : WGM;
        u.pm = fm + ((wgid % nig) % gsz); u.pn = (wgid % nig) / gsz; return true;
    }
    __device__ __forceinline__ void a_ready(const Unit&) const {}
    __device__ __forceinline__ void done(const Unit&) const {}
};

typedef float f32x2c_t __attribute__((ext_vector_type(2))); typedef __bf16 bf16x2c_t __attribute__((ext_vector_type(2)));
__device__ __forceinline__ unsigned cvt_pk_bf16(float lo, float hi) { f32x2c_t v = {lo, hi}; bf16x2c_t b = __builtin_convertvector(v, bf16x2c_t); return __builtin_bit_cast(unsigned, b); }
typedef float f32x2 __attribute__((ext_vector_type(2)));
__device__ __forceinline__ f32x2 gelu_pk(f32x2 v) {
    const f32x2 av = __builtin_elementwise_abs(v), d = av * 0.2316418882f + 1.0f;
    f32x2 t; t.x = __builtin_amdgcn_rcpf(d.x); t.y = __builtin_amdgcn_rcpf(d.y);
    f32x2 q = t * 0.5307027145f + (-0.7265760135f); q = q * t + 0.7107068705f; q = q * t + (-0.142248368f); q = q * t + 0.127414796f; q = q * t;
    const f32x2 s = (v * v) * (-0.72134752044f);
    f32x2 e; e.x = __builtin_amdgcn_exp2f(s.x); e.y = __builtin_amdgcn_exp2f(s.y);
    const f32x2 m = v * (q * e), r = v - m;
    f32x2 o; o.x = v.x < 0.f ? m.x : r.x; o.y = v.y < 0.f ? m.y : r.y; return o;
}


__device__ __forceinline__ float silu_f(float x) { return x * __builtin_amdgcn_rcpf(1.0f + __expf(-x)); }
struct EpiStoreBf16 {
    static constexpr bool PERM = true, AFTER_DRAIN = false;
    bf16_t* O; int ldc;
    __device__ __forceinline__ void operator()(const f32x4 (&acc)[2][2][4][2], const Unit& u, int wr, int wc, int fr, int fq) const {
        const int row0 = u.pm * BM + wr * 64 + fr, col0 = u.pn * BM + wc * 32 + 8 * fq;
#pragma unroll
        for (int ai = 0; ai < 2; ++ai)
#pragma unroll
            for (int m = 0; m < 4; ++m) { bf16_t* rowp = O + (size_t)(row0 + ai * HALF + m * 16) * ldc + col0;
#pragma unroll
                for (int bj = 0; bj < 2; ++bj) { const f32x4 v0 = acc[ai][bj][m][0], v1 = acc[ai][bj][m][1];
                    u32x4 w; w.x = cvt_pk_bf16(v0[0], v0[1]); w.y = cvt_pk_bf16(v0[2], v0[3]); w.z = cvt_pk_bf16(v1[0], v1[1]); w.w = cvt_pk_bf16(v1[2], v1[3]);
                    *(u32x4*)(rowp + bj * HALF) = w; } }
    }
};
struct EpiResF32 {
    static constexpr bool PERM = true, AFTER_DRAIN = false;
    const float* R; float* O; int ldc;
    __device__ __forceinline__ void operator()(const f32x4 (&acc)[2][2][4][2], const Unit& u, int wr, int wc, int fr, int fq) const {
        const int row0 = u.pm * BM + wr * 64 + fr, col0 = u.pn * BM + wc * 32 + 8 * fq;
#pragma unroll
        for (int ai = 0; ai < 2; ++ai)
#pragma unroll
            for (int m = 0; m < 4; ++m) { const size_t ro = (size_t)(row0 + ai * HALF + m * 16) * ldc + col0;
#pragma unroll
                for (int bj = 0; bj < 2; ++bj) { const float* rp = R + ro + bj * HALF; float* op = O + ro + bj * HALF;
                    const f32x4 r0 = *(const f32x4*)rp, r1 = *(const f32x4*)(rp + 4);
                    *(f32x4*)op = r0 + acc[ai][bj][m][0]; *(f32x4*)(op + 4) = r1 + acc[ai][bj][m][1]; } }
    }
};
struct EpiResScaledF32 {
    static constexpr bool PERM = true, AFTER_DRAIN = false;
    float* O; int ldc; const float* cw; int cws, cwo;
    __device__ __forceinline__ void operator()(const f32x4 (&acc)[2][2][4][2], const Unit& u, int wr, int wc, int fr, int fq) const {
        const int row0 = u.pm * BM + wr * 64 + fr, col0 = u.pn * BM + wc * 32 + 8 * fq;
#pragma unroll
        for (int ai = 0; ai < 2; ++ai)
#pragma unroll
            for (int m = 0; m < 4; ++m) { const int row = row0 + ai * HALF + m * 16; const size_t ro = (size_t)row * ldc + col0; const float w = cw[(size_t)row * cws + cwo];
                if (w != 0.f) {
#pragma unroll
                for (int bj = 0; bj < 2; ++bj) { float* op = O + ro + bj * HALF;
                    const f32x4 r0 = *(const f32x4*)op, r1 = *(const f32x4*)(op + 4);
                    *(f32x4*)op = r0 + acc[ai][bj][m][0] * w; *(f32x4*)(op + 4) = r1 + acc[ai][bj][m][1] * w; } } }
    }
};
struct EpiSwiglu {
    static constexpr bool PERM = true, AFTER_DRAIN = false;
    bf16_t* H; int ldh; int npn;
    __device__ __forceinline__ void operator()(const f32x4 (&acc)[2][2][4][2], const Unit& u, int wr, int wc, int fr, int fq) const {
        const int row0 = u.pm * BM + wr * 64 + fr, col0 = (u.pn % npn) * HALF + wc * 32 + 8 * fq;
#pragma unroll
        for (int ai = 0; ai < 2; ++ai)
#pragma unroll
            for (int m = 0; m < 4; ++m) { bf16_t* rowp = H + (size_t)(row0 + ai * HALF + m * 16) * ldh + col0;
                const f32x4 g0 = acc[ai][0][m][0], g1 = acc[ai][0][m][1], u0 = acc[ai][1][m][0], u1 = acc[ai][1][m][1];
                u32x4 w; w.x = cvt_pk_bf16(silu_f(g0[0]) * u0[0], silu_f(g0[1]) * u0[1]); w.y = cvt_pk_bf16(silu_f(g0[2]) * u0[2], silu_f(g0[3]) * u0[3]);
                w.z = cvt_pk_bf16(silu_f(g1[0]) * u1[0], silu_f(g1[1]) * u1[1]); w.w = cvt_pk_bf16(silu_f(g1[2]) * u1[2], silu_f(g1[3]) * u1[3]);
                *(u32x4*)rowp = w; }
    }
};
struct EpiGlu {
    static constexpr bool PERM = true, AFTER_DRAIN = false;
    const bf16_t* HG; const float* gb; bf16_t* O; int ldo;
    __device__ __forceinline__ void operator()(const f32x4 (&acc)[2][2][4][2], const Unit& u, int wr, int wc, int fr, int fq) const {
        const int row0 = u.pm * BM + wr * 64 + fr, col0 = u.pn * BM + wc * 32 + 8 * fq;
#pragma unroll
        for (int ai = 0; ai < 2; ++ai)
#pragma unroll
            for (int m = 0; m < 4; ++m) { const int row = row0 + ai * HALF + m * 16;
#pragma unroll
                for (int bj = 0; bj < 2; ++bj) { const int col = col0 + bj * HALF;
                    const u32x4 hw = *(const u32x4*)(HG + (size_t)row * 256 + col);
                    const f32x4 b0 = *(const f32x4*)(gb + col), b1 = *(const f32x4*)(gb + col + 4);
                    const f32x4 z0 = acc[ai][bj][m][0] + b0, z1 = acc[ai][bj][m][1] + b1;
                    f32x4 o0, o1;
                    o0[0] = __builtin_bit_cast(float, hw.x << 16) * __builtin_amdgcn_rcpf(1.0f + __expf(-z0[0])); o0[1] = __builtin_bit_cast(float, hw.x & 0xffff0000u) * __builtin_amdgcn_rcpf(1.0f + __expf(-z0[1]));
                    o0[2] = __builtin_bit_cast(float, hw.y << 16) * __builtin_amdgcn_rcpf(1.0f + __expf(-z0[2])); o0[3] = __builtin_bit_cast(float, hw.y & 0xffff0000u) * __builtin_amdgcn_rcpf(1.0f + __expf(-z0[3]));
                    o1[0] = __builtin_bit_cast(float, hw.z << 16) * __builtin_amdgcn_rcpf(1.0f + __expf(-z1[0])); o1[1] = __builtin_bit_cast(float, hw.z & 0xffff0000u) * __builtin_amdgcn_rcpf(1.0f + __expf(-z1[1]));
                    o1[2] = __builtin_bit_cast(float, hw.w << 16) * __builtin_amdgcn_rcpf(1.0f + __expf(-z1[2])); o1[3] = __builtin_bit_cast(float, hw.w & 0xffff0000u) * __builtin_amdgcn_rcpf(1.0f + __expf(-z1[3]));
                    u32x4 w; w.x = cvt_pk_bf16(o0[0], o0[1]); w.y = cvt_pk_bf16(o0[2], o0[3]); w.z = cvt_pk_bf16(o1[0], o1[1]); w.w = cvt_pk_bf16(o1[2], o1[3]);
                    *(u32x4*)(O + (size_t)row * ldo + col) = w; } }
    }
};
template <bool ACC> struct EpiYBf16 {
    static constexpr bool PERM = true, AFTER_DRAIN = false;
    bf16_t* Y; int ldc; int npn;
    __device__ __forceinline__ void operator()(const f32x4 (&acc)[2][2][4][2], const Unit& u, int wr, int wc, int fr, int fq) const {
        const int row0 = u.pm * BM + wr * 64 + fr, col0 = (u.pn % npn) * BM + wc * 32 + 8 * fq;
#pragma unroll
        for (int ai = 0; ai < 2; ++ai)
#pragma unroll
            for (int m = 0; m < 4; ++m) { bf16_t* rowp = Y + (size_t)(row0 + ai * HALF + m * 16) * ldc + col0;
#pragma unroll
                for (int bj = 0; bj < 2; ++bj) { f32x4 v0 = acc[ai][bj][m][0], v1 = acc[ai][bj][m][1];
                    if (ACC) { const u32x4 o = *(const u32x4*)(rowp + bj * HALF);
                        v0[0] += __builtin_bit_cast(float, o.x << 16); v0[1] += __builtin_bit_cast(float, o.x & 0xffff0000u); v0[2] += __builtin_bit_cast(float, o.y << 16); v0[3] += __builtin_bit_cast(float, o.y & 0xffff0000u);
                        v1[0] += __builtin_bit_cast(float, o.z << 16); v1[1] += __builtin_bit_cast(float, o.z & 0xffff0000u); v1[2] += __builtin_bit_cast(float, o.w << 16); v1[3] += __builtin_bit_cast(float, o.w & 0xffff0000u); }
                    u32x4 w; w.x = cvt_pk_bf16(v0[0], v0[1]); w.y = cvt_pk_bf16(v0[2], v0[3]); w.z = cvt_pk_bf16(v1[0], v1[1]); w.w = cvt_pk_bf16(v1[2], v1[3]);
                    *(u32x4*)(rowp + bj * HALF) = w; } }
    }
};
struct MoeOrder {
    int nunits, npn, G, c; int ts[9];
    __device__ __forceinline__ bool next(int i, Unit& u) const {
        const int L = i * G + c; if (L >= nunits) return false;
        const int nig = 8 * npn, gid = L / nig, w = L - gid * nig, fm = gid * 8, nt = ts[8], gsz = (nt - fm) < 8 ? (nt - fm) : 8;
        const int pnl = w / gsz, tile = fm + (w - pnl * gsz); int e = 0;
#pragma unroll
        for (int k = 1; k < 8; ++k) e += (tile >= ts[k]) ? 1 : 0;
        u.pm = tile; u.pn = e * npn + pnl; return true;
    }
    __device__ __forceinline__ void a_ready(const Unit&) const {}
    __device__ __forceinline__ void done(const Unit&) const {}
};
struct EpiGeluBias {
    static constexpr bool PERM = true, AFTER_DRAIN = false;
    bf16_t* O; int ldc; const float* bias;
    __device__ __forceinline__ static float gelu_t(float x) { const float u = 0.7978845608028654f * (x + 0.044715f * x * x * x); const float e = __expf(2.0f * u); return x * (1.0f - __builtin_amdgcn_rcpf(e + 1.0f)); }
    __device__ __forceinline__ void operator()(const f32x4 (&acc)[2][2][4][2], const Unit& u, int wr, int wc, int fr, int fq) const {
        const int row0 = u.pm * BM + wr * 64 + fr, col0 = wc * 32 + 8 * fq;
#pragma unroll
        for (int ai = 0; ai < 2; ++ai)
#pragma unroll
            for (int m = 0; m < 4; ++m) { bf16_t* rowp = O + (size_t)(row0 + ai * HALF + m * 16) * ldc + col0;
#pragma unroll
                for (int bj = 0; bj < 2; ++bj) { const float* bp = bias + u.pn * BM + col0 + bj * HALF; const f32x4 b0 = *(const f32x4*)bp, b1 = *(const f32x4*)(bp + 4);
                    const f32x4 v0 = acc[ai][bj][m][0] + b0, v1 = acc[ai][bj][m][1] + b1;
                    u32x4 w; w.x = cvt_pk_bf16(gelu_t(v0[0]), gelu_t(v0[1])); w.y = cvt_pk_bf16(gelu_t(v0[2]), gelu_t(v0[3])); w.z = cvt_pk_bf16(gelu_t(v1[0]), gelu_t(v1[1])); w.w = cvt_pk_bf16(gelu_t(v1[2]), gelu_t(v1[3]));
                    *(u32x4*)(rowp + bj * HALF) = w; } }
    }
};
struct FirstNOrder {
    int n, c, pdiv;
    __device__ __forceinline__ bool next(int i, Unit& u) const { if (i != 0 || c >= n) return false; u.pm = c; u.pn = c / pdiv; return true; }
    __device__ __forceinline__ void a_ready(const Unit&) const {}
    __device__ __forceinline__ void done(const Unit&) const {}
};
struct EpiResF32N {
    static constexpr bool PERM = true, AFTER_DRAIN = false;
    const float* R; float* O; bf16_t* XB; float* SSQ;
    __device__ __forceinline__ void operator()(const f32x4 (&acc)[2][2][4][2], const Unit& u, int wr, int wc, int fr, int fq) const {
        const int row0 = u.pm * BM + wr * 64 + fr, col0 = u.pn * BM + wc * 32 + 8 * fq;
#pragma unroll
        for (int ai = 0; ai < 2; ++ai)
#pragma unroll
            for (int m = 0; m < 4; ++m) { const int row = row0 + ai * HALF + m * 16; const size_t ro = (size_t)row * 1024 + col0; float ss = 0.f;
#pragma unroll
                for (int bj = 0; bj < 2; ++bj) { const float* rp = R + ro + bj * HALF; float* op = O + ro + bj * HALF;
                    const f32x4 v0 = *(const f32x4*)rp + acc[ai][bj][m][0], v1 = *(const f32x4*)(rp + 4) + acc[ai][bj][m][1];
                    *(f32x4*)op = v0; *(f32x4*)(op + 4) = v1;
                    ss += (v0[0] * v0[0] + v0[1] * v0[1]) + (v0[2] * v0[2] + v0[3] * v0[3]) + (v1[0] * v1[0] + v1[1] * v1[1]) + (v1[2] * v1[2] + v1[3] * v1[3]);
                    u32x4 w; w.x = cvt_pk_bf16(v0[0], v0[1]); w.y = cvt_pk_bf16(v0[2], v0[3]); w.z = cvt_pk_bf16(v1[0], v1[1]); w.w = cvt_pk_bf16(v1[2], v1[3]);
                    *(u32x4*)(XB + ro + bj * HALF) = w; }
                ss += __shfl_xor(ss, 16); ss += __shfl_xor(ss, 32);
                if (fq == 0) SSQ[(size_t)row * 16 + 4 * u.pn + wc] = ss; }
    }
};
__device__ __forceinline__ float row_rstd16(const float* SSQ, int row) {
    const f32x4* p = (const f32x4*)(SSQ + (size_t)row * 16); const f32x4 a = p[0], b = p[1], c = p[2], d = p[3];
    const float s = ((a[0] + a[1]) + (a[2] + a[3])) + ((b[0] + b[1]) + (b[2] + b[3])) + ((c[0] + c[1]) + (c[2] + c[3])) + ((d[0] + d[1]) + (d[2] + d[3]));
    return __builtin_amdgcn_rsqf(s * (1.0f / 1024.0f) + 1e-6f);
}
struct EpiStoreBf16N {
    static constexpr bool PERM = true, AFTER_DRAIN = false;
    bf16_t* O; int ldc; const float* SSQ;
    __device__ __forceinline__ void operator()(const f32x4 (&acc)[2][2][4][2], const Unit& u, int wr, int wc, int fr, int fq) const {
        const int row0 = u.pm * BM + wr * 64 + fr, col0 = u.pn * BM + wc * 32 + 8 * fq;
#pragma unroll
        for (int ai = 0; ai < 2; ++ai)
#pragma unroll
            for (int m = 0; m < 4; ++m) { const int row = row0 + ai * HALF + m * 16; const float rs = row_rstd16(SSQ, row); bf16_t* rowp = O + (size_t)row * ldc + col0;
#pragma unroll
                for (int bj = 0; bj < 2; ++bj) { const f32x4 v0 = acc[ai][bj][m][0] * rs, v1 = acc[ai][bj][m][1] * rs;
                    u32x4 w; w.x = cvt_pk_bf16(v0[0], v0[1]); w.y = cvt_pk_bf16(v0[2], v0[3]); w.z = cvt_pk_bf16(v1[0], v1[1]); w.w = cvt_pk_bf16(v1[2], v1[3]);
                    *(u32x4*)(rowp + bj * HALF) = w; } }
    }
};
struct EpiSwigluN {
    static constexpr bool PERM = true, AFTER_DRAIN = false;
    bf16_t* H; int ldh; int npn; const float* SSQ;
    __device__ __forceinline__ void operator()(const f32x4 (&acc)[2][2][4][2], const Unit& u, int wr, int wc, int fr, int fq) const {
        const int row0 = u.pm * BM + wr * 64 + fr, col0 = (u.pn % npn) * HALF + wc * 32 + 8 * fq;
#pragma unroll
        for (int ai = 0; ai < 2; ++ai)
#pragma unroll
            for (int m = 0; m < 4; ++m) { const int row = row0 + ai * HALF + m * 16; const float rs = row_rstd16(SSQ, row); bf16_t* rowp = H + (size_t)row * ldh + col0;
                const f32x4 g0 = acc[ai][0][m][0] * rs, g1 = acc[ai][0][m][1] * rs, u0 = acc[ai][1][m][0] * rs, u1 = acc[ai][1][m][1] * rs;
                u32x4 w; w.x = cvt_pk_bf16(silu_f(g0[0]) * u0[0], silu_f(g0[1]) * u0[1]); w.y = cvt_pk_bf16(silu_f(g0[2]) * u0[2], silu_f(g0[3]) * u0[3]);
                w.z = cvt_pk_bf16(silu_f(g1[0]) * u1[0], silu_f(g1[1]) * u1[1]); w.w = cvt_pk_bf16(silu_f(g1[2]) * u1[2], silu_f(g1[3]) * u1[3]);
                *(u32x4*)rowp = w; }
    }
};
template <class Epi, class Sched, bool ALIGN_EPI = false, bool SP2 = false, bool GATHER = false>
__device__ __forceinline__ void gemm_phase(PG8_LAS unsigned char* lds, const Gemm g, const Sched& S, const Epi& E, const PG8_LAS unsigned short* gidx = nullptr, int wave0 = -1) {
    int tid_ = (wave0 >= 0) ? (wave0 * 64 + (int)__builtin_amdgcn_mbcnt_hi(~0u, __builtin_amdgcn_mbcnt_lo(~0u, 0u))) : (int)threadIdx.x; asm volatile("" : "+v"(tid_));
    const int tid = tid_, wid = __builtin_amdgcn_readfirstlane(tid >> 6), lane = tid & 63, wr = wid >> 2, wc = wid & 3, fr = lane & 15, fq = lane >> 4;
    const int K = g.K, nt = K / BK;
    unsigned voffA[2], voffB[2]; int RA[2], CA[2]; unsigned voffG[2][2], voffN[2][2];
#pragma unroll
    for (int i = 0; i < 2; ++i) { int R, C; stage_rc(tid * 16 + i * 8192, R, C); const int Rb = Epi::PERM ? ((R & ~31) + perm32(R & 31)) : R; RA[i] = R; CA[i] = C;
        voffA[i] = (unsigned)(R * K + C) * 2u; voffB[i] = (unsigned)(Rb * K + C) * 2u; }
#define PG8_GIDX(dst, ui_) do { _Pragma("unroll") for (int _h = 0; _h < 2; ++_h) _Pragma("unroll") for (int _i = 0; _i < 2; ++_i) \
        { const unsigned _t = gidx[(ui_) * 256 + _h * 128 + RA[_i]]; dst[_h][_i] = ((_t & 0x7fffu) * (unsigned)g.lda + (_t >> 15) * (unsigned)g.hiofs + (unsigned)CA[_i]) * 2u; } } while (0)
    if constexpr (GATHER) { PG8_GIDX(voffG, 0); PG8_GIDX(voffN, 0); }
    (void)RA; (void)CA; (void)voffG; (void)voffN; (void)voffA;
    const size_t kstep = (size_t)(BK * 2);
    const size_t kstepA = GATHER ? (size_t)g.kstepA : kstep;
    const size_t hstep = (size_t)HALF * K * 2;
    const size_t tstep = 2 * hstep;
    const unsigned ldsw = (unsigned)wid * 1024u;
    const int aoff = lds_byte(wr * 64 + fr, fq * 8), boff = lds_byte(wc * 32 + fr, fq * 8);
#define PG8_SA(b, h) (((b) * 2 + (h)) * HTB)
#define PG8_SB(b, h) ((4 + (b) * 2 + (h)) * HTB)
#define PG8_STAGE(bufoff, gbase, voff) do { _Pragma("unroll") for (int _i = 0; _i < 2; ++_i) \
        __builtin_amdgcn_global_load_lds((const unsigned*)((const char*)(gbase) + (voff)[_i]), (PG8_LAS unsigned*)(lds + (bufoff) + ldsw + _i * 8192), 16, 0, 0); } while (0)
#define PG8_STAGE_A(bufoff, aptr, hh, nx) do { if constexpr (GATHER) { _Pragma("unroll") for (int _i = 0; _i < 2; ++_i) { const unsigned _vo = (nx) ? voffN[hh][_i] : voffG[hh][_i]; \
        __builtin_amdgcn_global_load_lds((const unsigned*)((const char*)(aptr) + _vo), (PG8_LAS unsigned*)(lds + (bufoff) + ldsw + _i * 8192), 16, 0, 0); } } \
        else { PG8_STAGE(bufoff, (aptr) + ((hh) ? hstep : 0), voffA); } } while (0)
#define PG8_LDA(dst, b, h) do { _Pragma("unroll") for (int m = 0; m < 4; ++m) _Pragma("unroll") for (int k = 0; k < 2; ++k) dst[m][k] = *(const PG8_LAS bf16x8*)(lds + PG8_SA(b, h) + aoff + m * 2048 + k * 1024); } while (0)
#define PG8_LDB(dst, b, h) do { _Pragma("unroll") for (int n = 0; n < 2; ++n) _Pragma("unroll") for (int k = 0; k < 2; ++k) dst[n][k] = *(const PG8_LAS bf16x8*)(lds + PG8_SB(b, h) + boff + n * 2048 + k * 1024); } while (0)
#define PG8_MMA(ai, bj, At, Bt) do { __builtin_amdgcn_s_setprio(1); _Pragma("unroll") for (int m = 0; m < 4; ++m) _Pragma("unroll") for (int n = 0; n < 2; ++n) _Pragma("unroll") for (int k = 0; k < 2; ++k) \
        acc[ai][bj][m][n] = __builtin_amdgcn_mfma_f32_16x16x32_bf16(Bt[n][k], At[m][k], acc[ai][bj][m][n], 0, 0, 0); __builtin_amdgcn_s_setprio(0); } while (0)
#define PG8_WAIT_V(n) asm volatile("s_waitcnt vmcnt(" #n ")" ::: "memory")
#define PG8_WAIT_L(n) asm volatile("s_waitcnt lgkmcnt(" #n ")" ::: "memory")
#define PG8_BAR __builtin_amdgcn_s_barrier()
#define PG8_SCHED __builtin_amdgcn_sched_barrier(0)
    Unit cur, nxt; int ui = 0;
    if (!S.next(0, cur)) return;
    f32x4 acc[2][2][4][2];
#pragma unroll
    for (int a = 0; a < 2; ++a)
#pragma unroll
        for (int b = 0; b < 2; ++b)
#pragma unroll
            for (int m = 0; m < 4; ++m)
#pragma unroll
                for (int n = 0; n < 2; ++n) acc[a][b][m][n] = (f32x4){0.f, 0.f, 0.f, 0.f};
    bf16x8 At[4][2], B0[2][2], B1[2][2];
    const char* cA = (const char*)g.A + (GATHER ? (size_t)0 : (size_t)cur.pm * tstep); const char* cB = (const char*)g.Bt + (size_t)cur.pn * tstep;
    S.a_ready(cur);
    if constexpr (SP2) {
        PG8_STAGE(PG8_SB(0, 0), cB, voffB); PG8_STAGE(PG8_SB(0, 1), cB + hstep, voffB); PG8_STAGE_A(PG8_SA(0, 0), cA, 0, false); PG8_STAGE_A(PG8_SA(0, 1), cA, 1, false);
        if (wr == 1) PG8_BAR;
        PG8_WAIT_V(2); PG8_BAR;
        PG8_STAGE(PG8_SB(1, 0), cB + kstep, voffB); PG8_STAGE_A(PG8_SA(1, 0), cA + kstepA, 0, false); PG8_STAGE(PG8_SB(1, 1), cB + hstep + kstep, voffB);
        PG8_WAIT_V(6); PG8_BAR;
    } else {
        PG8_STAGE(PG8_SB(0, 0), cB, voffB); PG8_STAGE(PG8_SA(0, 0), cA, voffA); PG8_STAGE(PG8_SB(0, 1), cB + hstep, voffB); PG8_STAGE(PG8_SA(0, 1), cA + hstep, voffA);
        if (wr == 1) PG8_BAR;
        PG8_WAIT_V(4); PG8_BAR;
        PG8_STAGE(PG8_SB(1, 0), cB + kstep, voffB); PG8_STAGE(PG8_SA(1, 0), cA + kstep, voffA); PG8_STAGE(PG8_SB(1, 1), cB + hstep + kstep, voffB);
        PG8_WAIT_V(6); PG8_BAR;
    }
    for (;;) {
        const bool has_next = S.next(ui + 1, nxt);
        const char* nA = (has_next && !GATHER) ? (const char*)g.A + (size_t)nxt.pm * tstep : cA; const char* nB = has_next ? (const char*)g.Bt + (size_t)nxt.pn * tstep : cB;
        if constexpr (GATHER) { if (has_next) PG8_GIDX(voffN, ui + 1); }
        for (int t = 0; t < nt; t += 2) {
            const bool last = (t == nt - 2);
            const char* a1 = cA + (size_t)(t + 1) * kstepA;
            const char* a2 = last ? nA : cA + (size_t)(t + 2) * kstepA; const char* b2 = last ? nB : cB + (size_t)(t + 2) * kstep;
            const char* a3 = a2 + kstepA; const char* b3 = b2 + kstep;
            if (last && has_next) S.a_ready(nxt);
            if constexpr (SP2) {
            const bool nx = last && has_next;
            PG8_LDB(B0, 0, 0); PG8_LDB(B1, 0, 1); PG8_SCHED; PG8_LDA(At, 0, 0); PG8_STAGE_A(PG8_SA(1, 1), a1, 1, false);
            PG8_WAIT_V(8); PG8_WAIT_L(0); PG8_BAR; PG8_MMA(0, 0, At, B0); PG8_MMA(0, 1, At, B1); PG8_BAR; PG8_SCHED;
            PG8_LDA(At, 0, 1); PG8_STAGE(PG8_SB(0, 0), b2, voffB); PG8_STAGE(PG8_SB(0, 1), b2 + hstep, voffB); PG8_STAGE_A(PG8_SA(0, 0), a2, 0, nx);
            PG8_WAIT_V(8); PG8_WAIT_L(0); PG8_BAR; PG8_MMA(1, 0, At, B0); PG8_MMA(1, 1, At, B1); PG8_BAR; PG8_SCHED;
            PG8_LDB(B0, 1, 0); PG8_LDB(B1, 1, 1); PG8_SCHED; PG8_LDA(At, 1, 0); PG8_STAGE_A(PG8_SA(0, 1), a2, 1, nx);
            PG8_WAIT_V(8); PG8_WAIT_L(0); PG8_BAR; PG8_MMA(0, 0, At, B0); PG8_MMA(0, 1, At, B1); PG8_BAR; PG8_SCHED;
            PG8_LDA(At, 1, 1); PG8_STAGE(PG8_SB(1, 0), b3, voffB); PG8_STAGE(PG8_SB(1, 1), b3 + hstep, voffB); PG8_STAGE_A(PG8_SA(1, 0), a3, 0, nx);
            PG8_WAIT_V(8); PG8_WAIT_L(0); PG8_BAR; PG8_MMA(1, 0, At, B0); PG8_MMA(1, 1, At, B1); PG8_BAR; PG8_SCHED;
            } else {
            static_assert(SP2 || !GATHER, "GATHER is implemented for the SP2 loop only");
            PG8_LDB(B0, 0, 0); PG8_SCHED; PG8_LDA(At, 0, 0); PG8_STAGE(PG8_SA(1, 1), a1 + hstep, voffA);
            PG8_WAIT_L(8); PG8_BAR; PG8_WAIT_L(0); PG8_MMA(0, 0, At, B0); PG8_BAR; PG8_SCHED;
            PG8_LDB(B1, 0, 1); PG8_STAGE(PG8_SB(0, 0), b2, voffB);
            PG8_BAR; PG8_WAIT_L(0); PG8_MMA(0, 1, At, B1); PG8_BAR;
            PG8_LDA(At, 0, 1); PG8_STAGE(PG8_SA(0, 0), a2, voffA);
            PG8_BAR; PG8_WAIT_L(0); PG8_MMA(1, 0, At, B0); PG8_BAR; PG8_SCHED;
            PG8_STAGE(PG8_SB(0, 1), b2 + hstep, voffB);
            PG8_WAIT_V(6); PG8_BAR; PG8_MMA(1, 1, At, B1); PG8_BAR;
            PG8_LDB(B0, 1, 0); PG8_SCHED; PG8_LDA(At, 1, 0); PG8_STAGE(PG8_SA(0, 1), a2 + hstep, voffA);
            PG8_WAIT_L(8); PG8_BAR; PG8_WAIT_L(0); PG8_MMA(0, 0, At, B0); PG8_BAR; PG8_SCHED;
            PG8_LDB(B1, 1, 1); PG8_STAGE(PG8_SB(1, 0), b3, voffB);
            PG8_BAR; PG8_WAIT_L(0); PG8_MMA(0, 1, At, B1); PG8_BAR;
            PG8_LDA(At, 1, 1); PG8_STAGE(PG8_SA(1, 0), a3, voffA);
            PG8_BAR; PG8_WAIT_L(0); PG8_MMA(1, 0, At, B0); PG8_BAR; PG8_SCHED;
            PG8_STAGE(PG8_SB(1, 1), b3 + hstep, voffB);
            PG8_WAIT_V(6); PG8_BAR; PG8_MMA(1, 1, At, B1); PG8_BAR;
            }
        }
        if constexpr (ALIGN_EPI) { if (wr == 0) PG8_BAR; }
        if constexpr (!Epi::AFTER_DRAIN) { E(acc, cur, wr, wc, fr, fq); S.done(cur); }
        if (!has_next) break;
#pragma unroll
        for (int a = 0; a < 2; ++a)
#pragma unroll
            for (int b = 0; b < 2; ++b)
#pragma unroll
                for (int m = 0; m < 4; ++m)
#pragma unroll
                    for (int n = 0; n < 2; ++n) acc[a][b][m][n] = (f32x4){0.f, 0.f, 0.f, 0.f};
        cur = nxt; cA = nA; cB = nB; ++ui;
        if constexpr (GATHER) {
#pragma unroll
            for (int _h = 0; _h < 2; ++_h)
#pragma unroll
                for (int _i = 0; _i < 2; ++_i) voffG[_h][_i] = voffN[_h][_i]; }
        if constexpr (ALIGN_EPI) { if (wr == 1) PG8_BAR; }
    }
    PG8_WAIT_V(0);
    if constexpr (!ALIGN_EPI) { if (wr == 0) PG8_BAR; }
    PG8_BAR;
    if constexpr (Epi::AFTER_DRAIN) { E.fused(acc, cur, wr, wc, fr, fq, lds, wid, lane); S.done(cur); }
#undef PG8_SA
#undef PG8_SB
#undef PG8_STAGE
#undef PG8_STAGE_A
#undef PG8_GIDX
#undef PG8_LDA
#undef PG8_LDB
#undef PG8_MMA
#undef PG8_WAIT_V
#undef PG8_WAIT_L
#undef PG8_BAR
#undef PG8_SCHED
}
}

#define GAS __attribute__((address_space(1)))
#define LAS __attribute__((address_space(3)))
typedef unsigned short bf16;
typedef unsigned v4u __attribute__((ext_vector_type(4)));
typedef unsigned v2u __attribute__((ext_vector_type(2)));
typedef float f32x4 __attribute__((ext_vector_type(4)));
typedef short bf16x8 __attribute__((ext_vector_type(8)));
typedef GAS unsigned gu32;
#define RLX_AGENT __ATOMIC_RELAXED, __HIP_MEMORY_SCOPE_AGENT
#define LDS_WAIT() asm volatile("s_waitcnt lgkmcnt(0)" ::: "memory")
#define VM_WAIT() asm volatile("s_waitcnt vmcnt(0)" ::: "memory")
__device__ __forceinline__ unsigned f2bf(float f) { unsigned u = __builtin_bit_cast(unsigned, f); return (u + 0x7fffu + ((u >> 16) & 1u)) >> 16; }
__device__ __forceinline__ unsigned pk2(float lo, float hi) { return pg8::cvt_pk_bf16(lo, hi); }
__device__ __forceinline__ float bf2f(unsigned short v) { return __builtin_bit_cast(float, (unsigned)v << 16); }
__device__ __forceinline__ float bflo(unsigned w) { return __builtin_bit_cast(float, w << 16); }
__device__ __forceinline__ float bfhi(unsigned w) { return __builtin_bit_cast(float, w & 0xffff0000u); }
__device__ __forceinline__ float wave_sum(float v) {
#pragma unroll
    for (int o = 1; o < 64; o <<= 1) v += __shfl_xor(v, o);
    return v;
}
__device__ __forceinline__ float wave_max(float v) {
#pragma unroll
    for (int o = 1; o < 64; o <<= 1) v = fmaxf(v, __shfl_xor(v, o));
    return v;
}
__device__ __forceinline__ float gelu_tanh(float x) { const float u = 0.7978845608028654f * (x + 0.044715f * x * x * x); return 0.5f * x * (1.0f + tanhf(u)); }
__device__ __forceinline__ float sigmoid_f(float x) { return 1.0f / (1.0f + __expf(-x)); }
__device__ __forceinline__ float log_sigmoid_f(float x) { return fminf(x, 0.f) - log1pf(__expf(-fabsf(x))); }

template <int D> __device__ __forceinline__ float dpp_row_shr(float v) { return __builtin_bit_cast(float, __builtin_amdgcn_update_dpp(0, __builtin_bit_cast(int, v), 0x110 + D, 0xf, 0xf, true)); }
__device__ __forceinline__ float dpp_xor1(float v) { return __builtin_bit_cast(float, __builtin_amdgcn_update_dpp(0, __builtin_bit_cast(int, v), 0xB1, 0xf, 0xf, true)); }
__device__ __forceinline__ float dpp_xor2(float v) { return __builtin_bit_cast(float, __builtin_amdgcn_update_dpp(0, __builtin_bit_cast(int, v), 0x4E, 0xf, 0xf, true)); }
#define XB_TMO      128
#define XB_XCNT(j)  (256  + 64 * (j))
#define XB_XSUB(j)  (1280 + 64 * (j))
#define XB_XGEN(j)  (2304 + 64 * (j))
#define XB_TOP      3328
#define XB_TOPGEN   3392
#define XCD_BAR_WORDS 3456
#define XB_SPIN_CAP (1u << 18)

__device__ __forceinline__ unsigned xb_ld(unsigned* p)              { return __hip_atomic_load(p, __ATOMIC_RELAXED, __HIP_MEMORY_SCOPE_AGENT); }
__device__ __forceinline__ unsigned xb_add(unsigned* p, unsigned v) { return __hip_atomic_fetch_add(p, v, __ATOMIC_RELAXED, __HIP_MEMORY_SCOPE_AGENT); }
__device__ __forceinline__ unsigned xb_xcc_id() { return (unsigned)__builtin_amdgcn_s_getreg((3 << 11) | 20) & 0xFu; }
#define XB_SPIN(cond, bar) do { unsigned _sp = 0; while (cond) { __builtin_amdgcn_s_sleep(1); \
    if ((++_sp & 255u) == 0u) { if (xb_ld(&(bar)[XB_TMO])) break; if (_sp > XB_SPIN_CAP) { atomicAdd(&(bar)[XB_TMO], 1u); break; } } } } while (0)

struct XcdBarrier {
    unsigned* bar; unsigned x;
    volatile LAS unsigned* st;
};

__device__ __forceinline__ XcdBarrier xcd_barrier_post(unsigned* bar, volatile LAS unsigned* st) {
    XcdBarrier b; b.bar = bar; b.x = xb_xcc_id(); b.st = st;
    if (threadIdx.x == 0) (void)xb_add(&bar[XB_XCNT(b.x)], 1u);
    return b;
}
__device__ __forceinline__ void xcd_barrier_complete(unsigned* bar, unsigned x, unsigned& nloc, unsigned& nx) {
    const unsigned G = gridDim.x * gridDim.y * gridDim.z;
    unsigned sum, cnt, mine, sp = 0u;
    for (;;) {
        sum = 0u; cnt = 0u; mine = 0u;
#pragma unroll
        for (unsigned j = 0; j < 16; ++j) { const unsigned c = xb_ld(&bar[XB_XCNT(j)]); sum += c; cnt += (c > 0u) ? 1u : 0u; mine = (j == x) ? c : mine; }
        if (sum == G) break;
        __builtin_amdgcn_s_sleep(1);
        if ((++sp & 255u) == 0u) { if (xb_ld(&bar[XB_TMO])) break; if (sp > XB_SPIN_CAP) { atomicAdd(&bar[XB_TMO], 1u); break; } }
    }
    nloc = mine > 0u ? mine : 1u; nx = cnt > 0u ? cnt : 1u;
}

__device__ __forceinline__ void xcd_barrier(const XcdBarrier& b) {
    asm volatile("s_waitcnt vmcnt(0)" ::: "memory");
    __syncthreads();
    if (threadIdx.x == 0) {
        unsigned* bar = b.bar;
        __builtin_amdgcn_s_waitcnt(0);
        unsigned nloc = b.st[0], nx = b.st[1];
        if (nloc == 0u) { xcd_barrier_complete(bar, b.x, nloc, nx); b.st[0] = nloc; b.st[1] = nx; }
        const unsigned old = xb_add(&bar[XB_XSUB(b.x)], 1u);
        const unsigned gen = old / nloc;
        if (old + 1u == (gen + 1u) * nloc) {
            __builtin_amdgcn_fence(__ATOMIC_RELEASE, "agent");
            asm volatile("s_waitcnt vmcnt(0)" ::: "memory");
            const unsigned og = xb_add(&bar[XB_TOP], 1u);
            const unsigned tg = og / nx;
            if (og + 1u == (tg + 1u) * nx) xb_add(&bar[XB_TOPGEN], 1u);
            else XB_SPIN(xb_ld(&bar[XB_TOPGEN]) == tg, bar);
            __builtin_amdgcn_fence(__ATOMIC_ACQUIRE, "agent");
            xb_add(&bar[XB_XGEN(b.x)], 1u);
            asm volatile("s_waitcnt vmcnt(0)" ::: "memory");
        } else {
            XB_SPIN(xb_ld(&bar[XB_XGEN(b.x)]) == gen, bar);
            __builtin_amdgcn_fence(__ATOMIC_ACQUIRE, "agent");
            asm volatile("s_waitcnt vmcnt(0)" ::: "memory");
        }
    }
    __syncthreads();
}


constexpr int NB = 8, SQ = 4096, NT = NB * SQ, DM = 1024;
constexpr int PW = 2560;
constexpr int P_DQ = 0, P_DK = 256, P_DV = 512, P_NQ = 768, P_KC = 1024, P_VC = 1088, P_KS = 1152, P_VS = 1216, P_KW = 1280, P_VW = 1344,
              P_GQ = 1408, P_GK = 1536, P_GV = 1664, P_GR = 1920, P_SU = 2176, P_GA = 2432, P_NG = 2448;
constexpr int PROJ_SRC = 2460;
constexpr int DFF = 2752, DFFP = 2816, DFE = 3584, NEXP = 8;
constexpr int NCMP = 255, NCMPP = 256;
__host__ __device__ __forceinline__ int inproj_src_col(int n) {
    if (n < 1408) return n;
    if (n < 1920) return n + 12;
    if (n < 2432) return n + 28;
    if (n < 2448) return n - 500;
    if (n < 2460) return n - 1040;
    return -1;
}
constexpr size_t MiB = 1u << 20;
constexpr size_t WS_CTL = 0, CTL_ZERO_BYTES = 1 * MiB;
constexpr size_t WS_WIN = 2 * MiB;
constexpr size_t WS_WOUT = 12 * MiB;
constexpr size_t WS_WFGU = 16 * MiB;
constexpr size_t WS_WFDN = 27 * MiB;
constexpr size_t WS_KC = 33 * MiB;
constexpr size_t WS_VC = WS_KC + 512 * 1024;
constexpr size_t WS_SEL = 34 * MiB;
constexpr size_t WS_CW = 34 * MiB + 512 * 1024;
constexpr size_t WS_HN = 36 * MiB;
constexpr size_t WS_PROJ = 100 * MiB;
constexpr size_t WS_MIXRAW = 260 * MiB;
constexpr size_t WS_GA = 388 * MiB;
constexpr size_t WS_GLAS = 404 * MiB;
constexpr size_t WS_OS = 420 * MiB, WS_OW = 452 * MiB;
constexpr size_t WS_HG = 484 * MiB;
constexpr size_t WS_S5X = 500 * MiB;
constexpr size_t WS_GLAD = 504 * MiB;
constexpr size_t WS_XB = 324 * MiB;
constexpr size_t WS_DO1 = 324 * MiB;
constexpr size_t WS_DL1 = 356 * MiB;
constexpr size_t WS_SSQ = 513 * MiB;
constexpr size_t WS_W2T = 34 * MiB + 256 * 1024;
constexpr size_t WS_S5TAB = 33 * MiB;
constexpr size_t WS_WGLU = 35 * MiB + 512 * 1024;
constexpr size_t WS_W1CT = 505 * MiB;
constexpr size_t WS_BIASP = 509 * MiB;
constexpr size_t WS_CHID = 510 * MiB;
constexpr size_t WS_KCB = 512 * MiB;
constexpr size_t WS_VCB = 512 * MiB + 256 * 1024;
constexpr size_t WS_FH = 100 * MiB;
constexpr size_t WS_WEGU = 100 * MiB;
constexpr size_t WS_WEDN = 114 * MiB;
constexpr size_t WS_EH = 128 * MiB;
constexpr int MOE_ROWS = 2 * NT + 8 * 256, MOE_HH = DFE / 2, MOE_NPN = MOE_HH / 128;
constexpr size_t WS_MTAB = 1 * MiB;
constexpr size_t WS_WCNT = 1 * MiB + 4096;
constexpr size_t WS_TOKINFO = 1 * MiB + 128 * 1024;
constexpr size_t WS_TOPW = 1 * MiB + 256 * 1024;
constexpr size_t WS_TOKPOS = 1 * MiB + 512 * 1024;
constexpr size_t WS_ROWTOK = 1 * MiB + 768 * 1024;
constexpr size_t WS_W2H = 3 * MiB;
constexpr size_t WS_W1H = 100 * MiB;
constexpr size_t WS_MHID = 156 * MiB;
constexpr size_t WS_MY = 387 * MiB;
constexpr size_t WS_END = 519 * MiB;
constexpr int GIDX_OFF = 131072 + 1024;
constexpr int CW_BAR = 4096;
constexpr int RING_OFF = 0, RING_BYTES = 131072;
constexpr int LDSCTL_OFF = RING_BYTES, MISC_OFF = LDSCTL_OFF + 320;
constexpr int LDS_BYTES = 147456;
constexpr int NWAVES = 8;

struct ConvJob { const float* src0; const float* src1; bf16* dst; int ld, Ksrc, Nsrc, Nd, Kd, mode, pad; const float* kscale = nullptr; };
__device__ __forceinline__ void conv_item(const ConvJob& J, LAS float* scr, int item, int lane) {
    const int nblk = J.Nd / 32, kb = item / nblk, nb = item % nblk, k0 = 64 * kb, n0 = 32 * nb;
    const int n = n0 + (lane & 31);
    const float* sp = nullptr;
    if (J.mode == 0) { if (n < J.Nsrc) sp = J.src0 + n; }
    else if (J.mode == 1) { const int c = inproj_src_col(n); if (c >= 0) sp = J.src0 + c; }
    else { const int pn = n >> 8, s = (n >> 7) & 1, j = J.pad + 128 * pn + (n & 127); const long long d01 = (const char*)J.src1 - (const char*)J.src0;
           if (j < J.Nsrc) sp = (const float*)((const char*)J.src0 + (s ? d01 : 0ll)) + j; }
#pragma unroll 8
    for (int i = 0; i < 32; ++i) { const int kk = 2 * i + (lane >> 5); float v = 0.f; if (sp && (k0 + kk) < J.Ksrc) { v = sp[(size_t)(k0 + kk) * J.ld]; if (J.kscale) v *= J.kscale[k0 + kk]; } scr[kk * 33 + (lane & 31)] = v; }
    LDS_WAIT(); asm volatile("" ::: "memory");
    const int c = lane & 7;
#pragma unroll
    for (int j = 0; j < 4; ++j) { const int nn = (lane >> 3) + 8 * j; const LAS float* s = scr + (8 * c) * 33 + nn;
        v4u o; o.x = pk2(s[0 * 33], s[1 * 33]); o.y = pk2(s[2 * 33], s[3 * 33]); o.z = pk2(s[4 * 33], s[5 * 33]); o.w = pk2(s[6 * 33], s[7 * 33]);
        *(GAS v4u*)(J.dst + (size_t)(n0 + nn) * J.Kd + k0 + 8 * c) = o; }
    LDS_WAIT(); asm volatile("" ::: "memory");
}
__device__ __forceinline__ void conv_run(const ConvJob& J, LAS float* scr, int gw, int ngw, int lane) {
    const int nitems = (J.Kd / 64) * (J.Nd / 32);
    for (int it = gw; it < nitems; it += ngw) conv_item(J, scr, it, lane);
}
__device__ __forceinline__ void conv_fast_item(const ConvJob& J, int item, int lane) {
    const int nblk = J.Nd / 256, kb = item / nblk, nb = item - kb * nblk, k0 = 32 * kb, n = 256 * nb + 4 * lane;
    const float* sp = nullptr;
    if (J.mode == 0) { if (n < J.Nsrc) sp = J.src0 + n; }
    else { const int pn = n >> 8, s = (n >> 7) & 1, j = J.pad + 128 * pn + (n & 127); const long long d01 = (const char*)J.src1 - (const char*)J.src0;
           if (j < J.Nsrc) sp = (const float*)((const char*)J.src0 + (s ? d01 : 0ll)) + j; }
    const bool live = (sp != nullptr) && (k0 < J.Ksrc);
    f32x4 v[32];
#pragma unroll
    for (int i = 0; i < 32; ++i) v[i] = live ? *(const f32x4*)(sp + (size_t)(k0 + i) * J.ld) : (f32x4){0.f, 0.f, 0.f, 0.f};
    if (J.kscale && live) {
#pragma unroll
        for (int i = 0; i < 32; ++i) v[i] = v[i] * J.kscale[k0 + i]; }
#pragma unroll
    for (int j = 0; j < 4; ++j) { bf16* dp = J.dst + (size_t)(n + j) * J.Kd + k0;
#pragma unroll
        for (int q = 0; q < 4; ++q) { v4u o; o.x = pk2(v[8 * q][j], v[8 * q + 1][j]); o.y = pk2(v[8 * q + 2][j], v[8 * q + 3][j]); o.z = pk2(v[8 * q + 4][j], v[8 * q + 5][j]); o.w = pk2(v[8 * q + 6][j], v[8 * q + 7][j]);
            *(GAS v4u*)(dp + 8 * q) = o; } }
}
__device__ __forceinline__ void conv_fast(const ConvJob& J, int gw, int ngw, int lane) {
    const int nitems = (J.Kd / 32) * (J.Nd / 256);
    for (int it = gw; it < nitems; it += ngw) conv_fast_item(J, it, lane);
}

template <bool ROUTER>
__device__ __forceinline__ void k_norm(int row, int lane, const float* __restrict__ x, const float* __restrict__ g, bf16* __restrict__ out,
                                              const float* __restrict__ rw, const float* __restrict__ rb, float* __restrict__ cw) {
    const f32x4* xr = (const f32x4*)(x + (size_t)row * DM) + lane;
    f32x4 v[4]; float s = 0.f;
#pragma unroll
    for (int j = 0; j < 4; ++j) { v[j] = xr[64 * j]; s += (v[j].x * v[j].x + v[j].y * v[j].y) + (v[j].z * v[j].z + v[j].w * v[j].w); }
    s = wave_sum(s);
    const float rstd = rsqrtf(s * (1.0f / DM) + 1e-6f);
    const f32x4* gr = (const f32x4*)g + lane;
    v2u* o8 = (v2u*)(out + (size_t)row * DM) + lane;
#pragma unroll
    for (int j = 0; j < 4; ++j) { const f32x4 gv = gr[64 * j]; v[j] = v[j] * rstd * gv; v2u o; o.x = pk2(v[j].x, v[j].y); o.y = pk2(v[j].z, v[j].w); o8[64 * j] = o; }
    if (ROUTER) {
        float lg[8];
#pragma unroll
        for (int e = 0; e < 8; ++e) lg[e] = 0.f;
#pragma unroll
        for (int j = 0; j < 4; ++j)
#pragma unroll
            for (int i = 0; i < 4; ++i) { const int c = 4 * lane + 256 * j + i; const f32x4 w0 = *(const f32x4*)(rw + (size_t)c * 8), w1 = *(const f32x4*)(rw + (size_t)c * 8 + 4); const float h = v[j][i];
                lg[0] += h * w0.x; lg[1] += h * w0.y; lg[2] += h * w0.z; lg[3] += h * w0.w; lg[4] += h * w1.x; lg[5] += h * w1.y; lg[6] += h * w1.z; lg[7] += h * w1.w; }
#pragma unroll
        for (int e = 0; e < 8; ++e) lg[e] = wave_sum(lg[e]) + rb[e];
        int i1 = 0; float v1 = lg[0];
#pragma unroll
        for (int e = 1; e < 8; ++e) if (lg[e] > v1) { v1 = lg[e]; i1 = e; }
        int i2 = -1; float v2 = -3.0e38f;
#pragma unroll
        for (int e = 0; e < 8; ++e) if (e != i1 && lg[e] > v2) { v2 = lg[e]; i2 = e; }
        const float e2 = __expf(v2 - v1), w1 = 1.0f / (1.0f + e2), w2 = e2 * w1;
        if (lane < 8) cw[(size_t)row * 8 + lane] = (lane == i1) ? w1 : ((lane == i2) ? w2 : 0.f);
    }
}

__device__ __forceinline__ void k_headnorm(int row, int lane, bf16* __restrict__ proj, const float* __restrict__ dil_g  , const float* __restrict__ nsa_g  ) {
    bf16* pr = proj + (size_t)row * PW;
#pragma unroll 1
    for (int i = 0; i < 14; ++i) {
        int off; const float* g;
        if (i < 4) { off = P_DQ + 64 * i; g = dil_g; } else if (i < 8) { off = P_DK + 64 * (i - 4); g = dil_g + 64; } else if (i < 12) { off = P_NQ + 64 * (i - 8); g = nsa_g; }
        else if (i == 12) { off = P_KS; g = nsa_g + 128; } else { off = P_KW; g = nsa_g + 192; }
        const float v = bf2f(pr[off + lane]);
        const float ss = wave_sum(v * v);
        pr[off + lane] = (bf16)f2bf(v * rsqrtf(ss * (1.0f / 64.0f) + 1e-6f) * g[lane]);
    }
}

__device__ __forceinline__ void att_key(const float (&q)[64], const bf16* __restrict__ kp, const bf16* __restrict__ vp, float bias, float& m, float& l, float (&o)[64]) {
    float dot = 0.f;
#pragma unroll
    for (int c = 0; c < 8; ++c) { const v4u kk = *(const v4u*)(kp + 8 * c);
        dot += q[8 * c + 0] * bflo(kk.x) + q[8 * c + 1] * bfhi(kk.x) + q[8 * c + 2] * bflo(kk.y) + q[8 * c + 3] * bfhi(kk.y)
             + q[8 * c + 4] * bflo(kk.z) + q[8 * c + 5] * bfhi(kk.z) + q[8 * c + 6] * bflo(kk.w) + q[8 * c + 7] * bfhi(kk.w); }
    const float s = dot * 0.125f + bias;
    const float mn = fmaxf(m, s), sc = __expf(m - mn), p = __expf(s - mn);
    l = l * sc + p; m = mn;
#pragma unroll
    for (int c = 0; c < 8; ++c) { const v4u vv = *(const v4u*)(vp + 8 * c);
        o[8 * c + 0] = o[8 * c + 0] * sc + p * bflo(vv.x); o[8 * c + 1] = o[8 * c + 1] * sc + p * bfhi(vv.x);
        o[8 * c + 2] = o[8 * c + 2] * sc + p * bflo(vv.y); o[8 * c + 3] = o[8 * c + 3] * sc + p * bfhi(vv.y);
        o[8 * c + 4] = o[8 * c + 4] * sc + p * bflo(vv.z); o[8 * c + 5] = o[8 * c + 5] * sc + p * bfhi(vv.z);
        o[8 * c + 6] = o[8 * c + 6] * sc + p * bflo(vv.w); o[8 * c + 7] = o[8 * c + 7] * sc + p * bfhi(vv.w); }
}
__device__ __forceinline__ void load_q(float (&q)[64], const bf16* qp) {
#pragma unroll
    for (int c = 0; c < 8; ++c) { const v4u kk = *(const v4u*)(qp + 8 * c);
        q[8 * c + 0] = bflo(kk.x); q[8 * c + 1] = bfhi(kk.x); q[8 * c + 2] = bflo(kk.y); q[8 * c + 3] = bfhi(kk.y);
        q[8 * c + 4] = bflo(kk.z); q[8 * c + 5] = bfhi(kk.z); q[8 * c + 6] = bflo(kk.w); q[8 * c + 7] = bfhi(kk.w); }
}
template <int MODE>
__device__ __forceinline__ void k_attn_naive(int idx, const bf16* __restrict__ proj, const unsigned long long* __restrict__ sel, float* __restrict__ out, int ldo, int ocol) {
    const int h = idx / NT, r = idx % NT, b = r / SQ, t = r % SQ;
    const bf16* base = proj + (size_t)b * SQ * PW;
    float q[64], o[64];
    load_q(q, proj + (size_t)r * PW + (MODE == 0 ? P_DQ : P_NQ) + 64 * h);
#pragma unroll
    for (int d = 0; d < 64; ++d) o[d] = 0.f;
    float m = -1.0e30f, l = 0.f;
    if (MODE == 0) {
        const float slope = exp2f(-2.0f * (h + 1));
        for (int p = 0; p < 3; ++p) { const int dil = (p == 0) ? 1 : (p == 1 ? 4 : 16);
            for (int j = 0; j <= 128; ++j) { const int pos = t - j * dil; if (pos < 0) break;
                att_key(q, base + (size_t)pos * PW + P_DK + 64 * h, base + (size_t)pos * PW + P_DV + 64 * h, -slope * (float)(j * dil), m, l, o); } }
    } else if (MODE == 1) {
        const float slope = exp2f(-(2.0f * h + 1.0f));
        const unsigned long long mask = sel[r]; const int cur = t >> 6;
        for (int j = 0; j <= cur; ++j) { if (!((mask >> j) & 1ull)) continue;
            for (int oo = 0; oo < 64; ++oo) { const int pos = 64 * j + oo; if (pos > t) break;
                att_key(q, base + (size_t)pos * PW + P_KS, base + (size_t)pos * PW + P_VS, -slope * (float)(t - pos), m, l, o); } }
    } else {
        const float slope = exp2f(-(2.0f * h + 1.0f));
        const int p0 = (t - 511) > 0 ? (t - 511) : 0;
        for (int pos = p0; pos <= t; ++pos) att_key(q, base + (size_t)pos * PW + P_KW, base + (size_t)pos * PW + P_VW, -slope * (float)(t - pos), m, l, o);
    }
    const float il = 1.0f / l;
    float* op = out + (size_t)r * ldo + ocol + 64 * h;
#pragma unroll
    for (int c = 0; c < 16; ++c) *(f32x4*)(op + 4 * c) = (f32x4){o[4 * c] * il, o[4 * c + 1] * il, o[4 * c + 2] * il, o[4 * c + 3] * il};
}

__device__ __forceinline__ void k_compress(int vb, int tid, LAS float* sm, const bf16* __restrict__ proj, const float* __restrict__ pos  , const float* __restrict__ w1  ,
                                                  const float* __restrict__ w2  , const float* __restrict__ gk  , float* __restrict__ KC, float* __restrict__ VC) {
    LAS float* in = sm; LAS float* hid = sm + 2048;
    const int which = vb & 1, c = (vb >> 1) % NCMP, b = (vb >> 1) / NCMP;
    const int pc = which ? P_VC : P_KC;
    for (int i = tid; i < 2048; i += 256) { const int l = i >> 6, d = i & 63; in[i] = bf2f(proj[(size_t)(b * SQ + 16 * c + l) * PW + pc + d]) + pos[which * 2048 + i]; }
    __syncthreads();
    const float* w1p = w1 + (size_t)which * 2048 * 256 + tid;
    float a = 0.f;
    for (int i = 0; i < 2048; ++i) a += in[i] * w1p[(size_t)i * 256];
    hid[tid] = gelu_tanh(a);
    __syncthreads();
    if (tid < 64) {
        const float* w2p = w2 + (size_t)which * 256 * 64 + tid; float o = 0.f;
        for (int j = 0; j < 256; ++j) o += hid[j] * w2p[j * 64];
        if (which == 0) { const float ss = wave_sum(o * o); o = o * rsqrtf(ss * (1.0f / 64.0f) + 1e-6f) * gk[tid]; KC[((size_t)b * NCMPP + c) * 64 + tid] = o; }
        else VC[((size_t)b * NCMPP + c) * 64 + tid] = o;
    }
}

__device__ __forceinline__ void k_cmp_topk(int vb, int tid, LAS float* sm, const bf16* __restrict__ proj, const float* __restrict__ KC, const float* __restrict__ VC, float* __restrict__ ocmp, int ldoc, unsigned long long* __restrict__ sel) {
    LAS float* qs = sm; LAS float (*sc)[256] = (LAS float (*)[256])(sm + 256); LAS float* impv = sm + 1280;
    const int r = vb, b = r / SQ, t = r % SQ, lane = tid & 63, w = tid >> 6;
    qs[tid] = bf2f(proj[(size_t)r * PW + P_NQ + tid]);
    __syncthreads();
    {   const int c = tid; const bool valid = (c < NCMP) && (t >= 16 * c + 31);
        float s[4] = {0.f, 0.f, 0.f, 0.f};
        if (valid) { const float* kp = KC + ((size_t)b * NCMPP + c) * 64;
            for (int d = 0; d < 64; ++d) { const float kv = kp[d]; s[0] += qs[d] * kv; s[1] += qs[64 + d] * kv; s[2] += qs[128 + d] * kv; s[3] += qs[192 + d] * kv; } }
        const float dist = (float)(t - 16 * c - 31);
#pragma unroll
        for (int h = 0; h < 4; ++h) sc[h][c] = valid ? (s[h] * 0.125f - exp2f(-(2.0f * h + 1.0f)) * dist) : -1.0e30f;
    }
    __syncthreads();
    {
        float v[4]; float mx = -1.0e30f;
#pragma unroll
        for (int i = 0; i < 4; ++i) { v[i] = sc[w][lane + 64 * i]; mx = fmaxf(mx, v[i]); }
        mx = wave_max(mx);
        float sum = 0.f;
#pragma unroll
        for (int i = 0; i < 4; ++i) { v[i] = (v[i] > -1.0e29f) ? __expf(v[i] - mx) : 0.f; sum += v[i]; }
        sum = wave_sum(sum);
        const float inv = sum > 0.f ? 1.0f / sum : 0.f;
#pragma unroll
        for (int i = 0; i < 4; ++i) sc[w][lane + 64 * i] = v[i] * inv;
    }
    __syncthreads();
    {
        const int h = tid >> 6, d = tid & 63; const float* vp = VC + (size_t)b * NCMPP * 64 + d; float o = 0.f;
        const int nc = (t >= 31) ? ((t - 31) / 16 + 1) : 0;
        for (int c = 0; c < nc && c < NCMP; ++c) o += sc[h][c] * vp[c * 64];
        ocmp[(size_t)r * ldoc + tid] = o;
    }
    if (tid < 64) {
        const int j = tid, cur = t >> 6; float imp = 0.f;
        for (int c = 4 * j - 1; c <= 4 * j + 3; ++c) if (c >= 0 && c < NCMP) imp += sc[0][c] + sc[1][c] + sc[2][c] + sc[3][c];
        const bool forced = (j == 0) || (j == cur) || (j == cur - 1);
        const float val = (j <= cur) ? (imp + (forced ? 1.0e4f : 0.f)) : -1.0e30f;
        impv[j] = val;
    }
    __syncthreads();
    if (tid < 64) {
        const int j = tid; const float val = impv[j]; int rank = 0;
        for (int k = 0; k < 64; ++k) { const float o = impv[k]; rank += (o > val || (o == val && k < j)) ? 1 : 0; }
        const unsigned long long mask = __ballot(rank < 16);
        if (tid == 0) sel[r] = mask;
    }
}

__device__ __forceinline__ void k_gla(int vb, int lane, const bf16* __restrict__ proj, const float* __restrict__ wa2  , const float* __restrict__ ba  , const float* __restrict__ ng  , float* __restrict__ mixraw) {
    const int b = vb >> 2, h = vb & 3, kk = lane & 31;
    float wcol[16];
#pragma unroll
    for (int j = 0; j < 16; ++j) wcol[j] = wa2[j * 128 + h * 32 + kk];
    const float bav = ba[h * 32 + kk], gn = ng[lane];
    float S[32];
#pragma unroll
    for (int k = 0; k < 32; ++k) S[k] = 0.f;
    for (int t = 0; t < SQ; ++t) {
        const bf16* pr = proj + (size_t)(b * SQ + t) * PW;
        const float qv = bf2f(pr[P_GQ + h * 32 + kk]) * 0.17677669529663687f, kv = bf2f(pr[P_GK + h * 32 + kk]);
        const v4u a0 = *(const v4u*)(pr + P_GA), a1 = *(const v4u*)(pr + P_GA + 8);
        float z = bav;
        z += bflo(a0.x) * wcol[0] + bfhi(a0.x) * wcol[1] + bflo(a0.y) * wcol[2] + bfhi(a0.y) * wcol[3] + bflo(a0.z) * wcol[4] + bfhi(a0.z) * wcol[5] + bflo(a0.w) * wcol[6] + bfhi(a0.w) * wcol[7];
        z += bflo(a1.x) * wcol[8] + bfhi(a1.x) * wcol[9] + bflo(a1.y) * wcol[10] + bfhi(a1.y) * wcol[11] + bflo(a1.z) * wcol[12] + bfhi(a1.z) * wcol[13] + bflo(a1.w) * wcol[14] + bfhi(a1.w) * wcol[15];
        const float av = __expf(log_sigmoid_f(z) * (1.0f / 16.0f));
        const float vv = bf2f(pr[P_GV + h * 64 + lane]);
        float o = 0.f;
#pragma unroll
        for (int k = 0; k < 32; ++k) { const float ak = __shfl(av, k), kx = __shfl(kv, k), qx = __shfl(qv, k); S[k] = S[k] * ak + kx * vv; o += qx * S[k]; }
        const float ss = wave_sum(o * o);
        float y = o * rsqrtf(ss * (1.0f / 64.0f) + 1e-6f) * gn;
        const float rr = bf2f(pr[P_GR + h * 64 + lane]);
        y *= rr * sigmoid_f(rr);
        mixraw[(size_t)(b * SQ + t) * 1024 + 512 + h * 64 + lane] = y;
    }
}

__device__ __forceinline__ void k_s5(int vb, int lane, LAS float* xs, const bf16* __restrict__ proj, const float* __restrict__ a_re, const float* __restrict__ a_im, const float* __restrict__ b_re, const float* __restrict__ b_im,
                                           const float* __restrict__ c_re, const float* __restrict__ c_im, const float* __restrict__ dvec, const float* __restrict__ log_dt, float* __restrict__ hg) {
    const int b = vb >> 4, g = vb & 15, n = lane;
    const float dt = expf(log_dt[g]), are = a_re[g * 64 + n], aim = a_im[g * 64 + n];
    const float mag = expf(dt * are), abr = mag * cosf(dt * aim), abi = mag * sinf(dt * aim);
    const float den = are * are + aim * aim, f_re = ((abr - 1.0f) * are + abi * aim) / den, f_im = (abi * are - (abr - 1.0f) * aim) / den;
    float bbr[16], bbi[16];
#pragma unroll
    for (int c = 0; c < 16; ++c) { const float br = b_re[(size_t)(g * 64 + n) * 16 + c], bi = b_im[(size_t)(g * 64 + n) * 16 + c]; bbr[c] = f_re * br - f_im * bi; bbi[c] = f_re * bi + f_im * br; }
    const int cc = lane & 15, qq = lane >> 4;
    float cre[16], cim[16];
#pragma unroll
    for (int i = 0; i < 16; ++i) { cre[i] = c_re[(size_t)(g * 16 + cc) * 64 + qq * 16 + i]; cim[i] = c_im[(size_t)(g * 16 + cc) * 64 + qq * 16 + i]; }
    const float dco = dvec[g * 16 + cc];
    float xr = 0.f, xi = 0.f;
    for (int t = 0; t < SQ; ++t) {
        const size_t r = (size_t)b * SQ + t;
        const float uval = bf2f(proj[r * PW + P_SU + g * 16 + cc]);
        float bur = 0.f, bui = 0.f;
#pragma unroll
        for (int c = 0; c < 16; ++c) { const float uc = __shfl(uval, c); bur += bbr[c] * uc; bui += bbi[c] * uc; }
        const float nr = abr * xr - abi * xi + bur, ni = abr * xi + abi * xr + bui; xr = nr; xi = ni;
        xs[n] = xr; xs[64 + n] = xi;
        LDS_WAIT(); asm volatile("" ::: "memory");
        float part = 0.f;
#pragma unroll
        for (int i = 0; i < 16; ++i) part += cre[i] * xs[qq * 16 + i] - cim[i] * xs[64 + qq * 16 + i];
        part += __shfl_xor(part, 16); part += __shfl_xor(part, 32);
        const float y = part + dco * uval;
        if (lane < 16) hg[r * 256 + g * 16 + lane] = gelu_tanh(y);
        LDS_WAIT(); asm volatile("" ::: "memory");
    }
}
__device__ __forceinline__ void k_s5_glu(int vb, int tid, LAS float* hs, const float* __restrict__ hg, const float* __restrict__ gw  , const float* __restrict__ gb, float* __restrict__ mixraw) {
    const int r = vb;
    hs[tid] = hg[(size_t)r * 256 + tid];
    __syncthreads();
    float z = gb[tid];
    for (int i = 0; i < 256; ++i) z += hs[i] * gw[i * 256 + tid];
    mixraw[(size_t)r * 1024 + 768 + tid] = hs[tid] * sigmoid_f(z);
}
__device__ __forceinline__ void k_mixfinal(int vb, int tid, LAS float* sm, const bf16* __restrict__ proj, const float* __restrict__ mixraw, const float* __restrict__ ocmp, int ldoc, const float* __restrict__ os, const float* __restrict__ ow,
                                                  const float* __restrict__ og  , bf16* __restrict__ mix) {
    LAS float (*red)[4] = (LAS float (*)[4])sm;
    const int r = vb, lane = tid & 63, w = tid >> 6;
    float v[4];
    v[0] = mixraw[(size_t)r * 1024 + tid]; v[2] = mixraw[(size_t)r * 1024 + 512 + tid]; v[3] = mixraw[(size_t)r * 1024 + 768 + tid];
    {   const bf16* gp = proj + (size_t)r * PW + P_NG + 3 * w;
        const float g0 = sigmoid_f(bf2f(gp[0])), g1 = sigmoid_f(bf2f(gp[1])), g2 = sigmoid_f(bf2f(gp[2]));
        v[1] = g0 * ocmp[(size_t)r * ldoc + tid] + g1 * os[(size_t)r * 256 + tid] + g2 * ow[(size_t)r * 256 + tid]; }
#pragma unroll
    for (int gidx = 0; gidx < 4; ++gidx) { const float s = wave_sum(v[gidx] * v[gidx]); if (lane == 0) red[gidx][w] = s; }
    __syncthreads();
#pragma unroll
    for (int gidx = 0; gidx < 4; ++gidx) { const float ss = red[gidx][0] + red[gidx][1] + red[gidx][2] + red[gidx][3];
        mix[(size_t)r * 1024 + gidx * 256 + tid] = (bf16)f2bf(v[gidx] * rsqrtf(ss * (1.0f / 256.0f) + 1e-6f) * og[gidx * 256 + tid]); }
}

typedef short s16x4 __attribute__((ext_vector_type(4)));
constexpr float ATT_SC = 0.125f * 1.4426950408889634f;
constexpr int VROWB = 144;
struct AttSt { f32x4 o[4]; float l; };
__device__ __forceinline__ s16x4 lds_tr16(const LAS unsigned char* p) { return __builtin_bit_cast(s16x4, __builtin_amdgcn_ds_read_tr16_b64_v4i16((LAS s16x4*)p)); }
__device__ __forceinline__ unsigned cvtpk(float lo, float hi) { return pg8::cvt_pk_bf16(lo, hi); }

constexpr float ATT_REF = 16.0f;
template <int NG>
__device__ __forceinline__ void att_unit(const bf16x8 (&kf)[2][2], const LAS unsigned char* vl, const bf16x8 (&qf)[NG][2], AttSt (&st)[NG],
                                         const int (&d0)[NG], const float (&c1)[NG], const int (&dmax)[NG], int dstep, int lane) {
    const int g = lane >> 4, i16 = lane & 15;
    const LAS unsigned char* vrd = vl + (4 * g + (i16 >> 2)) * VROWB + (i16 & 3) * 8;
    bf16x8 vt[4];
#pragma unroll
    for (int db = 0; db < 4; ++db) { const s16x4 a = lds_tr16(vrd + db * 32), b = lds_tr16(vrd + 16 * VROWB + db * 32);
        vt[db] = (bf16x8){a[0], a[1], a[2], a[3], b[0], b[1], b[2], b[3]}; }
    asm volatile("s_waitcnt lgkmcnt(0)" ::: "memory");
#pragma unroll
    for (int gi = 0; gi < NG; ++gi) {
        f32x4 s0 = {0.f, 0.f, 0.f, 0.f}, s1 = {0.f, 0.f, 0.f, 0.f};
        s0 = __builtin_amdgcn_mfma_f32_16x16x32_bf16(kf[0][0], qf[gi][0], s0, 0, 0, 0);
        s0 = __builtin_amdgcn_mfma_f32_16x16x32_bf16(kf[0][1], qf[gi][1], s0, 0, 0, 0);
        s1 = __builtin_amdgcn_mfma_f32_16x16x32_bf16(kf[1][0], qf[gi][0], s1, 0, 0, 0);
        s1 = __builtin_amdgcn_mfma_f32_16x16x32_bf16(kf[1][1], qf[gi][1], s1, 0, 0, 0);
        const float cd = c1[gi] * (float)dstep, B0 = fmaf(-c1[gi], (float)d0[gi], -ATT_REF);
        float x[8];
#pragma unroll
        for (int e = 0; e < 8; ++e) { const int kq = 16 * (e >> 2) + (e & 3), dist = d0[gi] - dstep * kq; const float a = (e < 4) ? s0[e & 3] : s1[e & 3];
            const float v = __builtin_amdgcn_exp2f(fmaf(a, ATT_SC, fmaf(cd, (float)kq, B0)));
            x[e] = ((unsigned)dist <= (unsigned)dmax[gi]) ? v : 0.f; }
        st[gi].l += ((x[0] + x[1]) + (x[2] + x[3])) + ((x[4] + x[5]) + (x[6] + x[7]));
        v4u pw; pw.x = cvtpk(x[0], x[1]); pw.y = cvtpk(x[2], x[3]); pw.z = cvtpk(x[4], x[5]); pw.w = cvtpk(x[6], x[7]);
        const bf16x8 pf = __builtin_bit_cast(bf16x8, pw);
#pragma unroll
        for (int db = 0; db < 4; ++db) st[gi].o[db] = __builtin_amdgcn_mfma_f32_16x16x32_bf16(vt[db], pf, st[gi].o[db], 0, 0, 0);
    }
}
__device__ __forceinline__ void att_load_k(bf16x8 (&kf)[2][2], const bf16* kb, int pitch, int r0, int r1, int g) {
    kf[0][0] = *(const bf16x8*)(kb + (size_t)r0 * pitch + 8 * g); kf[0][1] = *(const bf16x8*)(kb + (size_t)r0 * pitch + 32 + 8 * g);
    kf[1][0] = *(const bf16x8*)(kb + (size_t)r1 * pitch + 8 * g); kf[1][1] = *(const bf16x8*)(kb + (size_t)r1 * pitch + 32 + 8 * g);
}
__device__ __forceinline__ void att_load_v(v4u (&vf)[4], const bf16* vb, int pitch, const int (&vr)[4], int lane) {
#pragma unroll
    for (int i = 0; i < 4; ++i) vf[i] = *(const v4u*)(vb + (size_t)vr[i] * pitch + 8 * (lane & 7));
}
__device__ __forceinline__ void att_store_v(LAS unsigned char* vl, const v4u (&vf)[4], int lane) {
#pragma unroll
    for (int i = 0; i < 4; ++i) *(LAS v4u*)(vl + (8 * i + (lane >> 3)) * VROWB + 16 * (lane & 7)) = vf[i];
    asm volatile("s_waitcnt lgkmcnt(0)" ::: "memory");
}
__device__ __forceinline__ void att_init(AttSt& s) {
#pragma unroll
    for (int db = 0; db < 4; ++db) s.o[db] = (f32x4){0.f, 0.f, 0.f, 0.f};
    s.l = 0.f;
}
__device__ __forceinline__ void att_load_q(bf16x8 (&q)[2], const bf16* qp  , int g) {
    q[0] = *(const bf16x8*)(qp + 8 * g); q[1] = *(const bf16x8*)(qp + 32 + 8 * g);
}
__device__ __forceinline__ void att_finish(AttSt& s) {
    float l = s.l; l += __shfl_xor(l, 16); l += __shfl_xor(l, 32);
    const float il = l > 0.f ? 1.0f / l : 0.f;
#pragma unroll
    for (int db = 0; db < 4; ++db) s.o[db] = s.o[db] * il;
}

__device__ __forceinline__ void att_store_bf16(bf16* op, const AttSt& s) {
#pragma unroll
    for (int db = 0; db < 4; ++db) { v2u w; w.x = pk2(s.o[db][0], s.o[db][1]); w.y = pk2(s.o[db][2], s.o[db][3]); *(v2u*)(op + 16 * db) = w; }
}
__device__ __forceinline__ void nsa_win_job(int job, int lane, LAS unsigned char* vl, const bf16* __restrict__ proj, bf16* __restrict__ ow) {
    const int b = job / (SQ / 8), t0 = (job % (SQ / 8)) * 8, g = lane >> 4, c = lane & 15, qi = c >> 2, h = c & 3;
    const bf16* pb = proj + (size_t)b * SQ * PW;
    bf16x8 qf[2][2]; AttSt st[2]; int tq[2], dmax[2], d0[2]; float c1[2];
#pragma unroll
    for (int gi = 0; gi < 2; ++gi) { tq[gi] = t0 + 4 * gi + qi; att_load_q(qf[gi], pb + (size_t)tq[gi] * PW + P_NQ + 64 * h, g); att_init(st[gi]);
        c1[gi] = exp2f(-(2.0f * h + 1.0f)) * 1.4426950408889634f; dmax[gi] = tq[gi] < 511 ? tq[gi] : 511; }
    const int u0 = (t0 - 511) > 0 ? ((t0 - 511) >> 5) : 0, u1 = (t0 + 7) >> 5;
    bf16x8 kf[2][2]; v4u vf[4]; int vr[4];
    {   const int p0 = 32 * u0;
#pragma unroll
        for (int i = 0; i < 4; ++i) vr[i] = p0 + 8 * i + (lane >> 3);
        att_load_k(kf, pb + P_KW, PW, p0 + c, p0 + 16 + c, g); att_load_v(vf, pb + P_VW, PW, vr, lane); }
    for (int u = u0; u <= u1; ++u) {
        bf16x8 kc[2][2];
#pragma unroll
        for (int a = 0; a < 2; ++a)
#pragma unroll
            for (int k = 0; k < 2; ++k) kc[a][k] = kf[a][k];
        att_store_v(vl, vf, lane);
        if (u < u1) { const int p1 = 32 * (u + 1);
#pragma unroll
            for (int i = 0; i < 4; ++i) vr[i] = p1 + 8 * i + (lane >> 3);
            att_load_k(kf, pb + P_KW, PW, p1 + c, p1 + 16 + c, g); att_load_v(vf, pb + P_VW, PW, vr, lane); }
#pragma unroll
        for (int gi = 0; gi < 2; ++gi) d0[gi] = tq[gi] - 32 * u - 4 * g;
        att_unit<2>(kc, vl, qf, st, d0, c1, dmax, 1, lane);
    }
#pragma unroll
    for (int gi = 0; gi < 2; ++gi) { att_finish(st[gi]);
        att_store_bf16(ow + (size_t)(b * SQ + tq[gi]) * 256 + 64 * h + 4 * g, st[gi]); }
}

__device__ __forceinline__ void nsa_sel_job(int job, int lane, LAS unsigned char* vl, const bf16* __restrict__ proj, const unsigned long long* __restrict__ sel, bf16* __restrict__ os) {
    const int b = job / (SQ / 8), t0 = (job % (SQ / 8)) * 8, g = lane >> 4, c = lane & 15, qi = c >> 2, h = c & 3;
    const bf16* pb = proj + (size_t)b * SQ * PW;
    const unsigned long long mk = sel[(size_t)b * SQ + t0 + (lane & 7)];
    const unsigned mlo = (unsigned)mk, mhi = (unsigned)(mk >> 32);
    unsigned ulo = 0u, uhi = 0u;
#pragma unroll
    for (int k = 0; k < 8; ++k) { ulo |= (unsigned)__shfl((int)mlo, k); uhi |= (unsigned)__shfl((int)mhi, k); }
    ulo = __builtin_amdgcn_readfirstlane(ulo); uhi = __builtin_amdgcn_readfirstlane(uhi);
    const int cur = t0 >> 6;
    unsigned long long rem = ((unsigned long long)uhi << 32) | ulo;
    if (cur < 63) rem &= ((2ull << cur) - 1ull);
    bf16x8 qf[2][2]; AttSt st[2]; int tq[2], dmax[2], d0[2]; float c1[2]; unsigned long long mq[2];
#pragma unroll
    for (int gi = 0; gi < 2; ++gi) { tq[gi] = t0 + 4 * gi + qi; att_load_q(qf[gi], pb + (size_t)tq[gi] * PW + P_NQ + 64 * h, g); att_init(st[gi]);
        c1[gi] = exp2f(-(2.0f * h + 1.0f)) * 1.4426950408889634f; dmax[gi] = tq[gi];
        mq[gi] = ((unsigned long long)(unsigned)__shfl((int)mhi, 4 * gi + qi) << 32) | (unsigned)__shfl((int)mlo, 4 * gi + qi); }
    int j = __builtin_ctzll(rem), hf = 0;
    bf16x8 kf[2][2]; v4u vf[4]; int vr[4];
    {   const int p0 = 64 * j;
#pragma unroll
        for (int i = 0; i < 4; ++i) vr[i] = p0 + 8 * i + (lane >> 3);
        att_load_k(kf, pb + P_KS, PW, p0 + c, p0 + 16 + c, g); att_load_v(vf, pb + P_VS, PW, vr, lane); }
    for (;;) {
        bf16x8 kc[2][2];
#pragma unroll
        for (int a = 0; a < 2; ++a)
#pragma unroll
            for (int k = 0; k < 2; ++k) kc[a][k] = kf[a][k];
        att_store_v(vl, vf, lane);
        int nj = j, nhf = hf + 1; bool has = true;
        if (nhf == 2) { rem &= rem - 1ull; if (rem == 0ull) has = false; else { nj = __builtin_ctzll(rem); nhf = 0; } }
        if (has) { const int p1 = 64 * nj + 32 * nhf;
#pragma unroll
            for (int i = 0; i < 4; ++i) vr[i] = p1 + 8 * i + (lane >> 3);
            att_load_k(kf, pb + P_KS, PW, p1 + c, p1 + 16 + c, g); att_load_v(vf, pb + P_VS, PW, vr, lane); }
#pragma unroll
        for (int gi = 0; gi < 2; ++gi) d0[gi] = ((mq[gi] >> j) & 1ull) ? (tq[gi] - (64 * j + 32 * hf) - 4 * g) : -1000000;
        att_unit<2>(kc, vl, qf, st, d0, c1, dmax, 1, lane);
        if (!has) break;
        j = nj; hf = nhf;
    }
#pragma unroll
    for (int gi = 0; gi < 2; ++gi) { att_finish(st[gi]);
        att_store_bf16(os + (size_t)(b * SQ + tq[gi]) * 256 + 64 * h + 4 * g, st[gi]); }
}

__device__ __forceinline__ void dil_job(int job, int lane, LAS unsigned char* vl, const bf16* __restrict__ proj, bf16* __restrict__ mixraw, const float* __restrict__ do1, const float* __restrict__ dl1) {
    const int r = job & 15, blk = (job >> 4) & 15, h = (job >> 8) & 3, b = job >> 10, g = lane >> 4, c = lane & 15;
    const int tb = 256 * blk + r;
    const bf16* pb = proj + (size_t)b * SQ * PW;
    bf16x8 qf[1][2]; AttSt st[1]; int dmax[1], d0[1]; float c1[1];
    const int tq = tb + 16 * c;
    att_load_q(qf[0], pb + (size_t)tq * PW + P_DQ + 64 * h, g); att_init(st[0]);
    c1[0] = exp2f(-2.0f * (h + 1)) * 1.4426950408889634f;
    const bf16* kb = pb + P_DK + 64 * h; const bf16* vb = pb + P_DV + 64 * h;
#pragma unroll 1
    for (int p = 0; p < 2; ++p) {
        const int dil = (p == 0) ? 16 : 4, win = (p == 0) ? 2048 : 512, nun = (p == 0) ? 5 : 6;
        const int pstart = tb - win;
        dmax[0] = tq < win ? tq : win;
        bf16x8 kf[2][2]; v4u vf[4]; int vr[4];
#define DIL_ROW(n) ({ int _p = pstart + dil * (n); _p = _p < 0 ? 0 : _p; _p > SQ - 1 ? SQ - 1 : _p; })
        {
#pragma unroll
            for (int i = 0; i < 4; ++i) vr[i] = DIL_ROW(8 * i + (lane >> 3));
            att_load_k(kf, kb, PW, DIL_ROW(c), DIL_ROW(16 + c), g); att_load_v(vf, vb, PW, vr, lane); }
        for (int u = 0; u < nun; ++u) {
            bf16x8 kc[2][2];
#pragma unroll
            for (int a = 0; a < 2; ++a)
#pragma unroll
                for (int k = 0; k < 2; ++k) kc[a][k] = kf[a][k];
            att_store_v(vl, vf, lane);
            if (u + 1 < nun) { const int n1 = 32 * (u + 1);
#pragma unroll
                for (int i = 0; i < 4; ++i) vr[i] = DIL_ROW(n1 + 8 * i + (lane >> 3));
                att_load_k(kf, kb, PW, DIL_ROW(n1 + c), DIL_ROW(n1 + 16 + c), g); att_load_v(vf, vb, PW, vr, lane); }
            d0[0] = tq - (pstart + dil * (32 * u + 4 * g));
            att_unit<1>(kc, vl, qf, st, d0, c1, dmax, dil, lane);
        }
#undef DIL_ROW
    }
    {   const float* op = do1 + (size_t)(b * SQ + tq) * 256 + 64 * h + 4 * g;
        f32x4 p1[4];
#pragma unroll
        for (int db = 0; db < 4; ++db) p1[db] = *(const f32x4*)(op + 16 * db);
        float l = st[0].l; l += __shfl_xor(l, 16); l += __shfl_xor(l, 32); l += dl1[(size_t)(b * SQ + tq) * 4 + h];
        const float il = 1.0f / l;
#pragma unroll
        for (int db = 0; db < 4; ++db) st[0].o[db] = (st[0].o[db] + p1[db]) * il; }
    att_store_bf16(mixraw + (size_t)(b * SQ + tq) * 1024 + 64 * h + 4 * g, st[0]);
}


__device__ __forceinline__ void dil_p1_job(int job, int lane, LAS unsigned char* vl, const bf16* __restrict__ proj, float* __restrict__ do1, float* __restrict__ dl1) {
    const int qb = job & 127, h = (job >> 7) & 3, b = job >> 9, g = lane >> 4, c = lane & 15, t0 = 32 * qb;
    const bf16* pb = proj + (size_t)b * SQ * PW; const bf16* kb = pb + P_DK + 64 * h; const bf16* vb = pb + P_DV + 64 * h;
    bf16x8 qf[2][2]; AttSt st[2]; int tq[2], dmax[2], d0[2]; float c1[2];
#pragma unroll
    for (int gi = 0; gi < 2; ++gi) { tq[gi] = t0 + 16 * gi + c; att_load_q(qf[gi], pb + (size_t)tq[gi] * PW + P_DQ + 64 * h, g); att_init(st[gi]);
        c1[gi] = exp2f(-2.0f * (h + 1)) * 1.4426950408889634f; dmax[gi] = tq[gi] < 128 ? tq[gi] : 128; }
    const int u0 = (t0 - 128) > 0 ? ((t0 - 128) >> 5) : 0, u1 = (t0 + 31) >> 5;
    bf16x8 kf[2][2]; v4u vf[4]; int vr[4];
    {   const int p0 = 32 * u0;
#pragma unroll
        for (int i = 0; i < 4; ++i) vr[i] = p0 + 8 * i + (lane >> 3);
        att_load_k(kf, kb, PW, p0 + c, p0 + 16 + c, g); att_load_v(vf, vb, PW, vr, lane); }
    for (int u = u0; u <= u1; ++u) {
        bf16x8 kc[2][2];
#pragma unroll
        for (int a = 0; a < 2; ++a)
#pragma unroll
            for (int k = 0; k < 2; ++k) kc[a][k] = kf[a][k];
        att_store_v(vl, vf, lane);
        if (u < u1) { const int p1 = 32 * (u + 1);
#pragma unroll
            for (int i = 0; i < 4; ++i) vr[i] = p1 + 8 * i + (lane >> 3);
            att_load_k(kf, kb, PW, p1 + c, p1 + 16 + c, g); att_load_v(vf, vb, PW, vr, lane); }
#pragma unroll
        for (int gi = 0; gi < 2; ++gi) d0[gi] = tq[gi] - 32 * u - 4 * g;
        att_unit<2>(kc, vl, qf, st, d0, c1, dmax, 1, lane);
    }
#pragma unroll
    for (int gi = 0; gi < 2; ++gi) { float l = st[gi].l; l += __shfl_xor(l, 16); l += __shfl_xor(l, 32);
        float* op = do1 + (size_t)(b * SQ + tq[gi]) * 256 + 64 * h + 4 * g;
#pragma unroll
        for (int db = 0; db < 4; ++db) *(f32x4*)(op + 16 * db) = st[gi].o[db];
        if (g == 0) dl1[(size_t)(b * SQ + tq[gi]) * 4 + h] = l; }
}

__device__ __forceinline__ void cmp_second_job(int jw, int lane, const bf16* __restrict__ chid, const bf16* __restrict__ w2t  , const float* __restrict__ gk, bf16* __restrict__ KCb, bf16* __restrict__ VCb) {
    const int i16 = lane & 15, g4 = lane >> 4, which = jw >> 7;
    const bf16* hp = chid + (size_t)(16 * jw + i16) * 256 + 8 * g4; const bf16* wp = w2t + (size_t)which * 64 * 256 + (size_t)i16 * 256 + 8 * g4;
    f32x4 acc[4] = {{0.f, 0.f, 0.f, 0.f}, {0.f, 0.f, 0.f, 0.f}, {0.f, 0.f, 0.f, 0.f}, {0.f, 0.f, 0.f, 0.f}};
#pragma unroll
    for (int ks = 0; ks < 8; ++ks) { const bf16x8 af = *(const bf16x8*)(hp + 32 * ks);
#pragma unroll
        for (int cb = 0; cb < 4; ++cb) { const bf16x8 bfg = *(const bf16x8*)(wp + (size_t)cb * 16 * 256 + 32 * ks); acc[cb] = __builtin_amdgcn_mfma_f32_16x16x32_bf16(af, bfg, acc[cb], 0, 0, 0); } }
    bf16* dst = which ? VCb : KCb;
#pragma unroll
    for (int r = 0; r < 4; ++r) {
        const int R = (16 * jw + 4 * g4 + r) & 2047;
        float v[4] = {acc[0][r], acc[1][r], acc[2][r], acc[3][r]};
        if (which == 0) { float ss = (v[0] * v[0] + v[1] * v[1]) + (v[2] * v[2] + v[3] * v[3]);
            ss += __shfl_xor(ss, 1); ss += __shfl_xor(ss, 2); ss += __shfl_xor(ss, 4); ss += __shfl_xor(ss, 8);
            const float rs = rsqrtf(ss * (1.0f / 64.0f) + 1e-6f);
#pragma unroll
            for (int cb = 0; cb < 4; ++cb) v[cb] *= rs * gk[16 * cb + i16]; }
        if (R < NB * NCMP) { const int b = R / NCMP, c = R - b * NCMP;
#pragma unroll
            for (int cb = 0; cb < 4; ++cb) dst[((size_t)b * 256 + c) * 64 + 16 * cb + i16] = (bf16)f2bf(v[cb]); }
        else { const int b = R - NB * NCMP;
#pragma unroll
            for (int cb = 0; cb < 4; ++cb) dst[((size_t)b * 256 + 255) * 64 + 16 * cb + i16] = 0; }
    }
}

__device__ __forceinline__ void cmp_second(int row, int lane, const bf16* __restrict__ chid, const float* __restrict__ w2  , const float* __restrict__ gk, bf16* __restrict__ KCb, bf16* __restrict__ VCb) {
    const int which = row >> 11, R = row & 2047;
    if (R >= NB * NCMP) { if (R < NB * NCMP + NB) { const int b = R - NB * NCMP; (which ? VCb : KCb)[((size_t)b * 256 + 255) * 64 + lane] = 0; } return; }
    const int b = R / NCMP, c = R - b * NCMP;
    const bf16* hp = chid + (size_t)row * 256; const float* wp = w2 + (size_t)which * 256 * 64 + lane;
    float o = 0.f;
#pragma unroll 4
    for (int j8 = 0; j8 < 32; ++j8) { const v4u hv = *(const v4u*)(hp + 8 * j8); const float* w = wp + j8 * 8 * 64;
        o += bflo(hv.x) * w[0] + bfhi(hv.x) * w[64] + bflo(hv.y) * w[128] + bfhi(hv.y) * w[192] + bflo(hv.z) * w[256] + bfhi(hv.z) * w[320] + bflo(hv.w) * w[384] + bfhi(hv.w) * w[448]; }
    if (which == 0) { const float ss = wave_sum(o * o); o = o * rsqrtf(ss * (1.0f / 64.0f) + 1e-6f) * gk[lane]; KCb[((size_t)b * 256 + c) * 64 + lane] = (bf16)f2bf(o); }
    else VCb[((size_t)b * 256 + c) * 64 + lane] = (bf16)f2bf(o);
}

__device__ __forceinline__ void nsa_cmp_job(int job, int lane, LAS unsigned char* vl, const bf16* __restrict__ proj, const bf16* __restrict__ KCb, const bf16* __restrict__ VCb,
                                            bf16* __restrict__ ocmp, int ldoc, unsigned long long* __restrict__ sel) {
    const int b = job / (SQ / 8), t0 = (job % (SQ / 8)) * 8, g = lane >> 4, c = lane & 15, qi = c >> 2, h = c & 3;
    const bf16* pb = proj + (size_t)b * SQ * PW; const bf16* kb = KCb + (size_t)b * 256 * 64; const bf16* vb = VCb + (size_t)b * 256 * 64;
    LAS float* impA = (LAS float*)(vl + 8192); LAS float* impB = impA + 8 * 64;
    bf16x8 qf[2][2]; AttSt st[2]; int tq[2], dmax[2], d0[2]; float c1[2];
#pragma unroll
    for (int gi = 0; gi < 2; ++gi) { tq[gi] = t0 + 4 * gi + qi; att_load_q(qf[gi], pb + (size_t)tq[gi] * PW + P_NQ + 64 * h, g); att_init(st[gi]);
        c1[gi] = exp2f(-(2.0f * h + 1.0f)) * 1.4426950408889634f; dmax[gi] = 1 << 20; }
    const int nun = (t0 + 7 >= 31) ? ((((t0 + 7 - 31) >> 4) >> 5) + 1) : 0;
    for (int i = lane; i < 2 * 8 * 64; i += 64) impA[i] = 0.f;
    int vr[4];
    for (int u = 0; u < nun; ++u) {
        bf16x8 kf[2][2]; v4u vf[4];
#pragma unroll
        for (int i = 0; i < 4; ++i) vr[i] = 32 * u + 8 * i + (lane >> 3);
        att_load_k(kf, kb, 64, 32 * u + c, 32 * u + 16 + c, g); att_load_v(vf, vb, 64, vr, lane);
        att_store_v(vl, vf, lane);
#pragma unroll
        for (int gi = 0; gi < 2; ++gi) d0[gi] = tq[gi] - 31 - 16 * (32 * u + 4 * g);
        att_unit<2>(kf, vl, qf, st, d0, c1, dmax, 16, lane);
    }
    float il[2];
#pragma unroll
    for (int gi = 0; gi < 2; ++gi) { float l = st[gi].l; l += __shfl_xor(l, 16); l += __shfl_xor(l, 32); il[gi] = l > 0.f ? 1.0f / l : 0.f;
        bf16* op = ocmp + (size_t)(b * SQ + tq[gi]) * ldoc + 64 * h + 4 * g;
#pragma unroll
        for (int db = 0; db < 4; ++db) { const f32x4 t = st[gi].o[db] * il[gi]; v2u w; w.x = pk2(t[0], t[1]); w.y = pk2(t[2], t[3]); *(v2u*)(op + 16 * db) = w; } }
    bf16x8 kn[2][2];
    if (nun > 0) att_load_k(kn, kb, 64, c, 16 + c, g);
    for (int u = 0; u < nun; ++u) {
        bf16x8 kf[2][2];
#pragma unroll
        for (int a_ = 0; a_ < 2; ++a_) { kf[a_][0] = kn[a_][0]; kf[a_][1] = kn[a_][1]; }
        if (u + 1 < nun) att_load_k(kn, kb, 64, 32 * (u + 1) + c, 32 * (u + 1) + 16 + c, g);
#pragma unroll
        for (int gi = 0; gi < 2; ++gi) {
            f32x4 s0 = {0.f, 0.f, 0.f, 0.f}, s1 = {0.f, 0.f, 0.f, 0.f};
            s0 = __builtin_amdgcn_mfma_f32_16x16x32_bf16(kf[0][0], qf[gi][0], s0, 0, 0, 0); s0 = __builtin_amdgcn_mfma_f32_16x16x32_bf16(kf[0][1], qf[gi][1], s0, 0, 0, 0);
            s1 = __builtin_amdgcn_mfma_f32_16x16x32_bf16(kf[1][0], qf[gi][0], s1, 0, 0, 0); s1 = __builtin_amdgcn_mfma_f32_16x16x32_bf16(kf[1][1], qf[gi][1], s1, 0, 0, 0);
            const int dd = tq[gi] - 31 - 16 * (32 * u + 4 * g);
            float S4[2], P3[2];
#pragma unroll
            for (int blk = 0; blk < 2; ++blk) { float sum = 0.f, last = 0.f;
#pragma unroll
                for (int r = 0; r < 4; ++r) { const int dist = dd - 16 * (16 * blk + r); const float a = blk ? s1[r] : s0[r];
                    const float p = (dist >= 0) ? __builtin_amdgcn_exp2f(fmaf(a, ATT_SC, fmaf(-c1[gi], (float)dist, -ATT_REF))) * il[gi] : 0.f; sum += p; last = p; }
                S4[blk] = sum; P3[blk] = last; }
#pragma unroll
            for (int blk = 0; blk < 2; ++blk) { S4[blk] += dpp_xor1(S4[blk]); S4[blk] += dpp_xor2(S4[blk]); P3[blk] += dpp_xor1(P3[blk]); P3[blk] += dpp_xor2(P3[blk]); }
            if (h == 0) {
#pragma unroll
                for (int blk = 0; blk < 2; ++blk) { const int c4 = 8 * u + 4 * blk + g, q = 4 * gi + qi; impA[q * 64 + c4] = S4[blk]; if (c4 < 63) impB[q * 64 + c4 + 1] = P3[blk]; } }
        }
    }
    asm volatile("s_waitcnt lgkmcnt(0)" ::: "memory");
    LAS float* valL = impB + 8 * 64;
    const int cur = t0 >> 6, j = lane;
#pragma unroll 1
    for (int q = 0; q < 8; ++q) {
        const float imp = impA[q * 64 + j] + impB[q * 64 + j];
        const bool forced = (j == 0) || (j == cur) || (j == cur - 1);
        const float val = (j <= cur) ? (imp + (forced ? 1.0e4f : 0.f)) : -1.0e30f;
        valL[j] = val;
        asm volatile("s_waitcnt lgkmcnt(0)" ::: "memory");
        int rank = 0;
#pragma unroll
        for (int k4 = 0; k4 < 16; ++k4) { const f32x4 o = *(const LAS f32x4*)(valL + 4 * k4);
#pragma unroll
            for (int k = 0; k < 4; ++k) rank += (o[k] > val || (o[k] == val && (4 * k4 + k) < j)) ? 1 : 0; }
        const unsigned long long mask = __ballot(rank < 16);
        if (lane == 0) sel[(size_t)b * SQ + t0 + q] = mask;
        asm volatile("s_waitcnt lgkmcnt(0)" ::: "memory");
    }
}


constexpr int SEG = 64, NSEG = SQ / SEG;
typedef float f32x2 __attribute__((ext_vector_type(2)));
__device__ __forceinline__ void gla_gate_row(int row, int lane, const bf16* __restrict__ proj, const float* __restrict__ wa2, const float* __restrict__ ba, float* __restrict__ GA) {
    const bf16* pr = proj + (size_t)row * PW + P_GA;
    const v4u a0 = *(const v4u*)pr, a1 = *(const v4u*)(pr + 8);
    float gv[16] = {bflo(a0.x), bfhi(a0.x), bflo(a0.y), bfhi(a0.y), bflo(a0.z), bfhi(a0.z), bflo(a0.w), bfhi(a0.w), bflo(a1.x), bfhi(a1.x), bflo(a1.y), bfhi(a1.y), bflo(a1.z), bfhi(a1.z), bflo(a1.w), bfhi(a1.w)};
#pragma unroll
    for (int hh = 0; hh < 2; ++hh) { const int j = lane + 64 * hh; float z = ba[j];
#pragma unroll
        for (int i = 0; i < 16; ++i) z += gv[i] * wa2[i * 128 + j];
        GA[(size_t)row * 128 + j] = log_sigmoid_f(z) * (1.0f / 16.0f); }
}
constexpr int GLA_KLROWB = 80;
template <bool OUT>
__device__ __forceinline__ void gla_seg(int job, int lane, LAS unsigned char* vl, const bf16* __restrict__ proj, const float* __restrict__ GA, float* __restrict__ Sbuf, float* __restrict__ Dbuf,
                                        const float* __restrict__ ng, bf16* __restrict__ mixraw) {
    const int seg = job % NSEG, h = (job / NSEG) & 3, b = job / (NSEG * 4), g4 = lane >> 4, i16 = lane & 15;
    LAS unsigned char* kll = vl + 16 * VROWB;
    f32x4 Sr[4][2];
    float* sp = Sbuf + (size_t)job * 2048 + lane;
#pragma unroll
    for (int vb = 0; vb < 4; ++vb)
#pragma unroll
        for (int kb = 0; kb < 2; ++kb)
#pragma unroll
            for (int r = 0; r < 4; ++r) Sr[vb][kb][r] = OUT ? sp[((vb * 2 + kb) * 4 + r) * 64] : 0.f;
    float btot[8];
#pragma unroll
    for (int jj = 0; jj < 8; ++jj) btot[jj] = 0.f;
    const size_t r0 = (size_t)b * SQ + (size_t)seg * SEG;
    const LAS unsigned char* vrd = vl + (4 * g4 + (i16 >> 2)) * VROWB + (i16 & 3) * 8;
    const LAS unsigned char* klrd = kll + (4 * g4 + (i16 >> 2)) * GLA_KLROWB + (i16 & 3) * 8;
    f32x4 nla0, nla1; v2u nkw0, nkw1, nqw0 = {0u, 0u}, nqw1 = {0u, 0u}, nrr[4] = {{0u, 0u}, {0u, 0u}, {0u, 0u}, {0u, 0u}}; v4u nv0, nv1;
#define GLA_LOADCH(ch_) do { const size_t r_ = r0 + 16 * (ch_) + i16; const bf16* pr_ = proj + r_ * PW; \
        nla0 = *(const f32x4*)(GA + r_ * 128 + 32 * h + 4 * g4); nla1 = *(const f32x4*)(GA + r_ * 128 + 32 * h + 16 + 4 * g4); \
        nkw0 = *(const v2u*)(pr_ + P_GK + 32 * h + 4 * g4); nkw1 = *(const v2u*)(pr_ + P_GK + 32 * h + 16 + 4 * g4); \
        if (OUT) { nqw0 = *(const v2u*)(pr_ + P_GQ + 32 * h + 4 * g4); nqw1 = *(const v2u*)(pr_ + P_GQ + 32 * h + 16 + 4 * g4); \
            _Pragma("unroll") for (int vb_ = 0; vb_ < 4; ++vb_) nrr[vb_] = *(const v2u*)(pr_ + P_GR + 64 * h + 16 * vb_ + 4 * g4); } \
        const size_t rr_ = r0 + 16 * (ch_) + (lane >> 3); \
        nv0 = *(const v4u*)(proj + rr_ * PW + P_GV + 64 * h + 8 * (lane & 7)); nv1 = *(const v4u*)(proj + (rr_ + 8) * PW + P_GV + 64 * h + 8 * (lane & 7)); } while (0)
    GLA_LOADCH(0);
#pragma unroll 1
    for (int ch = 0; ch < SEG / 16; ++ch) {
        const size_t r = r0 + 16 * ch + i16;
        const f32x4 la0 = nla0, la1 = nla1; const v2u kw0 = nkw0, kw1 = nkw1, qw0 = nqw0, qw1 = nqw1; const v2u rrc[4] = {nrr[0], nrr[1], nrr[2], nrr[3]};
        *(LAS v4u*)(vl + (lane >> 3) * VROWB + 16 * (lane & 7)) = nv0; *(LAS v4u*)(vl + (8 + (lane >> 3)) * VROWB + 16 * (lane & 7)) = nv1;
        if (ch + 1 < SEG / 16) GLA_LOADCH(ch + 1);
        float bc[8] = {la0[0], la0[1], la0[2], la0[3], la1[0], la1[1], la1[2], la1[3]};
#pragma unroll
        for (int jj = 0; jj < 8; ++jj) bc[jj] += dpp_row_shr<1>(bc[jj]);
#pragma unroll
        for (int jj = 0; jj < 8; ++jj) bc[jj] += dpp_row_shr<2>(bc[jj]);
#pragma unroll
        for (int jj = 0; jj < 8; ++jj) bc[jj] += dpp_row_shr<4>(bc[jj]);
#pragma unroll
        for (int jj = 0; jj < 8; ++jj) bc[jj] += dpp_row_shr<8>(bc[jj]);
        const float kf[8] = {bflo(kw0.x), bfhi(kw0.x), bflo(kw0.y), bfhi(kw0.y), bflo(kw1.x), bfhi(kw1.x), bflo(kw1.y), bfhi(kw1.y)};
        float eb[8], emb[8], e15[8], b15[8];
#pragma unroll
        for (int jj = 0; jj < 8; ++jj) { b15[jj] = __shfl(bc[jj], 16 * g4 + 15); eb[jj] = __expf(bc[jj]); emb[jj] = __builtin_amdgcn_rcpf(eb[jj]); e15[jj] = __expf(b15[jj]); btot[jj] += b15[jj]; }
        {   v2u w0, w1; w0.x = pk2(kf[0] * e15[0] * emb[0], kf[1] * e15[1] * emb[1]); w0.y = pk2(kf[2] * e15[2] * emb[2], kf[3] * e15[3] * emb[3]);
            w1.x = pk2(kf[4] * e15[4] * emb[4], kf[5] * e15[5] * emb[5]); w1.y = pk2(kf[6] * e15[6] * emb[6], kf[7] * e15[7] * emb[7]);
            *(LAS v2u*)(kll + i16 * GLA_KLROWB + 8 * g4) = w0; *(LAS v2u*)(kll + i16 * GLA_KLROWB + 32 + 8 * g4) = w1; }
        asm volatile("s_waitcnt lgkmcnt(0)" ::: "memory");
        bf16x8 vt[4], klt[2];
#pragma unroll
        for (int vb = 0; vb < 4; ++vb) { const s16x4 a = lds_tr16(vrd + vb * 32); vt[vb] = (bf16x8){a[0], a[1], a[2], a[3], 0, 0, 0, 0}; }
#pragma unroll
        for (int kb = 0; kb < 2; ++kb) { const s16x4 a = lds_tr16(klrd + kb * 32); klt[kb] = (bf16x8){a[0], a[1], a[2], a[3], 0, 0, 0, 0}; }
        asm volatile("s_waitcnt lgkmcnt(0)" ::: "memory");
        if (OUT) {
            const float qf[8] = {bflo(qw0.x), bfhi(qw0.x), bflo(qw0.y), bfhi(qw0.y), bflo(qw1.x), bfhi(qw1.x), bflo(qw1.y), bfhi(qw1.y)};
            v4u qe_w, ke_w;
            qe_w.x = pk2(qf[0] * eb[0] * 0.17677669529663687f, qf[1] * eb[1] * 0.17677669529663687f); qe_w.y = pk2(qf[2] * eb[2] * 0.17677669529663687f, qf[3] * eb[3] * 0.17677669529663687f);
            qe_w.z = pk2(qf[4] * eb[4] * 0.17677669529663687f, qf[5] * eb[5] * 0.17677669529663687f); qe_w.w = pk2(qf[6] * eb[6] * 0.17677669529663687f, qf[7] * eb[7] * 0.17677669529663687f);
            ke_w.x = pk2(kf[0] * emb[0], kf[1] * emb[1]); ke_w.y = pk2(kf[2] * emb[2], kf[3] * emb[3]); ke_w.z = pk2(kf[4] * emb[4], kf[5] * emb[5]); ke_w.w = pk2(kf[6] * emb[6], kf[7] * emb[7]);
            const bf16x8 qe = __builtin_bit_cast(bf16x8, qe_w), ke = __builtin_bit_cast(bf16x8, ke_w);
            f32x4 at = {0.f, 0.f, 0.f, 0.f};
            at = __builtin_amdgcn_mfma_f32_16x16x32_bf16(ke, qe, at, 0, 0, 0);
            v4u pw; pw.x = pk2((4 * g4 + 0 <= i16) ? at[0] : 0.f, (4 * g4 + 1 <= i16) ? at[1] : 0.f); pw.y = pk2((4 * g4 + 2 <= i16) ? at[2] : 0.f, (4 * g4 + 3 <= i16) ? at[3] : 0.f); pw.z = 0u; pw.w = 0u;
            const bf16x8 pf = __builtin_bit_cast(bf16x8, pw);
            f32x4 o[4];
#pragma unroll
            for (int vb = 0; vb < 4; ++vb) {
                v4u sw; sw.x = pk2(Sr[vb][0][0], Sr[vb][0][1]); sw.y = pk2(Sr[vb][0][2], Sr[vb][0][3]); sw.z = pk2(Sr[vb][1][0], Sr[vb][1][1]); sw.w = pk2(Sr[vb][1][2], Sr[vb][1][3]);
                o[vb] = (f32x4){0.f, 0.f, 0.f, 0.f};
                o[vb] = __builtin_amdgcn_mfma_f32_16x16x32_bf16(__builtin_bit_cast(bf16x8, sw), qe, o[vb], 0, 0, 0);
                o[vb] = __builtin_amdgcn_mfma_f32_16x16x32_bf16(vt[vb], pf, o[vb], 0, 0, 0); }
            float ss = 0.f;
#pragma unroll
            for (int vb = 0; vb < 4; ++vb) ss += (o[vb][0] * o[vb][0] + o[vb][1] * o[vb][1]) + (o[vb][2] * o[vb][2] + o[vb][3] * o[vb][3]);
            ss += __shfl_xor(ss, 16); ss += __shfl_xor(ss, 32);
            const float rstd = rsqrtf(ss * (1.0f / 64.0f) + 1e-6f);
#pragma unroll
            for (int vb = 0; vb < 4; ++vb) { const f32x4 gn = *(const f32x4*)(ng + 16 * vb + 4 * g4); const v2u rr = rrc[vb];
                const float rf[4] = {bflo(rr.x), bfhi(rr.x), bflo(rr.y), bfhi(rr.y)}; float y[4];
#pragma unroll
                for (int q = 0; q < 4; ++q) y[q] = o[vb][q] * rstd * gn[q] * rf[q] * sigmoid_f(rf[q]);
                v2u w; w.x = pk2(y[0], y[1]); w.y = pk2(y[2], y[3]); *(v2u*)(mixraw + r * 1024 + 512 + 64 * h + 16 * vb + 4 * g4) = w; }
        }
#pragma unroll
        for (int vb = 0; vb < 4; ++vb)
#pragma unroll
            for (int kb = 0; kb < 2; ++kb) { f32x4 c = Sr[vb][kb];
#pragma unroll
                for (int q = 0; q < 4; ++q) c[q] *= e15[4 * kb + q];
                Sr[vb][kb] = __builtin_amdgcn_mfma_f32_16x16x32_bf16(klt[kb], vt[vb], c, 0, 0, 0); }
    }
#undef GLA_LOADCH
    if (!OUT) {
#pragma unroll
        for (int vb = 0; vb < 4; ++vb)
#pragma unroll
            for (int kb = 0; kb < 2; ++kb)
#pragma unroll
                for (int r = 0; r < 4; ++r) sp[((vb * 2 + kb) * 4 + r) * 64] = Sr[vb][kb][r];
        if (i16 == 0) {
#pragma unroll
            for (int jj = 0; jj < 8; ++jj) Dbuf[(size_t)job * 32 + ((jj < 4) ? (4 * g4 + jj) : (16 + 4 * g4 + (jj - 4)))] = __expf(btot[jj]); }
    }
}
__device__ __forceinline__ void gla_scan(int wj, int lane, float* __restrict__ Sbuf, const float* __restrict__ Dbuf) {
    const int e8 = wj & 7, kb = e8 & 1, bh = wj >> 3, g4 = lane >> 4;
    float S[4] = {0.f, 0.f, 0.f, 0.f};
    for (int s0 = 0; s0 < NSEG; s0 += 16) {
        float L[16][4]; f32x4 Dv[16];
#pragma unroll
        for (int u = 0; u < 16; ++u) { const size_t job = (size_t)bh * NSEG + s0 + u; Dv[u] = *(const f32x4*)(Dbuf + job * 32 + 16 * kb + 4 * g4);
#pragma unroll
            for (int j = 0; j < 4; ++j) L[u][j] = Sbuf[job * 2048 + (e8 * 4 + j) * 64 + lane]; }
#pragma unroll
        for (int u = 0; u < 16; ++u) { const size_t job = (size_t)bh * NSEG + s0 + u;
#pragma unroll
            for (int j = 0; j < 4; ++j) { Sbuf[job * 2048 + (e8 * 4 + j) * 64 + lane] = S[j]; S[j] = fmaf(S[j], Dv[u][j], L[u][j]); } }
    }
}

struct S5C { float abr, abi; f32x2 bb[16]; };
__device__ __forceinline__ void s5_consts(S5C& c, int g, int n, const float* __restrict__ a_re, const float* __restrict__ a_im, const float* __restrict__ b_re, const float* __restrict__ b_im, const float* __restrict__ log_dt) {
    const float dt = expf(log_dt[g]), are = a_re[g * 64 + n], aim = a_im[g * 64 + n];
    const float mag = expf(dt * are); c.abr = mag * cosf(dt * aim); c.abi = mag * sinf(dt * aim);
    const float den = are * are + aim * aim, f_re = ((c.abr - 1.0f) * are + c.abi * aim) / den, f_im = (c.abi * are - (c.abr - 1.0f) * aim) / den;
#pragma unroll
    for (int k = 0; k < 16; ++k) { const float br = b_re[(size_t)(g * 64 + n) * 16 + k], bi = b_im[(size_t)(g * 64 + n) * 16 + k]; c.bb[k] = (f32x2){f_re * br - f_im * bi, f_re * bi + f_im * br}; }
}
__device__ __forceinline__ void s5_step(const S5C& c, const v4u u0, const v4u u1, float& xr, float& xi) {
    const float uf[16] = {bflo(u0.x), bfhi(u0.x), bflo(u0.y), bfhi(u0.y), bflo(u0.z), bfhi(u0.z), bflo(u0.w), bfhi(u0.w), bflo(u1.x), bfhi(u1.x), bflo(u1.y), bfhi(u1.y), bflo(u1.z), bfhi(u1.z), bflo(u1.w), bfhi(u1.w)};
    f32x2 bu0 = {0.f, 0.f}, bu1 = {0.f, 0.f};
#pragma unroll
    for (int k = 0; k < 16; k += 2) { bu0 = __builtin_elementwise_fma(c.bb[k], (f32x2){uf[k], uf[k]}, bu0); bu1 = __builtin_elementwise_fma(c.bb[k + 1], (f32x2){uf[k + 1], uf[k + 1]}, bu1); }
    const f32x2 bu = bu0 + bu1;
    const float nr = c.abr * xr - c.abi * xi + bu.x, ni = c.abr * xi + c.abi * xr + bu.y; xr = nr; xi = ni;
}
__device__ __forceinline__ void s5_passA(int gw, int ngw, int lane, const bf16* __restrict__ proj, const float* __restrict__ a_re, const float* __restrict__ a_im, const float* __restrict__ b_re, const float* __restrict__ b_im,
                                        const float* __restrict__ log_dt, float* __restrict__ Xbuf) {
    const int g = gw & 15;
    S5C c; s5_consts(c, g, lane, a_re, a_im, b_re, b_im, log_dt);
    for (int jr = gw >> 4; jr < NB * NSEG; jr += ngw >> 4) {
    const int b = jr / NSEG, seg = jr - b * NSEG, job = (b * 16 + g) * NSEG + seg;
    float xr = 0.f, xi = 0.f;
    const bf16* up = proj + ((size_t)b * SQ + (size_t)seg * SEG) * PW + P_SU + 16 * g;
#define S5_LOADB(U_, tb_) do { _Pragma("unroll") for (int i_ = 0; i_ < 4; ++i_) { const bf16* q_ = up + (size_t)((tb_) + i_) * PW; U_[i_][0] = *(const v4u*)q_; U_[i_][1] = *(const v4u*)(q_ + 8); } } while (0)
    v4u Ua[4][2], Ub[4][2];
    S5_LOADB(Ua, 0);
    for (int t0 = 0; t0 < SEG; t0 += 8) {
        S5_LOADB(Ub, t0 + 4);
#pragma unroll
        for (int i = 0; i < 4; ++i) s5_step(c, Ua[i][0], Ua[i][1], xr, xi);
        if (t0 + 8 < SEG) S5_LOADB(Ua, t0 + 8);
#pragma unroll
        for (int i = 0; i < 4; ++i) s5_step(c, Ub[i][0], Ub[i][1], xr, xi);
    }
    Xbuf[(size_t)job * 128 + lane] = xr; Xbuf[(size_t)job * 128 + 64 + lane] = xi;
    }
}
__device__ __forceinline__ void s5_scan(int bg, int lane, const float* __restrict__ a_re, const float* __restrict__ a_im, const float* __restrict__ log_dt, float* __restrict__ Xbuf) {
    const int g = bg & 15;
    const float dt = expf(log_dt[g]) * (float)SEG, are = a_re[g * 64 + lane], aim = a_im[g * 64 + lane];
    const float mag = expf(dt * are), pr = mag * cosf(dt * aim), pi = mag * sinf(dt * aim);
    float xr = 0.f, xi = 0.f;
    for (int s0 = 0; s0 < NSEG; s0 += 32) {
        float lr[32], li[32];
#pragma unroll
        for (int u = 0; u < 32; ++u) { const size_t job = (size_t)bg * NSEG + s0 + u; lr[u] = Xbuf[job * 128 + lane]; li[u] = Xbuf[job * 128 + 64 + lane]; }
#pragma unroll
        for (int u = 0; u < 32; ++u) { const size_t job = (size_t)bg * NSEG + s0 + u; Xbuf[job * 128 + lane] = xr; Xbuf[job * 128 + 64 + lane] = xi;
            const float nr = pr * xr - pi * xi + lr[u], ni = pr * xi + pi * xr + li[u]; xr = nr; xi = ni; }
    }
}
constexpr int S5_XROWB = 272;
struct S5O { bf16x8 cf[4]; float dco; };
__device__ __forceinline__ void s5_oconsts(S5O& o, int g, int lane, const float* __restrict__ c_re, const float* __restrict__ c_im, const float* __restrict__ dvec) {
    const int cc = lane & 15, g4 = lane >> 4;
#pragma unroll
    for (int ks = 0; ks < 4; ++ks) { v4u w;
        const int n0 = (32 * ks + 8 * g4) >> 1; const float* cr = c_re + (size_t)(g * 16 + cc) * 64 + n0; const float* ci = c_im + (size_t)(g * 16 + cc) * 64 + n0;
        w.x = pk2(cr[0], -ci[0]); w.y = pk2(cr[1], -ci[1]); w.z = pk2(cr[2], -ci[2]); w.w = pk2(cr[3], -ci[3]); o.cf[ks] = __builtin_bit_cast(bf16x8, w); }
    o.dco = dvec[g * 16 + cc];
}
__device__ __forceinline__ void s5_passC(int gw, int ngw, int lane, LAS unsigned char* xl, const bf16* __restrict__ proj, const float* __restrict__ a_re, const float* __restrict__ a_im, const float* __restrict__ b_re, const float* __restrict__ b_im,
                                        const float* __restrict__ c_re, const float* __restrict__ c_im, const float* __restrict__ dvec, const float* __restrict__ log_dt, const float* __restrict__ Xbuf, bf16* __restrict__ hg) {
    const int g = gw & 15, cc = lane & 15, g4 = lane >> 4;
    S5C c; s5_consts(c, g, lane, a_re, a_im, b_re, b_im, log_dt);
    S5O oc; s5_oconsts(oc, g, lane, c_re, c_im, dvec);
    for (int jr = gw >> 4; jr < NB * NSEG; jr += ngw >> 4) {
    const int b = jr / NSEG, seg = jr - b * NSEG, job = (b * 16 + g) * NSEG + seg;
    float xr = Xbuf[(size_t)job * 128 + lane], xi = Xbuf[(size_t)job * 128 + 64 + lane];
    const size_t r0 = (size_t)b * SQ + (size_t)seg * SEG;
    const bf16* up = proj + r0 * PW + P_SU + 16 * g;
    v4u Ua[4][2], Ub[4][2];
    S5_LOADB(Ua, 0);
    for (int t0 = 0; t0 < SEG; t0 += 16) {
        float uv[4];
#pragma unroll
        for (int q = 0; q < 4; ++q) uv[q] = bf2f(proj[(r0 + t0 + 4 * g4 + q) * PW + P_SU + 16 * g + cc]);
#pragma unroll
        for (int hb = 0; hb < 2; ++hb) {
            S5_LOADB(Ub, t0 + 8 * hb + 4);
#pragma unroll
            for (int i = 0; i < 4; ++i) { s5_step(c, Ua[i][0], Ua[i][1], xr, xi); *(LAS unsigned*)(xl + (8 * hb + i) * S5_XROWB + 4 * lane) = pk2(xr, xi); }
            if (t0 + 8 * hb + 8 < SEG) S5_LOADB(Ua, t0 + 8 * hb + 8);
#pragma unroll
            for (int i = 0; i < 4; ++i) { s5_step(c, Ub[i][0], Ub[i][1], xr, xi); *(LAS unsigned*)(xl + (8 * hb + 4 + i) * S5_XROWB + 4 * lane) = pk2(xr, xi); }
        }
        asm volatile("s_waitcnt lgkmcnt(0)" ::: "memory");
        f32x4 acc = {0.f, 0.f, 0.f, 0.f};
#pragma unroll
        for (int ks = 0; ks < 4; ++ks) { const bf16x8 xa = *(const LAS bf16x8*)(xl + cc * S5_XROWB + (32 * ks + 8 * g4) * 2);
            acc = __builtin_amdgcn_mfma_f32_16x16x32_bf16(xa, oc.cf[ks], acc, 0, 0, 0); }
        asm volatile("s_waitcnt lgkmcnt(0)" ::: "memory");
#pragma unroll
        for (int q = 0; q < 4; ++q) { const size_t r = r0 + t0 + 4 * g4 + q;
            hg[r * 256 + 16 * g + cc] = (bf16)f2bf(gelu_tanh(acc[q] + oc.dco * uv[q])); }
    }
    }
}

__device__ __forceinline__ void s5_table_item(int item, int p, const float* __restrict__ a_re, const float* __restrict__ a_im, const float* __restrict__ b_re, const float* __restrict__ b_im,
                                              const float* __restrict__ log_dt, f32x2* __restrict__ tab) {
    const int g = item >> 6;
    const float dt = expf(log_dt[g]), are = a_re[item], aim = a_im[item];
    const float lm = dt * are, th = dt * aim;
    f32x2* t = tab + (size_t)item * 48;
    {   const float mn = expf(-(float)p * lm), mp = expf((float)p * lm), cs = cosf((float)p * th), sn = sinf((float)p * th);
        t[p] = (f32x2){mn * cs, -mn * sn}; t[16 + p] = (f32x2){mp * cs, mp * sn}; }
    const float mag = expf(lm), abr = mag * cosf(th), abi = mag * sinf(th);
    const float den = are * are + aim * aim, f_re = ((abr - 1.0f) * are + abi * aim) / den, f_im = (abi * are - (abr - 1.0f) * aim) / den;
    {   const int k = p; const float br = b_re[(size_t)item * 16 + k], bi = b_im[(size_t)item * 16 + k]; t[32 + k] = (f32x2){f_re * br - f_im * bi, f_re * bi + f_im * br}; }
}
template <bool OUT>
__device__ __forceinline__ void s5_mfma_pass(int gw, int ngw, int lane, LAS unsigned char* xl, const bf16* __restrict__ proj, const f32x2* __restrict__ tabl  ,
                                             const float* __restrict__ c_re, const float* __restrict__ c_im, const float* __restrict__ dvec, float* __restrict__ Xbuf, bf16* __restrict__ hg) {
    const int g = gw & 15, i16 = lane & 15, g4 = lane >> 4;
    const f32x2* tg = tabl + (size_t)g * 64 * 48;
    LAS float* xs = (LAS float*)xl;
    LAS unsigned char* bml = xl + 512;
    f32x2 AM[4][4], AT[4][4], A1[4];
#pragma unroll
    for (int rb = 0; rb < 4; ++rb) { A1[rb] = tg[(size_t)(16 * rb + i16) * 48 + 16 + 1];
#pragma unroll
        for (int r = 0; r < 4; ++r) { AM[rb][r] = tg[(size_t)(16 * rb + i16) * 48 + (4 * g4 + r)]; AT[rb][r] = tg[(size_t)(16 * rb + 4 * g4 + r) * 48 + 16 + i16]; } }
#pragma unroll
    for (int rb8 = 0; rb8 < 8; ++rb8) { v4u w = {0u, 0u, 0u, 0u};
        if (g4 < 2) { const f32x2* bp = tg + (size_t)(16 * (rb8 & 3) + i16) * 48 + 32 + 8 * g4; const int im = rb8 >> 2;
            w.x = pk2(bp[0][im], bp[1][im]); w.y = pk2(bp[2][im], bp[3][im]); w.z = pk2(bp[4][im], bp[5][im]); w.w = pk2(bp[6][im], bp[7][im]); }
        *(LAS v4u*)(bml + (rb8 * 64 + lane) * 16) = w; }
    v4u lfw;
    {   const unsigned one = 0x3f80u; unsigned e[4];
#pragma unroll
        for (int jj = 0; jj < 4; ++jj) e[jj] = (4 * g4 + jj <= i16) ? one : 0u;
        lfw.x = e[0] | (e[1] << 16); lfw.y = e[2] | (e[3] << 16); lfw.z = (g4 == 0) ? one : 0u; lfw.w = 0u; }
    const bf16x8 Lf = __builtin_bit_cast(bf16x8, lfw);
    bf16x8 Cm[4]; f32x4 dco4 = {0.f, 0.f, 0.f, 0.f};
    if (OUT) {
#pragma unroll
        for (int ks = 0; ks < 4; ++ks) { float cv[8];
#pragma unroll
            for (int jj = 0; jj < 8; ++jj) { const int np = 16 * (2 * ks + (jj >> 2)) + 4 * g4 + (jj & 3);
                cv[jj] = (np < 64) ? c_re[(size_t)(g * 16 + i16) * 64 + np] : -c_im[(size_t)(g * 16 + i16) * 64 + (np - 64)]; }
            v4u w; w.x = pk2(cv[0], cv[1]); w.y = pk2(cv[2], cv[3]); w.z = pk2(cv[4], cv[5]); w.w = pk2(cv[6], cv[7]); Cm[ks] = __builtin_bit_cast(bf16x8, w); }
        dco4 = *(const f32x4*)(dvec + g * 16 + 4 * g4);
    }
    asm volatile("s_waitcnt lgkmcnt(0)" ::: "memory");
    for (int jr = gw >> 4; jr < NB * NSEG; jr += ngw >> 4) {
        const int b = jr / NSEG, seg = jr - b * NSEG, job = (b * 16 + g) * NSEG + seg;
        const size_t r0 = (size_t)b * SQ + (size_t)seg * SEG;
        float xinr[4], xini[4];
#pragma unroll
        for (int rb = 0; rb < 4; ++rb) { xinr[rb] = OUT ? Xbuf[(size_t)job * 128 + 16 * rb + i16] : 0.f; xini[rb] = OUT ? Xbuf[(size_t)job * 128 + 64 + 16 * rb + i16] : 0.f; }
        f32x4 xr[4], xi[4];
        v4u nuw; v2u nue = {0u, 0u};
        {   const bf16* pr0 = proj + (r0 + i16) * PW + P_SU + 16 * g; nuw = *(const v4u*)(pr0 + 8 * (g4 & 1)); if (OUT) nue = *(const v2u*)(pr0 + 4 * g4); }
#pragma unroll 1
        for (int ch = 0; ch < SEG / 16; ++ch) {
            const v4u uw = nuw; const v2u ue = nue;
            if (ch + 1 < SEG / 16) { const bf16* pr1 = proj + (r0 + 16 * (ch + 1) + i16) * PW + P_SU + 16 * g; nuw = *(const v4u*)(pr1 + 8 * (g4 & 1)); if (OUT) nue = *(const v2u*)(pr1 + 4 * g4); }
            const bf16x8 uf = __builtin_bit_cast(bf16x8, uw);
            f32x4 bu[8];
#pragma unroll
            for (int rb8 = 0; rb8 < 8; ++rb8) { const bf16x8 bm = *(const LAS bf16x8*)(bml + (rb8 * 64 + lane) * 16);
                bu[rb8] = (f32x4){0.f, 0.f, 0.f, 0.f}; bu[rb8] = __builtin_amdgcn_mfma_f32_16x16x32_bf16(uf, bm, bu[rb8], 0, 0, 0); }
            v4u fz[8];
#pragma unroll
            for (int rb = 0; rb < 4; ++rb) { float zr[4], zi[4];
#pragma unroll
                for (int r = 0; r < 4; ++r) { zr[r] = bu[rb][r] * AM[rb][r].x - bu[rb + 4][r] * AM[rb][r].y; zi[r] = bu[rb][r] * AM[rb][r].y + bu[rb + 4][r] * AM[rb][r].x; }
                const float wr = A1[rb].x * xinr[rb] - A1[rb].y * xini[rb], wi = A1[rb].x * xini[rb] + A1[rb].y * xinr[rb];
                fz[rb].x = pk2(zr[0], zr[1]); fz[rb].y = pk2(zr[2], zr[3]); fz[rb].z = pk2(wr, 0.f); fz[rb].w = 0u;
                fz[rb + 4].x = pk2(zi[0], zi[1]); fz[rb + 4].y = pk2(zi[2], zi[3]); fz[rb + 4].z = pk2(wi, 0.f); fz[rb + 4].w = 0u; }
            f32x4 P[8];
#pragma unroll
            for (int rb8 = 0; rb8 < 8; ++rb8) { P[rb8] = (f32x4){0.f, 0.f, 0.f, 0.f}; P[rb8] = __builtin_amdgcn_mfma_f32_16x16x32_bf16(__builtin_bit_cast(bf16x8, fz[rb8]), Lf, P[rb8], 0, 0, 0); }
#pragma unroll
            for (int rb = 0; rb < 4; ++rb)
#pragma unroll
                for (int r = 0; r < 4; ++r) { xr[rb][r] = P[rb][r] * AT[rb][r].x - P[rb + 4][r] * AT[rb][r].y; xi[rb][r] = P[rb][r] * AT[rb][r].y + P[rb + 4][r] * AT[rb][r].x; }
            f32x4 y = {0.f, 0.f, 0.f, 0.f};
            if (OUT) {
#pragma unroll
                for (int ks = 0; ks < 4; ++ks) { const f32x4 lo = (ks < 2) ? xr[2 * ks] : xi[2 * ks - 4], hi = (ks < 2) ? xr[2 * ks + 1] : xi[2 * ks - 3];
                    v4u w; w.x = pk2(lo[0], lo[1]); w.y = pk2(lo[2], lo[3]); w.z = pk2(hi[0], hi[1]); w.w = pk2(hi[2], hi[3]);
                    y = __builtin_amdgcn_mfma_f32_16x16x32_bf16(Cm[ks], __builtin_bit_cast(bf16x8, w), y, 0, 0, 0); }
            }
            if (i16 == 15) {
#pragma unroll
                for (int rb = 0; rb < 4; ++rb) { *(LAS f32x4*)(xs + 16 * rb + 4 * g4) = xr[rb]; *(LAS f32x4*)(xs + 64 + 16 * rb + 4 * g4) = xi[rb]; } }
            asm volatile("s_waitcnt lgkmcnt(0)" ::: "memory");
#pragma unroll
            for (int rb = 0; rb < 4; ++rb) { xinr[rb] = xs[16 * rb + i16]; xini[rb] = xs[64 + 16 * rb + i16]; }
            asm volatile("s_waitcnt lgkmcnt(0)" ::: "memory");
            if (OUT) {
                const float uv[4] = {bflo(ue.x), bfhi(ue.x), bflo(ue.y), bfhi(ue.y)};
                v2u o; o.x = pk2(gelu_tanh(y[0] + dco4[0] * uv[0]), gelu_tanh(y[1] + dco4[1] * uv[1])); o.y = pk2(gelu_tanh(y[2] + dco4[2] * uv[2]), gelu_tanh(y[3] + dco4[3] * uv[3]));
                *(v2u*)(hg + (r0 + 16 * ch + i16) * 256 + 16 * g + 4 * g4) = o;
            }
        }
        if (!OUT && i16 == 15) {
#pragma unroll
            for (int rb = 0; rb < 4; ++rb) { *(f32x4*)(Xbuf + (size_t)job * 128 + 16 * rb + 4 * g4) = xr[rb]; *(f32x4*)(Xbuf + (size_t)job * 128 + 64 + 16 * rb + 4 * g4) = xi[rb]; } }
    }
}

__device__ __forceinline__ void headnorm8(int row0, int lane, bf16* __restrict__ proj, const float* __restrict__ dil_g  , const float* __restrict__ nsa_g  ) {
    bf16* pr = proj + (size_t)(row0 + (lane >> 3)) * PW + 8 * (lane & 7);
#pragma unroll
    for (int i = 0; i < 14; ++i) {
        const int off = (i < 4) ? (P_DQ + 64 * i) : (i < 8) ? (P_DK + 64 * (i - 4)) : (i < 12) ? (P_NQ + 64 * (i - 8)) : (i == 12) ? P_KS : P_KW;
        const float* gp = ((i < 4) ? dil_g : (i < 8) ? (dil_g + 64) : (i < 12) ? nsa_g : (i == 12) ? (nsa_g + 128) : (nsa_g + 192)) + 8 * (lane & 7);
        const v4u w = *(const v4u*)(pr + off);
        float v[8] = {bflo(w.x), bfhi(w.x), bflo(w.y), bfhi(w.y), bflo(w.z), bfhi(w.z), bflo(w.w), bfhi(w.w)};
        float ss = 0.f;
#pragma unroll
        for (int k = 0; k < 8; ++k) ss += v[k] * v[k];
        ss += __shfl_xor(ss, 1); ss += __shfl_xor(ss, 2); ss += __shfl_xor(ss, 4);
        const float rs = rsqrtf(ss * (1.0f / 64.0f) + 1e-6f);
        const f32x4 g0 = *(const f32x4*)gp, g1 = *(const f32x4*)(gp + 4);
        v4u o; o.x = pk2(v[0] * rs * g0.x, v[1] * rs * g0.y); o.y = pk2(v[2] * rs * g0.z, v[3] * rs * g0.w); o.z = pk2(v[4] * rs * g1.x, v[5] * rs * g1.y); o.w = pk2(v[6] * rs * g1.z, v[7] * rs * g1.w);
        *(v4u*)(pr + off) = o;
    }
}
__device__ __forceinline__ f32x4 ld4bf(const bf16* p) { const v2u w = *(const v2u*)p; return (f32x4){bflo(w.x), bfhi(w.x), bflo(w.y), bfhi(w.y)}; }
__device__ __forceinline__ void mixfinal_row(int r, int lane, const bf16* __restrict__ proj, const bf16* __restrict__ mixraw, const bf16* __restrict__ os, const bf16* __restrict__ ow,
                                             const float* __restrict__ og  , bf16* __restrict__ mix) {
    const bf16* mr = mixraw + (size_t)r * 1024 + 4 * lane;
    f32x4 v[4];
    v[0] = ld4bf(mr); v[2] = ld4bf(mr + 512); v[3] = ld4bf(mr + 768);
    {   const f32x4 oc = ld4bf(mr + 256), s = ld4bf(os + (size_t)r * 256 + 4 * lane), w = ld4bf(ow + (size_t)r * 256 + 4 * lane);
        const bf16* gp = proj + (size_t)r * PW + P_NG + 3 * (lane >> 4);
        const float g0 = sigmoid_f(bf2f(gp[0])), g1 = sigmoid_f(bf2f(gp[1])), g2 = sigmoid_f(bf2f(gp[2]));
        v[1] = oc * g0 + s * g1 + w * g2; }
#pragma unroll
    for (int gi = 0; gi < 4; ++gi) {
        float ss = (v[gi].x * v[gi].x + v[gi].y * v[gi].y) + (v[gi].z * v[gi].z + v[gi].w * v[gi].w);
        ss = wave_sum(ss);
        const float rs = rsqrtf(ss * (1.0f / 256.0f) + 1e-6f);
        const f32x4 g = *(const f32x4*)(og + 256 * gi + 4 * lane);
        v2u o; o.x = pk2(v[gi].x * rs * g.x, v[gi].y * rs * g.y); o.y = pk2(v[gi].z * rs * g.z, v[gi].w * rs * g.w);
        *(v2u*)(mix + (size_t)r * 1024 + 256 * gi + 4 * lane) = o;
    }
}


__device__ __forceinline__ void moe_route(int vb, int wave, int lane, const float* __restrict__ x, const float* __restrict__ g, const float* __restrict__ rw, const float* __restrict__ rb,
                                          bf16* __restrict__ hn, unsigned* __restrict__ tokinfo, float* __restrict__ topw, int* __restrict__ wcnt) {
    int c[8];
#pragma unroll
    for (int e = 0; e < 8; ++e) c[e] = 0;
    const f32x4* gr = (const f32x4*)g + lane;
    f32x4 nv[4];
    {   const f32x4* xr0 = (const f32x4*)(x + (size_t)(128 * vb + 16 * wave) * DM) + lane;
#pragma unroll
        for (int j = 0; j < 4; ++j) nv[j] = xr0[64 * j]; }
#pragma unroll 1
    for (int i = 0; i < 16; ++i) {
        const int row = 128 * vb + 16 * wave + i;
        f32x4 v[4]; float s = 0.f;
#pragma unroll
        for (int j = 0; j < 4; ++j) v[j] = nv[j];
        {   const f32x4* xn = (const f32x4*)(x + (size_t)(row + (i < 15 ? 1 : 0)) * DM) + lane;
#pragma unroll
            for (int j = 0; j < 4; ++j) nv[j] = xn[64 * j]; }
#pragma unroll
        for (int j = 0; j < 4; ++j) s += (v[j].x * v[j].x + v[j].y * v[j].y) + (v[j].z * v[j].z + v[j].w * v[j].w);
        s = wave_sum(s);
        const float rstd = rsqrtf(s * (1.0f / DM) + 1e-6f);
        v2u* o8 = (v2u*)(hn + (size_t)row * DM) + lane;
#pragma unroll
        for (int j = 0; j < 4; ++j) { const f32x4 gv = gr[64 * j]; v[j] = v[j] * rstd * gv; v2u o; o.x = pk2(v[j].x, v[j].y); o.y = pk2(v[j].z, v[j].w); o8[64 * j] = o; }
        float lg[8];
#pragma unroll
        for (int e = 0; e < 8; ++e) lg[e] = 0.f;
#pragma unroll
        for (int j = 0; j < 4; ++j)
#pragma unroll
            for (int k = 0; k < 4; ++k) { const int col = 4 * lane + 256 * j + k; const f32x4 w0 = *(const f32x4*)(rw + (size_t)col * 8), w1 = *(const f32x4*)(rw + (size_t)col * 8 + 4); const float h = v[j][k];
                lg[0] += h * w0.x; lg[1] += h * w0.y; lg[2] += h * w0.z; lg[3] += h * w0.w; lg[4] += h * w1.x; lg[5] += h * w1.y; lg[6] += h * w1.z; lg[7] += h * w1.w; }
#pragma unroll
        for (int e = 0; e < 8; ++e) lg[e] = wave_sum(lg[e]) + rb[e];
        int i1 = 0; float v1 = lg[0];
#pragma unroll
        for (int e = 1; e < 8; ++e) if (lg[e] > v1) { v1 = lg[e]; i1 = e; }
        int i2 = -1; float v2 = -3.0e38f;
#pragma unroll
        for (int e = 0; e < 8; ++e) if (e != i1 && lg[e] > v2) { v2 = lg[e]; i2 = e; }
        i1 = __builtin_amdgcn_readfirstlane(i1); i2 = __builtin_amdgcn_readfirstlane(i2);
        const float e2 = __expf(v2 - v1), w1 = 1.0f / (1.0f + e2), w2 = e2 * w1;
        int r1 = 0, r2 = 0;
#pragma unroll
        for (int e = 0; e < 8; ++e) { if (e == i1) { r1 = c[e]; c[e] += 1; } if (e == i2) { r2 = c[e]; c[e] += 1; } }
        if (lane == 0) { tokinfo[row] = (unsigned)i1 | ((unsigned)i2 << 3) | ((unsigned)r1 << 6) | ((unsigned)r2 << 11); topw[(size_t)row * 2] = w1; topw[(size_t)row * 2 + 1] = w2; }
    }
    int cv = 0;
#pragma unroll
    for (int e = 0; e < 8; ++e) cv = (lane == e) ? c[e] : cv;
    if (lane < 8) wcnt[(vb * 8 + wave) * 8 + lane] = cv;
}
__device__ __forceinline__ void moe_assign(int vb, int tid, LAS int* sm, const int* __restrict__ wcnt, const unsigned* __restrict__ tokinfo, unsigned short* __restrict__ rowtok, int* __restrict__ tokpos, int* __restrict__ mtab) {
    const int wave = tid >> 6, lane = tid & 63;
    {   const int e = tid & 7, part = tid >> 3; int s = 0;
        for (int b = 4 * part; b < 4 * part + 4; ++b)
#pragma unroll
            for (int w = 0; w < 8; ++w) s += wcnt[(b * 8 + w) * 8 + e];
        sm[part * 8 + e] = s; }
    __syncthreads();
    if (tid < 8) { const int e = tid; int total = 0, base = 0;
        for (int p = 0; p < 64; ++p) { const int s = sm[p * 8 + e]; total += s; if (4 * p + 4 <= vb) base += s; }
        for (int b = (vb >> 2) << 2; b < vb; ++b)
#pragma unroll
            for (int w = 0; w < 8; ++w) base += wcnt[(b * 8 + w) * 8 + e];
        sm[512 + e] = total; sm[520 + e] = base; }
    __syncthreads();
    if (tid == 0) { int acc = 0; sm[528] = 0;
        for (int e = 0; e < 8; ++e) { acc += (sm[512 + e] + 255) >> 8; sm[529 + e] = acc; }
        if (vb == 0) { for (int e = 0; e < 9; ++e) mtab[e] = sm[528 + e]; } }
    __syncthreads();
    if (lane < 16) {
        const int row = 128 * vb + 16 * wave + lane; const unsigned info = tokinfo[row];
        const int e1 = info & 7, e2 = (info >> 3) & 7, r1 = (info >> 6) & 31, r2 = (info >> 11) & 31;
        int wb1 = 0, wb2 = 0;
        for (int w = 0; w < wave; ++w) { wb1 += wcnt[(vb * 8 + w) * 8 + e1]; wb2 += wcnt[(vb * 8 + w) * 8 + e2]; }
        const int p1 = 256 * sm[528 + e1] + sm[520 + e1] + wb1 + r1, p2 = 256 * sm[528 + e2] + sm[520 + e2] + wb2 + r2;
        rowtok[p1] = (unsigned short)row; rowtok[p2] = (unsigned short)row; tokpos[(size_t)row * 2] = p1; tokpos[(size_t)row * 2 + 1] = p2;
    }
    if (vb < 8) { const int e = vb; for (int p = 256 * sm[528 + e] + sm[512 + e] + tid; p < 256 * sm[529 + e]; p += 512) rowtok[p] = 0; }
    __syncthreads();
}
template <bool EARLY>
__device__ __forceinline__ void moe_combine(int row, int lane, float* __restrict__ out, const bf16* __restrict__ Y, const int* __restrict__ tokpos, const float* __restrict__ topw, int tail0) {
    const int p0 = tokpos[(size_t)row * 2], p1 = tokpos[(size_t)row * 2 + 1];
    if (((p0 < tail0) && (p1 < tail0)) != EARLY) return;
    const float w0 = topw[(size_t)row * 2], w1 = topw[(size_t)row * 2 + 1];
    f32x4* xr = (f32x4*)(out + (size_t)row * DM) + lane; const v2u* y0 = (const v2u*)(Y + (size_t)p0 * DM) + lane; const v2u* y1 = (const v2u*)(Y + (size_t)p1 * DM) + lane;
#pragma unroll
    for (int j = 0; j < 4; ++j) { f32x4 v = xr[64 * j]; const v2u a = y0[64 * j], b = y1[64 * j];
        v.x += w0 * bflo(a.x) + w1 * bflo(b.x); v.y += w0 * bfhi(a.x) + w1 * bfhi(b.x); v.z += w0 * bflo(a.y) + w1 * bflo(b.y); v.w += w0 * bfhi(a.y) + w1 * bfhi(b.y); xr[64 * j] = v; }
}
__device__ __forceinline__ void moe_combine_late16(int row0, int lane, float* __restrict__ out, const bf16* __restrict__ Y, const int* __restrict__ tokpos, const float* __restrict__ topw, int tail0) {
    bool late = false;
    if (lane < 16) { const int p0 = tokpos[(size_t)(row0 + lane) * 2], p1 = tokpos[(size_t)(row0 + lane) * 2 + 1]; late = !((p0 < tail0) && (p1 < tail0)); }
    unsigned long long m = __ballot(late);
    while (m) { const int i = __builtin_ctzll(m); m &= m - 1; moe_combine<false>(row0 + i, lane, out, Y, tokpos, topw, tail0); }
}

constexpr int NPH = 16;
struct Args { const float* in[32]; float* out; unsigned char* ws; int ph_lo, ph_hi; };
typedef const __attribute__((address_space(4))) Args* KArgs;
__device__ __forceinline__ KArgs get_args() { KArgs p = (KArgs)__builtin_amdgcn_kernarg_segment_ptr(); asm volatile("" : "+s"(p)); return p; }
#define LOCALS  int tid = wave0 * 64 + (int)__builtin_amdgcn_mbcnt_hi(~0u, __builtin_amdgcn_mbcnt_lo(~0u, 0u)); asm volatile("" : "+v"(tid)); const int lane = tid & 63, wave = __builtin_amdgcn_readfirstlane(tid >> 6), gw = blockIdx.x * NWAVES + wave, gx = (((G & 7) == 0) ? ((int)(blockIdx.x & 7) * (G >> 3) + (int)(blockIdx.x >> 3)) : (int)blockIdx.x) * NWAVES + wave  , ngw = G * NWAVES, half = tid >> 8, htid = tid & 255; \
    LAS float* scr = (LAS float*)(lds + RING_OFF + wave * 16384); LAS float* hsm = (LAS float*)(lds + RING_OFF + half * 32768); (void)lane; (void)gw; (void)gx; (void)ngw; (void)htid; (void)scr; (void)hsm; \
    KArgs A_ = get_args(); unsigned char* ws = A_->ws; float* out = A_->out; \
    bf16* HN = (bf16*)(ws + WS_HN); bf16* PROJ = (bf16*)(ws + WS_PROJ); \
    bf16* MIXRAW = (bf16*)(ws + WS_MIXRAW); bf16* OCMP = MIXRAW + 256; bf16* OS = (bf16*)(ws + WS_OS); bf16* OW = (bf16*)(ws + WS_OW); bf16* HG = (bf16*)(ws + WS_HG); float* GA = (float*)(ws + WS_GA); float* GLAS = (float*)(ws + WS_GLAS); float* GLAD = (float*)(ws + WS_GLAD); float* S5X = (float*)(ws + WS_S5X); \
    float* KC = (float*)(ws + WS_KC); float* VC = (float*)(ws + WS_VC); unsigned long long* SEL = (unsigned long long*)(ws + WS_SEL); float* CW = (float*)(ws + WS_CW); \
    (void)GA; (void)GLAS; (void)GLAD; (void)S5X; (void)out; (void)HN; (void)PROJ; (void)MIXRAW; (void)OCMP; (void)OS; (void)OW; (void)HG; (void)KC; (void)VC; (void)SEL; (void)CW;
#define IN(i) (A_->in[i])
__global__ void __launch_bounds__(NWAVES * 64, 2) mk_fwd(Args args) {
    extern __shared__ __attribute__((aligned(16))) unsigned char lds_raw[];
    LAS unsigned char* lds = (LAS unsigned char*)lds_raw;
    const int G = gridDim.x;
    const int wave0 = __builtin_amdgcn_readfirstlane(threadIdx.x >> 6);
    for (int u = threadIdx.x; u < (LDS_BYTES - LDSCTL_OFF) / 4; u += NWAVES * 64) ((LAS unsigned*)(lds + LDSCTL_OFF))[u] = 0u;
    __syncthreads();
    volatile LAS unsigned* MISC = (volatile LAS unsigned*)(lds + MISC_OFF);
    XcdBarrier bar = xcd_barrier_post((unsigned*)(args.ws + WS_CTL) + CW_BAR, MISC + 8);
    const int lo = args.ph_lo, hi = args.ph_hi;
#ifndef PROBE_DUP
#define PROBE_DUP -1
#endif
#ifndef PROBE_SUB
#define PROBE_SUB -1
#endif
#define SUBREP(id) _Pragma("unroll") for (int rep2_ = 0; rep2_ < (((id) == PROBE_SUB) ? 2 : 1); ++rep2_)
#define PH(k) const int pc##k = l * NPH + (k); _Pragma("unroll") for (int rep_ = 0; rep_ < (((k) == PROBE_DUP) ? 2 : 1); ++rep_) if (lo <= pc##k && pc##k < hi)
#define SEAM(k) do { if (pc##k + 1 < hi) xcd_barrier(bar); } while (0)

    {   const int l = -1;
        PH(15) { LOCALS
            for (int ll = 0; ll < 2; ++ll) {
                ConvJob j1{IN(2) + (size_t)ll * DM * PROJ_SRC, nullptr, (bf16*)(ws + WS_WIN) + (size_t)ll * PW * DM, PROJ_SRC, DM, PROJ_SRC, PW, DM, 1, 0, ll == 1 ? IN(1) + DM : nullptr};
                conv_run(j1, scr, gw, ngw, lane);
                ConvJob j2{IN(22) + (size_t)ll * DM * DM, nullptr, (bf16*)(ws + WS_WOUT) + (size_t)ll * DM * DM, DM, DM, DM, DM, DM, 0, 0};
                conv_fast(j2, gw, ngw, lane);
                for (int wh = 0; wh < 2; ++wh) { ConvJob j6{IN(6) + (size_t)(ll * 2 + wh) * 2048 * 256, nullptr, (bf16*)(ws + WS_W1CT) + (size_t)(ll * 2 + wh) * 256 * 2048, 256, 2048, 256, 256, 2048, 0, 0};
                    conv_fast(j6, gw, ngw, lane); }
                for (int wh = 0; wh < 2; ++wh) { ConvJob j7{IN(7) + (size_t)(ll * 2 + wh) * 256 * 64, nullptr, (bf16*)(ws + WS_W2T) + (size_t)(ll * 2 + wh) * 64 * 256, 64, 256, 64, 64, 256, 0, 0};
                    conv_run(j7, scr, gw, ngw, lane); }
                ConvJob j5{IN(19) + (size_t)ll * 65536, nullptr, (bf16*)(ws + WS_WGLU) + (size_t)ll * 65536, 256, 256, 256, 256, 256, 0, 0};
                conv_fast(j5, gw, ngw, lane);
            }
            {   const int o = blockIdx.x * 512 + tid;
                if (o < 1024) { const float* pp = IN(5) + (size_t)(o >> 8) * 2048; const float* wp = IN(6) + (size_t)(o >> 8) * 2048 * 256 + (o & 255); float a = 0.f;
                    _Pragma("unroll 64") for (int i = 0; i < 2048; ++i) a += pp[i] * wp[(size_t)i * 256];
                    ((float*)(ws + WS_BIASP))[o] = a; } }
            for (int it = blockIdx.x * 512 + tid; it < 2 * 1024 * 16; it += G * 512) { const int ll = it >> 14, gn = (it >> 4) & 1023;
                s5_table_item(gn, it & 15, IN(11) + ll * 1024, IN(12) + ll * 1024, IN(13) + ll * 16384, IN(14) + ll * 16384, IN(18) + ll * 16, (f32x2*)(ws + WS_S5TAB) + (size_t)ll * 1024 * 48); }
        }
    }
#pragma clang loop unroll(full)
    for (int l = 0; l < 2; ++l) {
        PH(0) { LOCALS
            if (l == 0) { for (int row = gw; row < NT; row += ngw) k_norm<false>(row, lane, IN(0), IN(1), HN, nullptr, nullptr, nullptr);
                SEAM(0); }
        }
        PH(1) { LOCALS
            pg8::StaticOrder S; S.init(NT, PW, G, (int)blockIdx.x);
            if (l == 0) { pg8::Gemm g{HN, (bf16*)(ws + WS_WIN), NT, PW, DM}; pg8::EpiStoreBf16 Ep{PROJ, PW};
                pg8::gemm_phase<pg8::EpiStoreBf16, pg8::StaticOrder, false, true>(lds + RING_OFF, g, S, Ep, nullptr, wave0); }
            else { pg8::Gemm g{(bf16*)(ws + WS_XB), (bf16*)(ws + WS_WIN) + (size_t)PW * DM, NT, PW, DM}; pg8::EpiStoreBf16N Ep{PROJ, PW, (const float*)(ws + WS_SSQ)};
                pg8::gemm_phase<pg8::EpiStoreBf16N, pg8::StaticOrder, false, true>(lds + RING_OFF, g, S, Ep, nullptr, wave0); }
            SEAM(1);
        }
        PH(2) { LOCALS
            if (blockIdx.x < 16) {
                LAS unsigned short* gidx = (LAS unsigned short*)(lds + GIDX_OFF);
                if (tid < 256) { int R = 256 * (blockIdx.x & 7) + tid; R = R < NB * NCMP ? R : NB * NCMP - 1; const int bb = R / NCMP, cc = R - bb * NCMP;
                    gidx[tid] = (unsigned short)((bb * SQ + 16 * cc) | ((blockIdx.x >> 3) << 15)); }
                __syncthreads();
                pg8::Gemm g{PROJ + P_KC, (bf16*)(ws + WS_W1CT) + (size_t)l * 512 * 2048, 4096, 512, 2048, PW, PW * 2, P_VC - P_KC};
                pg8::FirstNOrder S{16, (int)blockIdx.x, 8}; pg8::EpiGeluBias Ep{(bf16*)(ws + WS_CHID), 256, (const float*)(ws + WS_BIASP) + l * 512};
                pg8::gemm_phase<pg8::EpiGeluBias, pg8::FirstNOrder, true, true, true>(lds + RING_OFF, g, S, Ep, gidx, wave0);
            }
            if (G > 32) {
                if (blockIdx.x >= 16) { const int gw2 = gw - 16 * NWAVES, ngw2 = ngw - 16 * NWAVES;
                    if (wave & 4) s5_mfma_pass<false>(gw2, ngw2, lane, (LAS unsigned char*)scr, PROJ, (const f32x2*)(ws + WS_S5TAB) + (size_t)l * 1024 * 48, nullptr, nullptr, nullptr, S5X, nullptr);
                    for (int r8 = gw2; r8 < NT / 8; r8 += ngw2) headnorm8(8 * r8, lane, PROJ, IN(3) + l * 128, IN(4) + l * 256);
                    for (int row = gw2; row < NT; row += ngw2) gla_gate_row(row, lane, PROJ, IN(8) + l * 16 * 128, IN(9) + l * 128, GA);
                    if (!(wave & 4)) s5_mfma_pass<false>(gw2, ngw2, lane, (LAS unsigned char*)scr, PROJ, (const f32x2*)(ws + WS_S5TAB) + (size_t)l * 1024 * 48, nullptr, nullptr, nullptr, S5X, nullptr); }
            } else {
                for (int r8 = gw; r8 < NT / 8; r8 += ngw) headnorm8(8 * r8, lane, PROJ, IN(3) + l * 128, IN(4) + l * 256);
                for (int row = gw; row < NT; row += ngw) gla_gate_row(row, lane, PROJ, IN(8) + l * 16 * 128, IN(9) + l * 128, GA);
            }
            SEAM(2);
        }
        PH(3) { LOCALS
            if (wave & 4) { for (int job = gx; job < NB * 4 * NSEG; job += ngw) gla_seg<false>(job, lane, (LAS unsigned char*)scr, PROJ, GA, GLAS, GLAD, nullptr, nullptr); }
            SUBREP(35) for (int jw = gw; jw < 256; jw += ngw) cmp_second_job(jw, lane, (const bf16*)(ws + WS_CHID), (const bf16*)(ws + WS_W2T) + (size_t)l * 2 * 64 * 256, IN(4) + l * 256 + 64, (bf16*)(ws + WS_KCB), (bf16*)(ws + WS_VCB));
            SUBREP(31) for (int job = gx; job < NB * 4 * 128; job += ngw) dil_p1_job(job, lane, (LAS unsigned char*)scr, PROJ, (float*)(ws + WS_DO1), (float*)(ws + WS_DL1));
            SUBREP(32) for (int rnd = 0, job; rnd * ngw < NT / 8; ++rnd) if ((job = rnd * ngw + ((rnd & 1) ? (ngw - 1 - gx) : gx)) < NT / 8) nsa_win_job(job, lane, (LAS unsigned char*)scr, PROJ, OW);
            if (!(wave & 4)) { for (int job = gx; job < NB * 4 * NSEG; job += ngw) gla_seg<false>(job, lane, (LAS unsigned char*)scr, PROJ, GA, GLAS, GLAD, nullptr, nullptr); }
            if (G <= 32) { SUBREP(34) s5_mfma_pass<false>(gx, ngw, lane, (LAS unsigned char*)scr, PROJ, (const f32x2*)(ws + WS_S5TAB) + (size_t)l * 1024 * 48, nullptr, nullptr, nullptr, S5X, nullptr); }
            SEAM(3);
        }
        PH(4) { LOCALS
            { LOCALS
              if (G >= NB * 4 * 8) {
                  if (wave == 7 && (int)blockIdx.x < NB * 4 * 8) gla_scan((int)blockIdx.x, lane, GLAS, GLAD);
                  else if (wave == 6 && (int)blockIdx.x < NB * 16) s5_scan((int)blockIdx.x, lane, IN(11) + l * 1024, IN(12) + l * 1024, IN(18) + l * 16, S5X);
              } else {
                  if (gw < NB * 4 * 8) gla_scan(gw, lane, GLAS, GLAD);
                  else if (gw < NB * 4 * 8 + NB * 16) s5_scan(gw - NB * 4 * 8, lane, IN(11) + l * 1024, IN(12) + l * 1024, IN(18) + l * 16, S5X); } }
            { LOCALS
            if (wave & 4) { for (int job = gx; job < NB * 4 * 16 * 16; job += ngw) dil_job(job, lane, (LAS unsigned char*)scr, PROJ, MIXRAW, (const float*)(ws + WS_DO1), (const float*)(ws + WS_DL1)); }
            SUBREP(41) for (int rnd = 0, job; rnd * ngw < NT / 8; ++rnd) if ((job = rnd * ngw + ((rnd & 1) ? (ngw - 1 - gx) : gx)) < NT / 8) nsa_cmp_job(job, lane, (LAS unsigned char*)scr, PROJ, (const bf16*)(ws + WS_KCB), (const bf16*)(ws + WS_VCB), OCMP, 1024, SEL);
            if (!(wave & 4)) { for (int job = gx; job < NB * 4 * 16 * 16; job += ngw) dil_job(job, lane, (LAS unsigned char*)scr, PROJ, MIXRAW, (const float*)(ws + WS_DO1), (const float*)(ws + WS_DL1)); } }
            SEAM(4);
        }
        PH(5) { LOCALS
            if (wave & 4) { for (int job = gx; job < NB * 4 * NSEG; job += ngw) gla_seg<true>(job, lane, (LAS unsigned char*)scr, PROJ, GA, GLAS, GLAD, IN(10) + l * 64, MIXRAW);
                s5_mfma_pass<true>(gx, ngw, lane, (LAS unsigned char*)scr, PROJ, (const f32x2*)(ws + WS_S5TAB) + (size_t)l * 1024 * 48, IN(15) + l * 16384, IN(16) + l * 16384, IN(17) + l * 256, S5X, HG); }
            SUBREP(51) for (int rnd = 0, job; rnd * ngw < NT / 8; ++rnd) if ((job = rnd * ngw + ((rnd & 1) ? (ngw - 1 - gx) : gx)) < NT / 8) nsa_sel_job(job, lane, (LAS unsigned char*)scr, PROJ, SEL, OS);
            if (!(wave & 4)) { for (int job = gx; job < NB * 4 * NSEG; job += ngw) gla_seg<true>(job, lane, (LAS unsigned char*)scr, PROJ, GA, GLAS, GLAD, IN(10) + l * 64, MIXRAW);
                s5_mfma_pass<true>(gx, ngw, lane, (LAS unsigned char*)scr, PROJ, (const f32x2*)(ws + WS_S5TAB) + (size_t)l * 1024 * 48, IN(15) + l * 16384, IN(16) + l * 16384, IN(17) + l * 256, S5X, HG); }
            SEAM(5);
        }
        PH(6) { LOCALS
            pg8::Gemm g{HG, (bf16*)(ws + WS_WGLU) + (size_t)l * 65536, NT, 256, 256}; pg8::StaticOrder S; S.init(NT, 256, G, (int)blockIdx.x);
            pg8::EpiGlu Ep{HG, IN(20) + l * 256, MIXRAW + 768, 1024};
            pg8::gemm_phase<pg8::EpiGlu, pg8::StaticOrder, true, true>(lds + RING_OFF, g, S, Ep, nullptr, wave0);
            {   const int c0 = (G > 128) ? 128 : 0;
                if ((int)blockIdx.x >= c0) { const int gw2 = gw - c0 * NWAVES, ngw2 = ngw - c0 * NWAVES;
                    if (l == 0) {
                        ConvJob j3{IN(24), IN(25), (bf16*)(ws + WS_WFGU), DFF, DM, DFF, 2 * DFFP, DM, 2, 0, IN(23)};
                        conv_fast(j3, gw2, ngw2, lane);
                        ConvJob j4{IN(26), nullptr, (bf16*)(ws + WS_WFDN), DM, DFF, DM, DM, DFFP, 0, 0};
                        conv_fast(j4, gw2, ngw2, lane);
                    } else {
                        constexpr int NIT = (MOE_HH / 32) * (DM / 256);
                        for (int git = 4 * NIT + gw2; git < NEXP * NIT; git += ngw2) { const int e = git / NIT;
                            ConvJob j2{IN(31) + (size_t)e * DFE * DM, nullptr, (bf16*)(ws + WS_W2H) + (size_t)e * DM * MOE_HH, DM, MOE_HH, DM, DM, MOE_HH, 0, 0};
                            conv_fast_item(j2, git - e * NIT, lane); } } } }
            SEAM(6);
        }
        PH(7) { LOCALS
            for (int row = gw; row < NT; row += ngw) mixfinal_row(row, lane, PROJ, MIXRAW, OS, OW, IN(21) + l * 1024, HN);
            SEAM(7);
        }
        PH(8) { LOCALS
            pg8::Gemm g{HN, (bf16*)(ws + WS_WOUT) + (size_t)l * DM * DM, NT, DM, DM}; pg8::StaticOrder S; S.init(NT, DM, G, (int)blockIdx.x);
            if (l == 0) { pg8::EpiResF32N Ep{IN(0), out, (bf16*)(ws + WS_XB), (float*)(ws + WS_SSQ)};
                pg8::gemm_phase<pg8::EpiResF32N, pg8::StaticOrder, true, true>(lds + RING_OFF, g, S, Ep, nullptr, wave0); }
            else { pg8::EpiResF32 Ep{(const float*)out, out, DM};
                pg8::gemm_phase<pg8::EpiResF32, pg8::StaticOrder, true, true>(lds + RING_OFF, g, S, Ep, nullptr, wave0); }
            SEAM(8);
        }
#define MOE_VCU ((((G & 7) == 0) ? ((int)(blockIdx.x & 7) * (G >> 3) + (int)(blockIdx.x >> 3)) : (int)blockIdx.x))
#define MOE_CONV_W1(hf, c0) do { constexpr int NIT = (DM / 32) * (MOE_NPN * 256 / 256); if (MOE_VCU >= (c0)) for (int git = (MOE_VCU - (c0)) * NWAVES + wave; git < NEXP * NIT; git += ngw - (c0) * NWAVES) { const int e = git / NIT; \
                ConvJob j1{IN(29) + (size_t)e * DM * DFE, IN(30) + (size_t)e * DM * DFE, (bf16*)(ws + WS_W1H) + (size_t)e * MOE_NPN * 256 * DM, DFE, DM, DFE, MOE_NPN * 256, DM, 2, (hf) * MOE_HH}; \
                conv_fast_item(j1, git - e * NIT, lane); } } while (0)
#define MOE_CONV_W2(hf, c0, ne) do { constexpr int NIT = (MOE_HH / 32) * (DM / 256); if (MOE_VCU >= (c0)) for (int git = (MOE_VCU - (c0)) * NWAVES + wave; git < (ne) * NIT; git += ngw - (c0) * NWAVES) { const int e = git / NIT; \
                ConvJob j2{IN(31) + (size_t)e * DFE * DM + (size_t)(hf) * MOE_HH * DM, nullptr, (bf16*)(ws + WS_W2H) + (size_t)e * DM * MOE_HH, DM, MOE_HH, DM, DM, MOE_HH, 0, 0}; \
                conv_fast_item(j2, git - e * NIT, lane); } } while (0)
        PH(9) { LOCALS
            if (l == 1) { if (wave & 1) MOE_CONV_W1(0, 0);
                for (int vb = blockIdx.x; vb < 256; vb += G) moe_route(vb, wave, lane, out, IN(23) + l * DM, IN(27), IN(28), HN, (unsigned*)(ws + WS_TOKINFO), (float*)(ws + WS_TOPW), (int*)(ws + WS_WCNT));
                if (!(wave & 1)) MOE_CONV_W1(0, 0);
                SEAM(9); }
        }
        if (l == 0) {
            PH(10) { LOCALS
                {   pg8::Gemm g{(bf16*)(ws + WS_XB), (bf16*)(ws + WS_WFGU), NT, 2 * DFFP, DM}; pg8::StaticOrder S; S.init(NT, 2 * DFFP, G, (int)blockIdx.x);
                    pg8::EpiSwigluN Ep{(bf16*)(ws + WS_FH), DFFP, 1 << 20, (const float*)(ws + WS_SSQ)};
                    pg8::gemm_phase<pg8::EpiSwigluN, pg8::StaticOrder, true, true>(lds + RING_OFF, g, S, Ep, nullptr, wave0); }
                xcd_barrier(bar);
                {   pg8::Gemm g{(bf16*)(ws + WS_FH), (bf16*)(ws + WS_WFDN), NT, DM, DFFP}; pg8::StaticOrder S; S.init(NT, DM, G, (int)blockIdx.x);
                    pg8::EpiResF32N Ep{out, out, (bf16*)(ws + WS_XB), (float*)(ws + WS_SSQ)};
                    pg8::gemm_phase<pg8::EpiResF32N, pg8::StaticOrder, true, true>(lds + RING_OFF, g, S, Ep, nullptr, wave0); }
                SEAM(10);
            }
        } else {
#define MOE_ORDER(S, NPNL) pg8::MoeOrder S; { const int* mt = (const int*)(ws + WS_MTAB); _Pragma("unroll") for (int e = 0; e < 9; ++e) S.ts[e] = __builtin_amdgcn_readfirstlane(mt[e]); S.npn = (NPNL); S.nunits = S.ts[8] * (NPNL); S.G = G; S.c = ((G & 7) == 0) ? ((int)(blockIdx.x & 7) * (G >> 3) + (int)(blockIdx.x >> 3)) : (int)blockIdx.x; }
#define MOE_GU() do { MOE_ORDER(S, MOE_NPN); \
                LAS unsigned short* gidx = (LAS unsigned short*)(lds + GIDX_OFF); const unsigned short* rowtok = (const unsigned short*)(ws + WS_ROWTOK); \
                { pg8::Unit u; for (int i = 0; S.next(i, u); ++i) { if (tid < 256) gidx[i * 256 + tid] = rowtok[u.pm * 256 + tid]; } } \
                __syncthreads(); \
                pg8::Gemm g{HN, (bf16*)(ws + WS_W1H), NT, NEXP * MOE_NPN * 256, DM, DM, 128, 0}; pg8::EpiSwiglu Ep{(bf16*)(ws + WS_MHID), MOE_HH, MOE_NPN}; \
                pg8::gemm_phase<pg8::EpiSwiglu, pg8::MoeOrder, true, true, true>(lds + RING_OFF, g, S, Ep, gidx, wave0); } while (0)
            PH(10) { LOCALS
                for (int vb = blockIdx.x; vb < 256; vb += G) moe_assign(vb, tid, (LAS int*)(lds + RING_OFF + 65536), (const int*)(ws + WS_WCNT), (const unsigned*)(ws + WS_TOKINFO), (unsigned short*)(ws + WS_ROWTOK), (int*)(ws + WS_TOKPOS), (int*)(ws + WS_MTAB));
                SEAM(10);
            }
            PH(11) { LOCALS
                MOE_GU();
                { const int* mt = (const int*)(ws + WS_MTAB); const int rem = (__builtin_amdgcn_readfirstlane(mt[8]) * MOE_NPN) % G; const int c0 = (rem <= G / 2) ? rem : 0;
                  MOE_CONV_W2(0, c0, 4); }
                SEAM(11);
            }
            PH(12) { LOCALS
                {   MOE_ORDER(S, 4);
                    pg8::Gemm g{(bf16*)(ws + WS_MHID), (bf16*)(ws + WS_W2H), MOE_ROWS, NEXP * DM, MOE_HH}; pg8::EpiYBf16<false> Ep{(bf16*)(ws + WS_MY), DM, 4};
                    pg8::gemm_phase<pg8::EpiYBf16<false>, pg8::MoeOrder, true, true>(lds + RING_OFF, g, S, Ep, nullptr, wave0); }
                { const int* mt = (const int*)(ws + WS_MTAB); const int rem = (__builtin_amdgcn_readfirstlane(mt[8]) * 4) % G; const int c0 = (rem <= G / 2) ? rem : 0;
                  MOE_CONV_W1(1, c0); }
                SEAM(12);
            }
            PH(13) { LOCALS
                MOE_GU();
                { const int* mt = (const int*)(ws + WS_MTAB); const int rem = (__builtin_amdgcn_readfirstlane(mt[8]) * MOE_NPN) % G; const int c0 = (rem <= G / 2) ? rem : 0;
                  MOE_CONV_W2(1, c0, NEXP); }
                SEAM(13);
            }
            PH(14) {
                int tail0 = 0x7fffffff, rem = 0, vc = 0;
                {   LOCALS MOE_ORDER(S, 4);
                    const int nun = S.nunits, nfull0 = (nun / G) * G, rem0 = nun - nfull0; const bool split = (rem0 > 0) && (rem0 * 4 <= G) && ((nfull0 & 31) == 0);
                    if (split) { S.nunits = nfull0; rem = rem0; tail0 = (nfull0 >> 2) * 256; }
                    vc = S.c;
                    pg8::Gemm g{(bf16*)(ws + WS_MHID), (bf16*)(ws + WS_W2H), MOE_ROWS, NEXP * DM, MOE_HH}; pg8::EpiYBf16<true> Ep{(bf16*)(ws + WS_MY), DM, 4};
                    pg8::gemm_phase<pg8::EpiYBf16<true>, pg8::MoeOrder, true, true>(lds + RING_OFF, g, S, Ep, nullptr, wave0); }
                xcd_barrier(bar);
                if (vc < rem) { LOCALS MOE_ORDER(S, 4);
                    S.c = (S.nunits / G) * G + S.c; S.G = 1 << 24;
                    pg8::Gemm g{(bf16*)(ws + WS_MHID), (bf16*)(ws + WS_W2H), MOE_ROWS, NEXP * DM, MOE_HH}; pg8::EpiYBf16<true> Ep{(bf16*)(ws + WS_MY), DM, 4};
                    pg8::gemm_phase<pg8::EpiYBf16<true>, pg8::MoeOrder, true, true>(lds + RING_OFF, g, S, Ep, nullptr, wave0);
                } else { LOCALS
                    for (int row = (vc - rem) * NWAVES + wave; row < NT; row += (G - rem) * NWAVES) moe_combine<true>(row, lane, out, (const bf16*)(ws + WS_MY), (const int*)(ws + WS_TOKPOS), (const float*)(ws + WS_TOPW), tail0); }
                SEAM(14);
            }
            PH(15) { LOCALS
                const int* mt = (const int*)(ws + WS_MTAB); const int nun = __builtin_amdgcn_readfirstlane(mt[8]) * 4, nfull0 = (nun / G) * G, rem0 = nun - nfull0;
                const bool split = (rem0 > 0) && (rem0 * 4 <= G) && ((nfull0 & 31) == 0);
                if (split) { const int tail0 = (nfull0 >> 2) * 256;
                    for (int r16 = gw; r16 < NT / 16; r16 += ngw) moe_combine_late16(16 * r16, lane, out, (const bf16*)(ws + WS_MY), (const int*)(ws + WS_TOKPOS), (const float*)(ws + WS_TOPW), tail0); }
            }
#undef MOE_VCU
#undef MOE_CONV_W1
#undef MOE_CONV_W2
#undef MOE_ORDER
#undef MOE_GU
        }
    }
#undef PH
#undef SEAM
}

#ifndef MK_SPLIT
#define MK_SPLIT 0
#endif
extern "C" void kernel_launch(void* const* d_in, const int* in_sizes, int n_in, void* d_out, int out_size, void* d_ws, size_t ws_size, hipStream_t stream) {
    static int grid = 0;
    if (grid == 0) {
        if (n_in != 32 || in_sizes[0] != NT * DM || out_size != NT * DM || ws_size < WS_END) { fprintf(stderr, "kernel_launch: unexpected shapes (n_in %d, in0 %d, out %d, ws %zu)\n", n_in, n_in > 0 ? in_sizes[0] : -1, out_size, ws_size); grid = -1; return; }
        int dev = 0, cus = 0, per_cu = 0;
        if (hipGetDevice(&dev) != hipSuccess || hipDeviceGetAttribute(&cus, hipDeviceAttributeMultiprocessorCount, dev) != hipSuccess) { grid = -1; return; }
        if (hipFuncSetAttribute((const void*)mk_fwd, hipFuncAttributeMaxDynamicSharedMemorySize, LDS_BYTES) != hipSuccess) { fprintf(stderr, "kernel_launch: hipFuncSetAttribute failed\n"); grid = -1; return; }
        if (hipOccupancyMaxActiveBlocksPerMultiprocessor(&per_cu, (const void*)mk_fwd, NWAVES * 64, LDS_BYTES) != hipSuccess || per_cu < 1) { fprintf(stderr, "kernel_launch: occupancy query says %d blocks per CU\n", per_cu); }
        (void)hipGetLastError();
        grid = cus;
    }
    if (grid < 0) return;
    (void)hipMemsetAsync((unsigned char*)d_ws + WS_CTL, 0, CTL_ZERO_BYTES, stream);
    Args a{};
    for (int i = 0; i < 32; ++i) a.in[i] = (const float*)d_in[i];
    a.out = (float*)d_out; a.ws = (unsigned char*)d_ws;
#if MK_SPLIT
    for (int pc = -1; pc < 2 * NPH; ++pc) { const int k = (pc < 0) ? 15 : pc % NPH; if (pc >= 0 && pc < NPH && k > 10) continue; a.ph_lo = pc; a.ph_hi = pc + 1; hipLaunchKernelGGL(mk_fwd, dim3(grid), dim3(NWAVES * 64), LDS_BYTES, stream, a); }
#else
    a.ph_lo = -1; a.ph_hi = 2 * NPH;
    hipLaunchKernelGGL(mk_fwd, dim3(grid), dim3(NWAVES * 64), LDS_BYTES, stream, a);
#endif
}
```

```cpp
#include <hip/hip_runtime.h>
#include <cstdio>
#include <cstdint>
namespace pg8 {
#define PG8_LAS __attribute__((address_space(3)))
typedef unsigned short bf16_t;
typedef short bf16x8 __attribute__((ext_vector_type(8)));
typedef float f32x4 __attribute__((ext_vector_type(4)));
typedef unsigned u32x4 __attribute__((ext_vector_type(4)));
constexpr int BM = 256, BK = 64, HALF = 128, HTB = HALF * BK * 2  , STAGE_BYTES = 8 * HTB, NXCD = 8, WGM = 8;

__host__ __device__ __forceinline__ int lds_byte(int r, int c) { const int st = (r >> 4) * 2 + (c >> 5), rr = r & 15, cc = c & 31, ob = rr * 64 + cc * 2; return st * 1024 + (ob ^ (((ob >> 9) & 1) << 5)); }
__host__ __device__ __forceinline__ void stage_rc(int b, int& R, int& C) { const int st = b / 1024, sb = b % 1024, swz = sb ^ (((sb >> 9) & 1) << 5); R = (st >> 1) * 16 + swz / 64; C = (st & 1) * 32 + (swz % 64) / 2; }
__host__ __device__ __forceinline__ int perm32(int rho) { const int n = rho >> 4, i = rho & 15; return 8 * (i >> 2) + 4 * n + (i & 3); }

struct Unit { int pm, pn; };
struct Gemm { const bf16_t* A; const bf16_t* Bt; int M, N, K; int lda = 0, kstepA = 0, hiofs = 0; };

struct StaticOrder {
    int nM, nN, nwg, G, c;
    __host__ __device__ void init(int M, int N, int G_, int c_) { nM = M / BM; nN = N / BM; nwg = nM * nN; G = G_; c = c_; }
    __host__ __device__ bool next(int i, Unit& u) const {
        const long L = (long)i * G + c; if (L >= nwg) return false;
        int wgid = (int)L; { const int q = nwg / NXCD, r = nwg % NXCD, xcd = wgid % NXCD, off = wgid / NXCD; wgid = (xcd < r ? xcd * (q + 1) : r * (q + 1) + (xcd - r) * q) + off; }
        const int nig = WGM * nN, gid = wgid / nig, fm = gid * WGM, gsz = (nM - fm) < WGM ? (nM - fm) : WGM;
        u.pm = fm + ((wgid % nig) % gsz); u.pn = (wgid % nig) / gsz; return true;
    }
    __device__ __forceinline__ void a_ready(const Unit&) const {}
    __device__ __forceinline__ void done(const Unit&) const {}
};

typedef float f32x2c_t __attribute__((ext_vector_type(2))); typedef __bf16 bf16x2c_t __attribute__((ext_vector_type(2)));
__device__ __forceinline__ unsigned cvt_pk_bf16(float lo, float hi) { f32x2c_t v = {lo, hi}; bf16x2c_t b = __builtin_convertvector(v, bf16x2c_t); return __builtin_bit_cast(unsigned, b); }
typedef float f32x2 __attribute__((ext_vector_type(2)));
__device__ __forceinline__ f32x2 gelu_pk(f32x2 v) {
    const f32x2 av = __builtin_elementwise_abs(v), d = av * 0.2316418882f + 1.0f;
    f32x2 t; t.x = __builtin_amdgcn_rcpf(d.x); t.y = __builtin_amdgcn_rcpf(d.y);
    f32x2 q = t * 0.5307027145f + (-0.7265760135f); q = q * t + 0.7107068705f; q = q * t + (-0.142248368f); q = q * t + 0.127414796f; q = q * t;
    const f32x2 s = (v * v) * (-0.72134752044f);
    f32x2 e; e.x = __builtin_amdgcn_exp2f(s.x); e.y = __builtin_amdgcn_exp2f(s.y);
    const f32x2 m = v * (q * e), r = v - m;
    f32x2 o; o.x = v.x < 0.f ? m.x : r.x; o.y = v.y < 0.f ? m.y : r.y; return o;
}


__device__ __forceinline__ float silu_f(float x) { return x * __builtin_amdgcn_rcpf(1.0f + __expf(-x)); }
struct EpiStoreBf16 {
    static constexpr bool PERM = true, AFTER_DRAIN = false;
    bf16_t* O; int ldc;
    __device__ __forceinline__ void operator()(const f32x4 (&acc)[2][2][4][2], const Unit& u, int wr, int wc, int fr, int fq) const {
        const int row0 = u.pm * BM + wr * 64 + fr, col0 = u.pn * BM + wc * 32 + 8 * fq;
#pragma unroll
        for (int ai = 0; ai < 2; ++ai)
#pragma unroll
            for (int m = 0; m < 4; ++m) { bf16_t* rowp = O + (size_t)(row0 + ai * HALF + m * 16) * ldc + col0;
#pragma unroll
                for (int bj = 0; bj < 2; ++bj) { const f32x4 v0 = acc[ai][bj][m][0], v1 = acc[ai][bj][m][1];
                    u32x4 w; w.x = cvt_pk_bf16(v0[0], v0[1]); w.y = cvt_pk_bf16(v0[2], v0[3]); w.z = cvt_pk_bf16(v1[0], v1[1]); w.w = cvt_pk_bf16(v1[2], v1[3]);
                    *(u32x4*)(rowp + bj * HALF) = w; } }
    }
};
struct EpiResF32 {
    static constexpr bool PERM = true, AFTER_DRAIN = false;
    const float* R; float* O; int ldc;
    __device__ __forceinline__ void operator()(const f32x4 (&acc)[2][2][4][2], const Unit& u, int wr, int wc, int fr, int fq) const {
        const int row0 = u.pm * BM + wr * 64 + fr, col0 = u.pn * BM + wc * 32 + 8 * fq;
#pragma unroll
        for (int ai = 0; ai < 2; ++ai)
#pragma unroll
            for (int m = 0; m < 4; ++m) { const size_t ro = (size_t)(row0 + ai * HALF + m * 16) * ldc + col0;
#pragma unroll
                for (int bj = 0; bj < 2; ++bj) { const float* rp = R + ro + bj * HALF; float* op = O + ro + bj * HALF;
                    const f32x4 r0 = *(const f32x4*)rp, r1 = *(const f32x4*)(rp + 4);
                    *(f32x4*)op = r0 + acc[ai][bj][m][0]; *(f32x4*)(op + 4) = r1 + acc[ai][bj][m][1]; } }
    }
};
struct EpiResScaledF32 {
    static constexpr bool PERM = true, AFTER_DRAIN = false;
    float* O; int ldc; const float* cw; int cws, cwo;
    __device__ __forceinline__ void operator()(const f32x4 (&acc)[2][2][4][2], const Unit& u, int wr, int wc, int fr, int fq) const {
        const int row0 = u.pm * BM + wr * 64 + fr, col0 = u.pn * BM + wc * 32 + 8 * fq;
#pragma unroll
        for (int ai = 0; ai < 2; ++ai)
#pragma unroll
            for (int m = 0; m < 4; ++m) { const int row = row0 + ai * HALF + m * 16; const size_t ro = (size_t)row * ldc + col0; const float w = cw[(size_t)row * cws + cwo];
                if (w != 0.f) {
#pragma unroll
                for (int bj = 0; bj < 2; ++bj) { float* op = O + ro + bj * HALF;
                    const f32x4 r0 = *(const f32x4*)op, r1 = *(const f32x4*)(op + 4);
                    *(f32x4*)op = r0 + acc[ai][bj][m][0] * w; *(f32x4*)(op + 4) = r1 + acc[ai][bj][m][1] * w; } } }
    }
};
struct EpiSwiglu {
    static constexpr bool PERM = true, AFTER_DRAIN = false;
    bf16_t* H; int ldh; int npn;
    __device__ __forceinline__ void operator()(const f32x4 (&acc)[2][2][4][2], const Unit& u, int wr, int wc, int fr, int fq) const {
        const int row0 = u.pm * BM + wr * 64 + fr, col0 = (u.pn % npn) * HALF + wc * 32 + 8 * fq;
#pragma unroll
        for (int ai = 0; ai < 2; ++ai)
#pragma unroll
            for (int m = 0; m < 4; ++m) { bf16_t* rowp = H + (size_t)(row0 + ai * HALF + m * 16) * ldh + col0;
                const f32x4 g0 = acc[ai][0][m][0], g1 = acc[ai][0][m][1], u0 = acc[ai][1][m][0], u1 = acc[ai][1][m][1];
                u32x4 w; w.x = cvt_pk_bf16(silu_f(g0[0]) * u0[0], silu_f(g0[1]) * u0[1]); w.y = cvt_pk_bf16(silu_f(g0[2]) * u0[2], silu_f(g0[3]) * u0[3]);
                w.z = cvt_pk_bf16(silu_f(g1[0]) * u1[0], silu_f(g1[1]) * u1[1]); w.w = cvt_pk_bf16(silu_f(g1[2]) * u1[2], silu_f(g1[3]) * u1[3]);
                *(u32x4*)rowp = w; }
    }
};
struct EpiGlu {
    static constexpr bool PERM = true, AFTER_DRAIN = false;
    const bf16_t* HG; const float* gb; bf16_t* O; int ldo;
    __device__ __forceinline__ void operator()(const f32x4 (&acc)[2][2][4][2], const Unit& u, int wr, int wc, int fr, int fq) const {
        const int row0 = u.pm * BM + wr * 64 + fr, col0 = u.pn * BM + wc * 32 + 8 * fq;
#pragma unroll
        for (int ai = 0; ai < 2; ++ai)
#pragma unroll
            for (int m = 0; m < 4; ++m) { const int row = row0 + ai * HALF + m * 16;
#pragma unroll
                for (int bj = 0; bj < 2; ++bj) { const int col = col0 + bj * HALF;
                    const u32x4 hw = *(const u32x4*)(HG + (size_t)row * 256 + col);
                    const f32x4 b0 = *(const f32x4*)(gb + col), b1 = *(const f32x4*)(gb + col + 4);
                    const f32x4 z0 = acc[ai][bj][m][0] + b0, z1 = acc[ai][bj][m][1] + b1;
                    f32x4 o0, o1;
                    o0[0] = __builtin_bit_cast(float, hw.x << 16) * __builtin_amdgcn_rcpf(1.0f + __expf(-z0[0])); o0[1] = __builtin_bit_cast(float, hw.x & 0xffff0000u) * __builtin_amdgcn_rcpf(1.0f + __expf(-z0[1]));
                    o0[2] = __builtin_bit_cast(float, hw.y << 16) * __builtin_amdgcn_rcpf(1.0f + __expf(-z0[2])); o0[3] = __builtin_bit_cast(float, hw.y & 0xffff0000u) * __builtin_amdgcn_rcpf(1.0f + __expf(-z0[3]));
                    o1[0] = __builtin_bit_cast(float, hw.z << 16) * __builtin_amdgcn_rcpf(1.0f + __expf(-z1[0])); o1[1] = __builtin_bit_cast(float, hw.z & 0xffff0000u) * __builtin_amdgcn_rcpf(1.0f + __expf(-z1[1]));
                    o1[2] = __builtin_bit_cast(float, hw.w << 16) * __builtin_amdgcn_rcpf(1.0f + __expf(-z1[2])); o1[3] = __builtin_bit_cast(float, hw.w & 0xffff0000u) * __builtin_amdgcn_rcpf(1.0f + __expf(-z1[3]));
                    u32x4 w; w.x = cvt_pk_bf16(o0[0], o0[1]); w.y = cvt_pk_bf16(o0[2], o0[3]); w.z = cvt_pk_bf16(o1[0], o1[1]); w.w = cvt_pk_bf16(o1[2], o1[3]);
                    *(u32x4*)(O + (size_t)row * ldo + col) = w; } }
    }
};
template <bool ACC> struct EpiYBf16 {
    static constexpr bool PERM = true, AFTER_DRAIN = false;
    bf16_t* Y; int ldc; int npn;
    __device__ __forceinline__ void operator()(const f32x4 (&acc)[2][2][4][2], const Unit& u, int wr, int wc, int fr, int fq) const {
        const int row0 = u.pm * BM + wr * 64 + fr, col0 = (u.pn % npn) * BM + wc * 32 + 8 * fq;
#pragma unroll
        for (int ai = 0; ai < 2; ++ai)
#pragma unroll
            for (int m = 0; m < 4; ++m) { bf16_t* rowp = Y + (size_t)(row0 + ai * HALF + m * 16) * ldc + col0;
#pragma unroll
                for (int bj = 0; bj < 2; ++bj) { f32x4 v0 = acc[ai][bj][m][0], v1 = acc[ai][bj][m][1];
                    if (ACC) { const u32x4 o = *(const u32x4*)(rowp + bj * HALF);
                        v0[0] += __builtin_bit_cast(float, o.x << 16); v0[1] += __builtin_bit_cast(float, o.x & 0xffff0000u); v0[2] += __builtin_bit_cast(float, o.y << 16); v0[3] += __builtin_bit_cast(float, o.y & 0xffff0000u);
                        v1[0] += __builtin_bit_cast(float, o.z << 16); v1[1] += __builtin_bit_cast(float, o.z & 0xffff0000u); v1[2] += __builtin_bit_cast(float, o.w << 16); v1[3] += __builtin_bit_cast(float, o.w & 0xffff0000u); }
                    u32x4 w; w.x = cvt_pk_bf16(v0[0], v0[1]); w.y = cvt_pk_bf16(v0[2], v0[3]); w.z = cvt_pk_bf16(v1[0], v1[1]); w.w = cvt_pk_bf16(v1[2], v1[3]);
                    *(u32x4*)(rowp + bj * HALF) = w; } }
    }
};
struct MoeOrder {
    int nunits, npn, G, c; int ts[9];
    __device__ __forceinline__ bool next(int i, Unit& u) const {
        const int L = i * G + c; if (L >= nunits) return false;
        const int nig = 8 * npn, gid = L / nig, w = L - gid * nig, fm = gid * 8, nt = ts[8], gsz = (nt - fm) < 8 ? (nt - fm) : 8;
        const int pnl = w / gsz, tile = fm + (w - pnl * gsz); int e = 0;
#pragma unroll
        for (int k = 1; k < 8; ++k) e += (tile >= ts[k]) ? 1 : 0;
        u.pm = tile; u.pn = e * npn + pnl; return true;
    }
    __device__ __forceinline__ void a_ready(const Unit&) const {}
    __device__ __forceinline__ void done(const Unit&) const {}
};
struct EpiGeluBias {
    static constexpr bool PERM = true, AFTER_DRAIN = false;
    bf16_t* O; int ldc; const float* bias;
    __device__ __forceinline__ static float gelu_t(float x) { const float u = 0.7978845608028654f * (x + 0.044715f * x * x * x); const float e = __expf(2.0f * u); return x * (1.0f - __builtin_amdgcn_rcpf(e + 1.0f)); }
    __device__ __forceinline__ void operator()(const f32x4 (&acc)[2][2][4][2], const Unit& u, int wr, int wc, int fr, int fq) const {
        const int row0 = u.pm * BM + wr * 64 + fr, col0 = wc * 32 + 8 * fq;
#pragma unroll
        for (int ai = 0; ai < 2; ++ai)
#pragma unroll
            for (int m = 0; m < 4; ++m) { bf16_t* rowp = O + (size_t)(row0 + ai * HALF + m * 16) * ldc + col0;
#pragma unroll
                for (int bj = 0; bj < 2; ++bj) { const float* bp = bias + u.pn * BM + col0 + bj * HALF; const f32x4 b0 = *(const f32x4*)bp, b1 = *(const f32x4*)(bp + 4);
                    const f32x4 v0 = acc[ai][bj][m][0] + b0, v1 = acc[ai][bj][m][1] + b1;
                    u32x4 w; w.x = cvt_pk_bf16(gelu_t(v0[0]), gelu_t(v0[1])); w.y = cvt_pk_bf16(gelu_t(v0[2]), gelu_t(v0[3])); w.z = cvt_pk_bf16(gelu_t(v1[0]), gelu_t(v1[1])); w.w = cvt_pk_bf16(gelu_t(v1[2]), gelu_t(v1[3]));
                    *(u32x4*)(rowp + bj * HALF) = w; } }
    }
};
struct FirstNOrder {
    int n, c, pdiv;
    __device__ __forceinline__ bool next(int i, Unit& u) const { if (i != 0 || c >= n) return false; u.pm = c; u.pn = c / pdiv; return true; }
    __device__ __forceinline__ void a_ready(const Unit&) const {}
    __device__ __forceinline__ void done(const Unit&) const {}
};
struct EpiResF32N {
    static constexpr bool PERM = true, AFTER_DRAIN = false;
    const float* R; float* O; bf16_t* XB; float* SSQ;
    __device__ __forceinline__ void operator()(const f32x4 (&acc)[2][2][4][2], const Unit& u, int wr, int wc, int fr, int fq) const {
        const int row0 = u.pm * BM + wr * 64 + fr, col0 = u.pn * BM + wc * 32 + 8 * fq;
#pragma unroll
        for (int ai = 0; ai < 2; ++ai)
#pragma unroll
            for (int m = 0; m < 4; ++m) { const int row = row0 + ai * HALF + m * 16; const size_t ro = (size_t)row * 1024 + col0; float ss = 0.f;
#pragma unroll
                for (int bj = 0; bj < 2; ++bj) { const float* rp = R + ro + bj * HALF; float* op = O + ro + bj * HALF;
                    const f32x4 v0 = *(const f32x4*)rp + acc[ai][bj][m][0], v1 = *(const f32x4*)(rp + 4) + acc[ai][bj][m][1];
                    *(f32x4*)op = v0; *(f32x4*)(op + 4) = v1;
                    ss += (v0[0] * v0[0] + v0[1] * v0[1]) + (v0[2] * v0[2] + v0[3] * v0[3]) + (v1[0] * v1[0] + v1[1] * v1[1]) + (v1[2] * v1[2] + v1[3] * v1[3]);
                    u32x4 w; w.x = cvt_pk_bf16(v0[0], v0[1]); w.y = cvt_pk_bf16(v0[2], v0[3]); w.z = cvt_pk_bf16(v1[0], v1[1]); w.w = cvt_pk_bf16(v1[2], v1[3]);
                    *(u32x4*)(XB + ro + bj * HALF) = w; }
                ss += __shfl_xor(ss, 16); ss += __shfl_xor(ss, 32);
                if (fq == 0) SSQ[(size_t)row * 16 + 4 * u.pn + wc] = ss; }
    }
};
__device__ __forceinline__ float row_rstd16(const float* SSQ, int row) {
    const f32x4* p = (const f32x4*)(SSQ + (size_t)row * 16); const f32x4 a = p[0], b = p[1], c = p[2], d = p[3];
    const float s = ((a[0] + a[1]) + (a[2] + a[3])) + ((b[0] + b[1]) + (b[2] + b[3])) + ((c[0] + c[1]) + (c[2] + c[3])) + ((d[0] + d[1]) + (d[2] + d[3]));
    return __builtin_amdgcn_rsqf(s * (1.0f / 1024.0f) + 1e-6f);
}
struct EpiStoreBf16N {
    static constexpr bool PERM = true, AFTER_DRAIN = false;
    bf16_t* O; int ldc; const float* SSQ;
    __device__ __forceinline__ void operator()(const f32x4 (&acc)[2][2][4][2], const Unit& u, int wr, int wc, int fr, int fq) const {
        const int row0 = u.pm * BM + wr * 64 + fr, col0 = u.pn * BM + wc * 32 + 8 * fq;
#pragma unroll
        for (int ai = 0; ai < 2; ++ai)
#pragma unroll
            for (int m = 0; m < 4; ++m) { const int row = row0 + ai * HALF + m * 16; const float rs = row_rstd16(SSQ, row); bf16_t* rowp = O + (size_t)row * ldc + col0;
#pragma unroll
                for (int bj = 0; bj < 2; ++bj) { const f32x4 v0 = acc[ai][bj][m][0] * rs, v1 = acc[ai][bj][m][1] * rs;
                    u32x4 w; w.x = cvt_pk_bf16(v0[0], v0[1]); w.y = cvt_pk_bf16(v0[2], v0[3]); w.z = cvt_pk_bf16(v1[0], v1[1]); w.w = cvt_pk_bf16(v1[2], v1[3]);
                    *(u32x4*)(rowp + bj * HALF) = w; } }
    }
};
struct EpiSwigluN {
    static constexpr bool PERM = true, AFTER_DRAIN = false;
    bf16_t* H; int ldh; int npn; const float* SSQ;
    __device__ __forceinline__ void operator()(const f32x4 (&acc)[2][2][4][2], const Unit& u, int wr, int wc, int fr, int fq) const {
        const int row0 = u.pm * BM + wr * 64 + fr, col0 = (u.pn % npn) * HALF + wc * 32 + 8 * fq;
#pragma unroll
        for (int ai = 0; ai < 2; ++ai)
#pragma unroll
            for (int m = 0; m < 4; ++m) { const int row = row0 + ai * HALF + m * 16; const float rs = row_rstd16(SSQ, row); bf16_t* rowp = H + (size_t)row * ldh + col0;
                const f32x4 g0 = acc[ai][0][m][0] * rs, g1 = acc[ai][0][m][1] * rs, u0 = acc[ai][1][m][0] * rs, u1 = acc[ai][1][m][1] * rs;
                u32x4 w; w.x = cvt_pk_bf16(silu_f(g0[0]) * u0[0], silu_f(g0[1]) * u0[1]); w.y = cvt_pk_bf16(silu_f(g0[2]) * u0[2], silu_f(g0[3]) * u0[3]);
                w.z = cvt_pk_bf16(silu_f(g1[0]) * u1[0], silu_f(g1[1]) * u1[1]); w.w = cvt_pk_bf16(silu_f(g1[2]) * u1[2], silu_f(g1[3]) * u1[3]);
                *(u32x4*)rowp = w; }
    }
};
template <class Epi, class Sched, bool ALIGN_EPI = false, bool SP2 = false, bool GATHER = false>
__device__ __forceinline__ void gemm_phase(PG8_LAS unsigned char* lds, const Gemm g, const Sched& S, const Epi& E, const PG8_LAS unsigned short* gidx = nullptr, int wave0 = -1) {
    int tid_ = (wave0 >= 0) ? (wave0 * 64 + (int)__builtin_amdgcn_mbcnt_hi(~0u, __builtin_amdgcn_mbcnt_lo(~0u, 0u))) : (int)threadIdx.x; asm volatile("" : "+v"(tid_));
    const int tid = tid_, wid = __builtin_amdgcn_readfirstlane(tid >> 6), lane = tid & 63, wr = wid >> 2, wc = wid & 3, fr = lane & 15, fq = lane >> 4;
    const int K = g.K, nt = K / BK;
    unsigned voffA[2], voffB[2]; int RA[2], CA[2]; unsigned voffG[2][2], voffN[2][2];
#pragma unroll
    for (int i = 0; i < 2; ++i) { int R, C; stage_rc(tid * 16 + i * 8192, R, C); const int Rb = Epi::PERM ? ((R & ~31) + perm32(R & 31)) : R; RA[i] = R; CA[i] = C;
        voffA[i] = (unsigned)(R * K + C) * 2u; voffB[i] = (unsigned)(Rb * K + C) * 2u; }
#define PG8_GIDX(dst, ui_) do { _Pragma("unroll") for (int _h = 0; _h < 2; ++_h) _Pragma("unroll") for (int _i = 0; _i < 2; ++_i) \
        { const unsigned _t = gidx[(ui_) * 256 + _h * 128 + RA[_i]]; dst[_h][_i] = ((_t & 0x7fffu) * (unsigned)g.lda + (_t >> 15) * (unsigned)g.hiofs + (unsigned)CA[_i]) * 2u; } } while (0)
    if constexpr (GATHER) { PG8_GIDX(voffG, 0); PG8_GIDX(voffN, 0); }
    (void)RA; (void)CA; (void)voffG; (void)voffN; (void)voffA;
    const size_t kstep = (size_t)(BK * 2);
    const size_t kstepA = GATHER ? (size_t)g.kstepA : kstep;
    const size_t hstep = (size_t)HALF * K * 2;
    const size_t tstep = 2 * hstep;
    const unsigned ldsw = (unsigned)wid * 1024u;
    const int aoff = lds_byte(wr * 64 + fr, fq * 8), boff = lds_byte(wc * 32 + fr, fq * 8);
#define PG8_SA(b, h) (((b) * 2 + (h)) * HTB)
#define PG8_SB(b, h) ((4 + (b) * 2 + (h)) * HTB)
#define PG8_STAGE(bufoff, gbase, voff) do { _Pragma("unroll") for (int _i = 0; _i < 2; ++_i) \
        __builtin_amdgcn_global_load_lds((const unsigned*)((const char*)(gbase) + (voff)[_i]), (PG8_LAS unsigned*)(lds + (bufoff) + ldsw + _i * 8192), 16, 0, 0); } while (0)
#define PG8_STAGE_A(bufoff, aptr, hh, nx) do { if constexpr (GATHER) { _Pragma("unroll") for (int _i = 0; _i < 2; ++_i) { const unsigned _vo = (nx) ? voffN[hh][_i] : voffG[hh][_i]; \
        __builtin_amdgcn_global_load_lds((const unsigned*)((const char*)(aptr) + _vo), (PG8_LAS unsigned*)(lds + (bufoff) + ldsw + _i * 8192), 16, 0, 0); } } \
        else { PG8_STAGE(bufoff, (aptr) + ((hh) ? hstep : 0), voffA); } } while (0)
#define PG8_LDA(dst, b, h) do { _Pragma("unroll") for (int m = 0; m < 4; ++m) _Pragma("unroll") for (int k = 0; k < 2; ++k) dst[m][k] = *(const PG8_LAS bf16x8*)(lds + PG8_SA(b, h) + aoff + m * 2048 + k * 1024); } while (0)
#define PG8_LDB(dst, b, h) do { _Pragma("unroll") for (int n = 0; n < 2; ++n) _Pragma("unroll") for (int k = 0; k < 2; ++k) dst[n][k] = *(const PG8_LAS bf16x8*)(lds + PG8_SB(b, h) + boff + n * 2048 + k * 1024); } while (0)
#define PG8_MMA(ai, bj, At, Bt) do { __builtin_amdgcn_s_setprio(1); _Pragma("unroll") for (int m = 0; m < 4; ++m) _Pragma("unroll") for (int n = 0; n < 2; ++n) _Pragma("unroll") for (int k = 0; k < 2; ++k) \
        acc[ai][bj][m][n] = __builtin_amdgcn_mfma_f32_16x16x32_bf16(Bt[n][k], At[m][k], acc[ai][bj][m][n], 0, 0, 0); __builtin_amdgcn_s_setprio(0); } while (0)
#define PG8_WAIT_V(n) asm volatile("s_waitcnt vmcnt(" #n ")" ::: "memory")
#define PG8_WAIT_L(n) asm volatile("s_waitcnt lgkmcnt(" #n ")" ::: "memory")
#define PG8_BAR __builtin_amdgcn_s_barrier()
#define PG8_SCHED __builtin_amdgcn_sched_barrier(0)
    Unit cur, nxt; int ui = 0;
    if (!S.next(0, cur)) return;
    f32x4 acc[2][2][4][2];
#pragma unroll
    for (int a = 0; a < 2; ++a)
#pragma unroll
        for (int b = 0; b < 2; ++b)
#pragma unroll
            for (int m = 0; m < 4; ++m)
#pragma unroll
                for (int n = 0; n < 2; ++n) acc[a][b][m][n] = (f32x4){0.f, 0.f, 0.f, 0.f};
    bf16x8 At[4][2], B0[2][2], B1[2][2];
    const char* cA = (const char*)g.A + (GATHER ? (size_t)0 : (size_t)cur.pm * tstep); const char* cB = (const char*)g.Bt + (size_t)cur.pn * tstep;
    S.a_ready(cur);
    if constexpr (SP2) {
        PG8_STAGE(PG8_SB(0, 0), cB, voffB); PG8_STAGE(PG8_SB(0, 1), cB + hstep, voffB); PG8_STAGE_A(PG8_SA(0, 0), cA, 0, false); PG8_STAGE_A(PG8_SA(0, 1), cA, 1, false);
        if (wr == 1) PG8_BAR;
        PG8_WAIT_V(2); PG8_BAR;
        PG8_STAGE(PG8_SB(1, 0), cB + kstep, voffB); PG8_STAGE_A(PG8_SA(1, 0), cA + kstepA, 0, false); PG8_STAGE(PG8_SB(1, 1), cB + hstep + kstep, voffB);
        PG8_WAIT_V(6); PG8_BAR;
    } else {
        PG8_STAGE(PG8_SB(0, 0), cB, voffB); PG8_STAGE(PG8_SA(0, 0), cA, voffA); PG8_STAGE(PG8_SB(0, 1), cB + hstep, voffB); PG8_STAGE(PG8_SA(0, 1), cA + hstep, voffA);
        if (wr == 1) PG8_BAR;
        PG8_WAIT_V(4); PG8_BAR;
        PG8_STAGE(PG8_SB(1, 0), cB + kstep, voffB); PG8_STAGE(PG8_SA(1, 0), cA + kstep, voffA); PG8_STAGE(PG8_SB(1, 1), cB + hstep + kstep, voffB);
        PG8_WAIT_V(6); PG8_BAR;
    }
    for (;;) {
        const bool has_next = S.next(ui + 1, nxt);
        const char* nA = (has_next && !GATHER) ? (const char*)g.A + (size_t)nxt.pm * tstep : cA; const char* nB = has_next ? (const char*)g.Bt + (size_t)nxt.pn * tstep : cB;
        if constexpr (GATHER) { if (has_next) PG8_GIDX(voffN, ui + 1); }
        for (int t = 0; t < nt; t += 2) {
            const bool last = (t == nt - 2);
            const char* a1 = cA + (size_t)(t + 1) * kstepA;
            const char* a2 = last ? nA : cA + (size_t)(t + 2) * kstepA; const char* b2 = last ? nB : cB + (size_t)(t + 2) * kstep;
            const char* a3 = a2 + kstepA; const char* b3 = b2 + kstep;
            if (last && has_next) S.a_ready(nxt);
            if constexpr (SP2) {
            const bool nx = last && has_next;
            PG8_LDB(B0, 0, 0); PG8_LDB(B1, 0, 1); PG8_SCHED; PG8_LDA(At, 0, 0); PG8_STAGE_A(PG8_SA(1, 1), a1, 1, false);
            PG8_WAIT_V(8); PG8_WAIT_L(0); PG8_BAR; PG8_MMA(0, 0, At, B0); PG8_MMA(0, 1, At, B1); PG8_BAR; PG8_SCHED;
            PG8_LDA(At, 0, 1); PG8_STAGE(PG8_SB(0, 0), b2, voffB); PG8_STAGE(PG8_SB(0, 1), b2 + hstep, voffB); PG8_STAGE_A(PG8_SA(0, 0), a2, 0, nx);
            PG8_WAIT_V(8); PG8_WAIT_L(0); PG8_BAR; PG8_MMA(1, 0, At, B0); PG8_MMA(1, 1, At, B1); PG8_BAR; PG8_SCHED;
            PG8_LDB(B0, 1, 0); PG8_LDB(B1, 1, 1); PG8_SCHED; PG8_LDA(At, 1, 0); PG8_STAGE_A(PG8_SA(0, 1), a2, 1, nx);
            PG8_WAIT_V(8); PG8_WAIT_L(0); PG8_BAR; PG8_MMA(0, 0, At, B0); PG8_MMA(0, 1, At, B1); PG8_BAR; PG8_SCHED;
            PG8_LDA(At, 1, 1); PG8_STAGE(PG8_SB(1, 0), b3, voffB); PG8_STAGE(PG8_SB(1, 1), b3 + hstep, voffB); PG8_STAGE_A(PG8_SA(1, 0), a3, 0, nx);
            PG8_WAIT_V(8); PG8_WAIT_L(0); PG8_BAR; PG8_MMA(1, 0, At, B0); PG8_MMA(1, 1, At, B1); PG8_BAR; PG8_SCHED;
            } else {
            static_assert(SP2 || !GATHER, "GATHER is implemented for the SP2 loop only");
            PG8_LDB(B0, 0, 0); PG8_SCHED; PG8_LDA(At, 0, 0); PG8_STAGE(PG8_SA(1, 1), a1 + hstep, voffA);
            PG8_WAIT_L(8); PG8_BAR; PG8_WAIT_L(0); PG8_MMA(0, 0, At, B0); PG8_BAR; PG8_SCHED;
            PG8_LDB(B1, 0, 1); PG8_STAGE(PG8_SB(0, 0), b2, voffB);
            PG8_BAR; PG8_WAIT_L(0); PG8_MMA(0, 1, At, B1); PG8_BAR;
            PG8_LDA(At, 0, 1); PG8_STAGE(PG8_SA(0, 0), a2, voffA);
            PG8_BAR; PG8_WAIT_L(0); PG8_MMA(1, 0, At, B0); PG8_BAR; PG8_SCHED;
            PG8_STAGE(PG8_SB(0, 1), b2 + hstep, voffB);
            PG8_WAIT_V(6); PG8_BAR; PG8_MMA(1, 1, At, B1); PG8_BAR;
            PG8_LDB(B0, 1, 0); PG8_SCHED; PG8_LDA(At, 1, 0); PG8_STAGE(PG8_SA(0, 1), a2 + hstep, voffA);
            PG8_WAIT_L(8); PG8_BAR; PG8_WAIT_L(0); PG8_MMA(0, 0, At, B0); PG8_BAR; PG8_SCHED;
            PG8_LDB(B1, 1, 1); PG8_STAGE(PG8_SB(1, 0), b3, voffB);
            PG8_BAR; PG8_WAIT_L(0); PG8_MMA(0, 1, At, B1); PG8_BAR;
            PG8_LDA(At, 1, 1); PG8_STAGE(PG8_SA(1, 0), a3, voffA);
            PG8_BAR; PG8_WAIT_L(0); PG8_MMA(1, 0, At, B0); PG8_BAR; PG8_SCHED;
            PG8_STAGE(PG8_SB(1, 1), b3 + hstep, voffB);
            PG8_WAIT_V(6); PG8_BAR; PG8_MMA(1, 1, At, B1); PG8_BAR;
            }
        }
        if constexpr (ALIGN_EPI) { if (wr == 0) PG8_BAR; }
        if constexpr (!Epi::AFTER_DRAIN) { E(acc, cur, wr, wc, fr, fq); S.done(cur); }
        if (!has_next) break;
#pragma unroll
        for (int a = 0; a < 2; ++a)
#pragma unroll
            for (int b = 0; b < 2; ++b)
#pragma unroll
                for (int m = 0; m < 4; ++m)
#pragma unroll
                    for (int n = 0; n < 2; ++n) acc[a][b][m][n] = (f32x4){0.f, 0.f, 0.f, 0.f};
        cur = nxt; cA = nA; cB = nB; ++ui;
        if constexpr (GATHER) {
#pragma unroll
            for (int _h = 0; _h < 2; ++_h)
#pragma unroll
                for (int _i = 0; _i < 2; ++_i) voffG[_h][_i] = voffN[_h][_i]; }
        if constexpr (ALIGN_EPI) { if (wr == 1) PG8_BAR; }
    }
    PG8_WAIT_V(0);
    if constexpr (!ALIGN_EPI) { if (wr == 0) PG8_BAR; }
    PG8_BAR;
    if constexpr (Epi::AFTER_DRAIN) { E.fused(acc, cur, wr, wc, fr, fq, lds, wid, lane); S.done(cur); }
#undef PG8_SA
#undef PG8_SB
#undef PG8_STAGE
#undef PG8_STAGE_A
#undef PG8_GIDX
#undef PG8_LDA
#undef PG8_LDB
#undef PG8_MMA
#undef PG8_WAIT_V
#undef PG8_WAIT_L
#undef PG8_BAR
#undef PG8_SCHED
}
}

#define GAS __attribute__((address_space(1)))
#define LAS __attribute__((address_space(3)))
typedef unsigned short bf16;
typedef unsigned v4u __attribute__((ext_vector_type(4)));
typedef unsigned v2u __attribute__((ext_vector_type(2)));
typedef float f32x4 __attribute__((ext_vector_type(4)));
typedef short bf16x8 __attribute__((ext_vector_type(8)));
typedef GAS unsigned gu32;
#define RLX_AGENT __ATOMIC_RELAXED, __HIP_MEMORY_SCOPE_AGENT
#define LDS_WAIT() asm volatile("s_waitcnt lgkmcnt(0)" ::: "memory")
#define VM_WAIT() asm volatile("s_waitcnt vmcnt(0)" ::: "memory")
__device__ __forceinline__ unsigned f2bf(float f) { unsigned u = __builtin_bit_cast(unsigned, f); return (u + 0x7fffu + ((u >> 16) & 1u)) >> 16; }
__device__ __forceinline__ unsigned pk2(float lo, float hi) { return pg8::cvt_pk_bf16(lo, hi); }
__device__ __forceinline__ float bf2f(unsigned short v) { return __builtin_bit_cast(float, (unsigned)v << 16); }
__device__ __forceinline__ float bflo(unsigned w) { return __builtin_bit_cast(float, w << 16); }
__device__ __forceinline__ float bfhi(unsigned w) { return __builtin_bit_cast(float, w & 0xffff0000u); }
template <int CTRL> __device__ __forceinline__ float dpp_lane(float v) { return __builtin_bit_cast(float, __builtin_amdgcn_update_dpp(0, __builtin_bit_cast(int, v), CTRL, 0xf, 0xf, true)); }
__device__ __forceinline__ float wave_sum(float v) {
    v += dpp_lane<0xB1>(v); v += dpp_lane<0x4E>(v); v += dpp_lane<0x141>(v); v += dpp_lane<0x140>(v);
    v += __shfl_xor(v, 16); v += __shfl_xor(v, 32);
    return v;
}
__device__ __forceinline__ float wave_max(float v) {
#pragma unroll
    for (int o = 1; o < 64; o <<= 1) v = fmaxf(v, __shfl_xor(v, o));
    return v;
}
__device__ __forceinline__ float gelu_tanh(float x) { const float u = 0.7978845608028654f * (x + 0.044715f * x * x * x); const float e = __expf(2.0f * u); return x * (1.0f - __builtin_amdgcn_rcpf(e + 1.0f)); }
__device__ __forceinline__ float sigmoid_f(float x) { return __builtin_amdgcn_rcpf(1.0f + __expf(-x)); }
__device__ __forceinline__ float log_sigmoid_f(float x) { return fminf(x, 0.f) - __logf(1.0f + __expf(-fabsf(x))); }

template <int D> __device__ __forceinline__ float dpp_row_shr(float v) { return __builtin_bit_cast(float, __builtin_amdgcn_update_dpp(0, __builtin_bit_cast(int, v), 0x110 + D, 0xf, 0xf, true)); }
__device__ __forceinline__ float dpp_xor1(float v) { return __builtin_bit_cast(float, __builtin_amdgcn_update_dpp(0, __builtin_bit_cast(int, v), 0xB1, 0xf, 0xf, true)); }
__device__ __forceinline__ float dpp_xor2(float v) { return __builtin_bit_cast(float, __builtin_amdgcn_update_dpp(0, __builtin_bit_cast(int, v), 0x4E, 0xf, 0xf, true)); }
#define XB_TMO      128
#define XB_XCNT(j)  (256  + 64 * (j))
#define XB_XSUB(j)  (1280 + 64 * (j))
#define XB_XGEN(j)  (2304 + 64 * (j))
#define XB_TOP      3328
#define XB_TOPGEN   3392
#define XCD_BAR_WORDS 3456
#define XB_SPIN_CAP (1u << 18)

__device__ __forceinline__ unsigned xb_ld(unsigned* p)              { return __hip_atomic_load(p, __ATOMIC_RELAXED, __HIP_MEMORY_SCOPE_AGENT); }
__device__ __forceinline__ unsigned xb_add(unsigned* p, unsigned v) { return __hip_atomic_fetch_add(p, v, __ATOMIC_RELAXED, __HIP_MEMORY_SCOPE_AGENT); }
__device__ __forceinline__ unsigned xb_xcc_id() { return (unsigned)__builtin_amdgcn_s_getreg((3 << 11) | 20) & 0xFu; }
#define XB_SPIN(cond, bar) do { unsigned _sp = 0; while (cond) { __builtin_amdgcn_s_sleep(1); \
    if ((++_sp & 255u) == 0u) { if (xb_ld(&(bar)[XB_TMO])) break; if (_sp > XB_SPIN_CAP) { atomicAdd(&(bar)[XB_TMO], 1u); break; } } } } while (0)

struct XcdBarrier {
    unsigned* bar; unsigned x;
    volatile LAS unsigned* st;
};

__device__ __forceinline__ XcdBarrier xcd_barrier_post(unsigned* bar, volatile LAS unsigned* st) {
    XcdBarrier b; b.bar = bar; b.x = xb_xcc_id(); b.st = st;
    if (threadIdx.x == 0) (void)xb_add(&bar[XB_XCNT(b.x)], 1u);
    return b;
}
__device__ __forceinline__ void xcd_barrier_complete(unsigned* bar, unsigned x, unsigned& nloc, unsigned& nx) {
    const unsigned G = gridDim.x * gridDim.y * gridDim.z;
    unsigned sum, cnt, mine, sp = 0u;
    for (;;) {
        sum = 0u; cnt = 0u; mine = 0u;
#pragma unroll
        for (unsigned j = 0; j < 16; ++j) { const unsigned c = xb_ld(&bar[XB_XCNT(j)]); sum += c; cnt += (c > 0u) ? 1u : 0u; mine = (j == x) ? c : mine; }
        if (sum == G) break;
        __builtin_amdgcn_s_sleep(1);
        if ((++sp & 255u) == 0u) { if (xb_ld(&bar[XB_TMO])) break; if (sp > XB_SPIN_CAP) { atomicAdd(&bar[XB_TMO], 1u); break; } }
    }
    nloc = mine > 0u ? mine : 1u; nx = cnt > 0u ? cnt : 1u;
}

__device__ __forceinline__ void xcd_barrier(const XcdBarrier& b) {
    asm volatile("s_waitcnt vmcnt(0)" ::: "memory");
    __syncthreads();
    if (threadIdx.x == 0) {
        unsigned* bar = b.bar;
        __builtin_amdgcn_s_waitcnt(0);
        unsigned nloc = b.st[0], nx = b.st[1];
        if (nloc == 0u) { xcd_barrier_complete(bar, b.x, nloc, nx); b.st[0] = nloc; b.st[1] = nx; }
        const unsigned old = xb_add(&bar[XB_XSUB(b.x)], 1u);
        const unsigned gen = old / nloc;
        if (old + 1u == (gen + 1u) * nloc) {
            __builtin_amdgcn_fence(__ATOMIC_RELEASE, "agent");
            asm volatile("s_waitcnt vmcnt(0)" ::: "memory");
            const unsigned og = xb_add(&bar[XB_TOP], 1u);
            const unsigned tg = og / nx;
            if (og + 1u == (tg + 1u) * nx) xb_add(&bar[XB_TOPGEN], 1u);
            else XB_SPIN(xb_ld(&bar[XB_TOPGEN]) == tg, bar);
            __builtin_amdgcn_fence(__ATOMIC_ACQUIRE, "agent");
            xb_add(&bar[XB_XGEN(b.x)], 1u);
            asm volatile("s_waitcnt vmcnt(0)" ::: "memory");
        } else {
            XB_SPIN(xb_ld(&bar[XB_XGEN(b.x)]) == gen, bar);
            __builtin_amdgcn_fence(__ATOMIC_ACQUIRE, "agent");
            asm volatile("s_waitcnt vmcnt(0)" ::: "memory");
        }
    }
    __syncthreads();
}


constexpr int NB = 8, SQ = 4096, NT = NB * SQ, DM = 1024;
constexpr int PW = 2560;
constexpr int P_DQ = 0, P_DK = 256, P_DV = 512, P_NQ = 768, P_KC = 1024, P_VC = 1088, P_KS = 1152, P_VS = 1216, P_KW = 1280, P_VW = 1344,
              P_GQ = 1408, P_GK = 1536, P_GV = 1664, P_GR = 1920, P_SU = 2176, P_GA = 2432, P_NG = 2448;
constexpr int PROJ_SRC = 2460;
constexpr int DFF = 2752, DFFP = 2816, DFE = 3584, NEXP = 8;
constexpr int NCMP = 255, NCMPP = 256;
__host__ __device__ __forceinline__ int inproj_src_col(int n) {
    if (n < 1408) return n;
    if (n < 1920) return n + 12;
    if (n < 2432) return n + 28;
    if (n < 2448) return n - 500;
    if (n < 2460) return n - 1040;
    return -1;
}
constexpr size_t MiB = 1u << 20;
constexpr size_t WS_CTL = 0, CTL_ZERO_BYTES = 1 * MiB;
constexpr size_t WS_WIN = 2 * MiB;
constexpr size_t WS_WOUT = 12 * MiB;
constexpr size_t WS_WFGU = 16 * MiB;
constexpr size_t WS_WFDN = 27 * MiB;
constexpr size_t WS_KC = 33 * MiB;
constexpr size_t WS_VC = WS_KC + 512 * 1024;
constexpr size_t WS_SEL = 34 * MiB;
constexpr size_t WS_CW = 34 * MiB + 512 * 1024;
constexpr size_t WS_HN = 36 * MiB;
constexpr size_t WS_PROJ = 100 * MiB;
constexpr size_t WS_MIXRAW = 260 * MiB;
constexpr size_t WS_GA = 388 * MiB;
constexpr size_t WS_GLAS = 404 * MiB;
constexpr size_t WS_OS = 420 * MiB, WS_OW = 452 * MiB;
constexpr size_t WS_HG = 484 * MiB;
constexpr size_t WS_S5X = 500 * MiB;
constexpr size_t WS_GLAD = 504 * MiB;
constexpr size_t WS_XB = 324 * MiB;
constexpr size_t WS_DO1 = 324 * MiB;
constexpr size_t WS_DL1 = 356 * MiB;
constexpr size_t WS_SSQ = 513 * MiB;
constexpr size_t WS_W2T = 34 * MiB + 256 * 1024;
constexpr size_t WS_S5TAB = 33 * MiB;
constexpr size_t WS_WGLU = 35 * MiB + 512 * 1024;
constexpr size_t WS_W1CT = 505 * MiB;
constexpr size_t WS_BIASP = 509 * MiB;
constexpr size_t WS_CHID = 510 * MiB;
constexpr size_t WS_KCB = 512 * MiB;
constexpr size_t WS_VCB = 512 * MiB + 256 * 1024;
constexpr size_t WS_FH = 100 * MiB;
constexpr size_t WS_WEGU = 100 * MiB;
constexpr size_t WS_WEDN = 114 * MiB;
constexpr size_t WS_EH = 128 * MiB;
constexpr int MOE_ROWS = 2 * NT + 8 * 256, MOE_HH = DFE / 2, MOE_NPN = MOE_HH / 128;
constexpr size_t WS_MTAB = 1 * MiB;
constexpr size_t WS_WCNT = 1 * MiB + 4096;
constexpr size_t WS_TOKINFO = 1 * MiB + 128 * 1024;
constexpr size_t WS_TOPW = 1 * MiB + 256 * 1024;
constexpr size_t WS_TOKPOS = 1 * MiB + 512 * 1024;
constexpr size_t WS_ROWTOK = 1 * MiB + 768 * 1024;
constexpr size_t WS_W2H = 3 * MiB;
constexpr size_t WS_W1H = 100 * MiB;
constexpr size_t WS_MHID = 156 * MiB;
constexpr size_t WS_MY = 387 * MiB;
constexpr size_t WS_END = 519 * MiB;
constexpr int GIDX_OFF = 131072 + 1024;
constexpr int CW_BAR = 4096;
constexpr int RING_OFF = 0, RING_BYTES = 131072;
constexpr int LDSCTL_OFF = RING_BYTES, MISC_OFF = LDSCTL_OFF + 320;
constexpr int LDS_BYTES = 147456;
constexpr int NWAVES = 8;

struct ConvJob { const float* src0; const float* src1; bf16* dst; int ld, Ksrc, Nsrc, Nd, Kd, mode, pad; const float* kscale = nullptr; };
__device__ __forceinline__ void conv_item(const ConvJob& J, LAS float* scr, int item, int lane) {
    const int nblk = J.Nd / 32, kb = item / nblk, nb = item % nblk, k0 = 64 * kb, n0 = 32 * nb;
    const int n = n0 + (lane & 31);
    const float* sp = nullptr;
    if (J.mode == 0) { if (n < J.Nsrc) sp = J.src0 + n; }
    else if (J.mode == 1) { const int c = inproj_src_col(n); if (c >= 0) sp = J.src0 + c; }
    else { const int pn = n >> 8, s = (n >> 7) & 1, j = J.pad + 128 * pn + (n & 127); const long long d01 = (const char*)J.src1 - (const char*)J.src0;
           if (j < J.Nsrc) sp = (const float*)((const char*)J.src0 + (s ? d01 : 0ll)) + j; }
#pragma unroll 8
    for (int i = 0; i < 32; ++i) { const int kk = 2 * i + (lane >> 5); float v = 0.f; if (sp && (k0 + kk) < J.Ksrc) { v = sp[(size_t)(k0 + kk) * J.ld]; if (J.kscale) v *= J.kscale[k0 + kk]; } scr[kk * 33 + (lane & 31)] = v; }
    LDS_WAIT(); asm volatile("" ::: "memory");
    const int c = lane & 7;
#pragma unroll
    for (int j = 0; j < 4; ++j) { const int nn = (lane >> 3) + 8 * j; const LAS float* s = scr + (8 * c) * 33 + nn;
        v4u o; o.x = pk2(s[0 * 33], s[1 * 33]); o.y = pk2(s[2 * 33], s[3 * 33]); o.z = pk2(s[4 * 33], s[5 * 33]); o.w = pk2(s[6 * 33], s[7 * 33]);
        *(GAS v4u*)(J.dst + (size_t)(n0 + nn) * J.Kd + k0 + 8 * c) = o; }
    LDS_WAIT(); asm volatile("" ::: "memory");
}
__device__ __forceinline__ void conv_run(const ConvJob& J, LAS float* scr, int gw, int ngw, int lane) {
    const int nitems = (J.Kd / 64) * (J.Nd / 32);
    for (int it = gw; it < nitems; it += ngw) conv_item(J, scr, it, lane);
}
__device__ __forceinline__ void conv_fast_item(const ConvJob& J, int item, int lane) {
    const int nblk = J.Nd / 256, kb = item / nblk, nb = item - kb * nblk, k0 = 32 * kb, n = 256 * nb + 4 * lane;
    const float* sp = nullptr;
    if (J.mode == 0) { if (n < J.Nsrc) sp = J.src0 + n; }
    else { const int pn = n >> 8, s = (n >> 7) & 1, j = J.pad + 128 * pn + (n & 127); const long long d01 = (const char*)J.src1 - (const char*)J.src0;
           if (j < J.Nsrc) sp = (const float*)((const char*)J.src0 + (s ? d01 : 0ll)) + j; }
    const bool live = (sp != nullptr) && (k0 < J.Ksrc);
    f32x4 v[32];
#pragma unroll
    for (int i = 0; i < 32; ++i) v[i] = live ? *(const f32x4*)(sp + (size_t)(k0 + i) * J.ld) : (f32x4){0.f, 0.f, 0.f, 0.f};
    if (J.kscale && live) {
#pragma unroll
        for (int i = 0; i < 32; ++i) v[i] = v[i] * J.kscale[k0 + i]; }
#pragma unroll
    for (int j = 0; j < 4; ++j) { bf16* dp = J.dst + (size_t)(n + j) * J.Kd + k0;
#pragma unroll
        for (int q = 0; q < 4; ++q) { v4u o; o.x = pk2(v[8 * q][j], v[8 * q + 1][j]); o.y = pk2(v[8 * q + 2][j], v[8 * q + 3][j]); o.z = pk2(v[8 * q + 4][j], v[8 * q + 5][j]); o.w = pk2(v[8 * q + 6][j], v[8 * q + 7][j]);
            *(GAS v4u*)(dp + 8 * q) = o; } }
}
__device__ __forceinline__ void conv_fast(const ConvJob& J, int gw, int ngw, int lane) {
    const int nitems = (J.Kd / 32) * (J.Nd / 256);
    for (int it = gw; it < nitems; it += ngw) conv_fast_item(J, it, lane);
}

template <bool ROUTER>
__device__ __forceinline__ void k_norm(int row, int lane, const float* __restrict__ x, const float* __restrict__ g, bf16* __restrict__ out,
                                              const float* __restrict__ rw, const float* __restrict__ rb, float* __restrict__ cw) {
    const f32x4* xr = (const f32x4*)(x + (size_t)row * DM) + lane;
    f32x4 v[4]; float s = 0.f;
#pragma unroll
    for (int j = 0; j < 4; ++j) { v[j] = xr[64 * j]; s += (v[j].x * v[j].x + v[j].y * v[j].y) + (v[j].z * v[j].z + v[j].w * v[j].w); }
    s = wave_sum(s);
    const float rstd = rsqrtf(s * (1.0f / DM) + 1e-6f);
    const f32x4* gr = (const f32x4*)g + lane;
    v2u* o8 = (v2u*)(out + (size_t)row * DM) + lane;
#pragma unroll
    for (int j = 0; j < 4; ++j) { const f32x4 gv = gr[64 * j]; v[j] = v[j] * rstd * gv; v2u o; o.x = pk2(v[j].x, v[j].y); o.y = pk2(v[j].z, v[j].w); o8[64 * j] = o; }
    if (ROUTER) {
        float lg[8];
#pragma unroll
        for (int e = 0; e < 8; ++e) lg[e] = 0.f;
#pragma unroll
        for (int j = 0; j < 4; ++j)
#pragma unroll
            for (int i = 0; i < 4; ++i) { const int c = 4 * lane + 256 * j + i; const f32x4 w0 = *(const f32x4*)(rw + (size_t)c * 8), w1 = *(const f32x4*)(rw + (size_t)c * 8 + 4); const float h = v[j][i];
                lg[0] += h * w0.x; lg[1] += h * w0.y; lg[2] += h * w0.z; lg[3] += h * w0.w; lg[4] += h * w1.x; lg[5] += h * w1.y; lg[6] += h * w1.z; lg[7] += h * w1.w; }
#pragma unroll
        for (int e = 0; e < 8; ++e) lg[e] = wave_sum(lg[e]) + rb[e];
        int i1 = 0; float v1 = lg[0];
#pragma unroll
        for (int e = 1; e < 8; ++e) if (lg[e] > v1) { v1 = lg[e]; i1 = e; }
        int i2 = -1; float v2 = -3.0e38f;
#pragma unroll
        for (int e = 0; e < 8; ++e) if (e != i1 && lg[e] > v2) { v2 = lg[e]; i2 = e; }
        const float e2 = __expf(v2 - v1), w1 = 1.0f / (1.0f + e2), w2 = e2 * w1;
        if (lane < 8) cw[(size_t)row * 8 + lane] = (lane == i1) ? w1 : ((lane == i2) ? w2 : 0.f);
    }
}

__device__ __forceinline__ void k_headnorm(int row, int lane, bf16* __restrict__ proj, const float* __restrict__ dil_g  , const float* __restrict__ nsa_g  ) {
    bf16* pr = proj + (size_t)row * PW;
#pragma unroll 1
    for (int i = 0; i < 14; ++i) {
        int off; const float* g;
        if (i < 4) { off = P_DQ + 64 * i; g = dil_g; } else if (i < 8) { off = P_DK + 64 * (i - 4); g = dil_g + 64; } else if (i < 12) { off = P_NQ + 64 * (i - 8); g = nsa_g; }
        else if (i == 12) { off = P_KS; g = nsa_g + 128; } else { off = P_KW; g = nsa_g + 192; }
        const float v = bf2f(pr[off + lane]);
        const float ss = wave_sum(v * v);
        pr[off + lane] = (bf16)f2bf(v * rsqrtf(ss * (1.0f / 64.0f) + 1e-6f) * g[lane]);
    }
}

__device__ __forceinline__ void att_key(const float (&q)[64], const bf16* __restrict__ kp, const bf16* __restrict__ vp, float bias, float& m, float& l, float (&o)[64]) {
    float dot = 0.f;
#pragma unroll
    for (int c = 0; c < 8; ++c) { const v4u kk = *(const v4u*)(kp + 8 * c);
        dot += q[8 * c + 0] * bflo(kk.x) + q[8 * c + 1] * bfhi(kk.x) + q[8 * c + 2] * bflo(kk.y) + q[8 * c + 3] * bfhi(kk.y)
             + q[8 * c + 4] * bflo(kk.z) + q[8 * c + 5] * bfhi(kk.z) + q[8 * c + 6] * bflo(kk.w) + q[8 * c + 7] * bfhi(kk.w); }
    const float s = dot * 0.125f + bias;
    const float mn = fmaxf(m, s), sc = __expf(m - mn), p = __expf(s - mn);
    l = l * sc + p; m = mn;
#pragma unroll
    for (int c = 0; c < 8; ++c) { const v4u vv = *(const v4u*)(vp + 8 * c);
        o[8 * c + 0] = o[8 * c + 0] * sc + p * bflo(vv.x); o[8 * c + 1] = o[8 * c + 1] * sc + p * bfhi(vv.x);
        o[8 * c + 2] = o[8 * c + 2] * sc + p * bflo(vv.y); o[8 * c + 3] = o[8 * c + 3] * sc + p * bfhi(vv.y);
        o[8 * c + 4] = o[8 * c + 4] * sc + p * bflo(vv.z); o[8 * c + 5] = o[8 * c + 5] * sc + p * bfhi(vv.z);
        o[8 * c + 6] = o[8 * c + 6] * sc + p * bflo(vv.w); o[8 * c + 7] = o[8 * c + 7] * sc + p * bfhi(vv.w); }
}
__device__ __forceinline__ void load_q(float (&q)[64], const bf16* qp) {
#pragma unroll
    for (int c = 0; c < 8; ++c) { const v4u kk = *(const v4u*)(qp + 8 * c);
        q[8 * c + 0] = bflo(kk.x); q[8 * c + 1] = bfhi(kk.x); q[8 * c + 2] = bflo(kk.y); q[8 * c + 3] = bfhi(kk.y);
        q[8 * c + 4] = bflo(kk.z); q[8 * c + 5] = bfhi(kk.z); q[8 * c + 6] = bflo(kk.w); q[8 * c + 7] = bfhi(kk.w); }
}
template <int MODE>
__device__ __forceinline__ void k_attn_naive(int idx, const bf16* __restrict__ proj, const unsigned long long* __restrict__ sel, float* __restrict__ out, int ldo, int ocol) {
    const int h = idx / NT, r = idx % NT, b = r / SQ, t = r % SQ;
    const bf16* base = proj + (size_t)b * SQ * PW;
    float q[64], o[64];
    load_q(q, proj + (size_t)r * PW + (MODE == 0 ? P_DQ : P_NQ) + 64 * h);
#pragma unroll
    for (int d = 0; d < 64; ++d) o[d] = 0.f;
    float m = -1.0e30f, l = 0.f;
    if (MODE == 0) {
        const float slope = exp2f(-2.0f * (h + 1));
        for (int p = 0; p < 3; ++p) { const int dil = (p == 0) ? 1 : (p == 1 ? 4 : 16);
            for (int j = 0; j <= 128; ++j) { const int pos = t - j * dil; if (pos < 0) break;
                att_key(q, base + (size_t)pos * PW + P_DK + 64 * h, base + (size_t)pos * PW + P_DV + 64 * h, -slope * (float)(j * dil), m, l, o); } }
    } else if (MODE == 1) {
        const float slope = exp2f(-(2.0f * h + 1.0f));
        const unsigned long long mask = sel[r]; const int cur = t >> 6;
        for (int j = 0; j <= cur; ++j) { if (!((mask >> j) & 1ull)) continue;
            for (int oo = 0; oo < 64; ++oo) { const int pos = 64 * j + oo; if (pos > t) break;
                att_key(q, base + (size_t)pos * PW + P_KS, base + (size_t)pos * PW + P_VS, -slope * (float)(t - pos), m, l, o); } }
    } else {
        const float slope = exp2f(-(2.0f * h + 1.0f));
        const int p0 = (t - 511) > 0 ? (t - 511) : 0;
        for (int pos = p0; pos <= t; ++pos) att_key(q, base + (size_t)pos * PW + P_KW, base + (size_t)pos * PW + P_VW, -slope * (float)(t - pos), m, l, o);
    }
    const float il = 1.0f / l;
    float* op = out + (size_t)r * ldo + ocol + 64 * h;
#pragma unroll
    for (int c = 0; c < 16; ++c) *(f32x4*)(op + 4 * c) = (f32x4){o[4 * c] * il, o[4 * c + 1] * il, o[4 * c + 2] * il, o[4 * c + 3] * il};
}

__device__ __forceinline__ void k_compress(int vb, int tid, LAS float* sm, const bf16* __restrict__ proj, const float* __restrict__ pos  , const float* __restrict__ w1  ,
                                                  const float* __restrict__ w2  , const float* __restrict__ gk  , float* __restrict__ KC, float* __restrict__ VC) {
    LAS float* in = sm; LAS float* hid = sm + 2048;
    const int which = vb & 1, c = (vb >> 1) % NCMP, b = (vb >> 1) / NCMP;
    const int pc = which ? P_VC : P_KC;
    for (int i = tid; i < 2048; i += 256) { const int l = i >> 6, d = i & 63; in[i] = bf2f(proj[(size_t)(b * SQ + 16 * c + l) * PW + pc + d]) + pos[which * 2048 + i]; }
    __syncthreads();
    const float* w1p = w1 + (size_t)which * 2048 * 256 + tid;
    float a = 0.f;
    for (int i = 0; i < 2048; ++i) a += in[i] * w1p[(size_t)i * 256];
    hid[tid] = gelu_tanh(a);
    __syncthreads();
    if (tid < 64) {
        const float* w2p = w2 + (size_t)which * 256 * 64 + tid; float o = 0.f;
        for (int j = 0; j < 256; ++j) o += hid[j] * w2p[j * 64];
        if (which == 0) { const float ss = wave_sum(o * o); o = o * rsqrtf(ss * (1.0f / 64.0f) + 1e-6f) * gk[tid]; KC[((size_t)b * NCMPP + c) * 64 + tid] = o; }
        else VC[((size_t)b * NCMPP + c) * 64 + tid] = o;
    }
}

__device__ __forceinline__ void k_cmp_topk(int vb, int tid, LAS float* sm, const bf16* __restrict__ proj, const float* __restrict__ KC, const float* __restrict__ VC, float* __restrict__ ocmp, int ldoc, unsigned long long* __restrict__ sel) {
    LAS float* qs = sm; LAS float (*sc)[256] = (LAS float (*)[256])(sm + 256); LAS float* impv = sm + 1280;
    const int r = vb, b = r / SQ, t = r % SQ, lane = tid & 63, w = tid >> 6;
    qs[tid] = bf2f(proj[(size_t)r * PW + P_NQ + tid]);
    __syncthreads();
    {   const int c = tid; const bool valid = (c < NCMP) && (t >= 16 * c + 31);
        float s[4] = {0.f, 0.f, 0.f, 0.f};
        if (valid) { const float* kp = KC + ((size_t)b * NCMPP + c) * 64;
            for (int d = 0; d < 64; ++d) { const float kv = kp[d]; s[0] += qs[d] * kv; s[1] += qs[64 + d] * kv; s[2] += qs[128 + d] * kv; s[3] += qs[192 + d] * kv; } }
        const float dist = (float)(t - 16 * c - 31);
#pragma unroll
        for (int h = 0; h < 4; ++h) sc[h][c] = valid ? (s[h] * 0.125f - exp2f(-(2.0f * h + 1.0f)) * dist) : -1.0e30f;
    }
    __syncthreads();
    {
        float v[4]; float mx = -1.0e30f;
#pragma unroll
        for (int i = 0; i < 4; ++i) { v[i] = sc[w][lane + 64 * i]; mx = fmaxf(mx, v[i]); }
        mx = wave_max(mx);
        float sum = 0.f;
#pragma unroll
        for (int i = 0; i < 4; ++i) { v[i] = (v[i] > -1.0e29f) ? __expf(v[i] - mx) : 0.f; sum += v[i]; }
        sum = wave_sum(sum);
        const float inv = sum > 0.f ? 1.0f / sum : 0.f;
#pragma unroll
        for (int i = 0; i < 4; ++i) sc[w][lane + 64 * i] = v[i] * inv;
    }
    __syncthreads();
    {
        const int h = tid >> 6, d = tid & 63; const float* vp = VC + (size_t)b * NCMPP * 64 + d; float o = 0.f;
        const int nc = (t >= 31) ? ((t - 31) / 16 + 1) : 0;
        for (int c = 0; c < nc && c < NCMP; ++c) o += sc[h][c] * vp[c * 64];
        ocmp[(size_t)r * ldoc + tid] = o;
    }
    if (tid < 64) {
        const int j = tid, cur = t >> 6; float imp = 0.f;
        for (int c = 4 * j - 1; c <= 4 * j + 3; ++c) if (c >= 0 && c < NCMP) imp += sc[0][c] + sc[1][c] + sc[2][c] + sc[3][c];
        const bool forced = (j == 0) || (j == cur) || (j == cur - 1);
        const float val = (j <= cur) ? (imp + (forced ? 1.0e4f : 0.f)) : -1.0e30f;
        impv[j] = val;
    }
    __syncthreads();
    if (tid < 64) {
        const int j = tid; const float val = impv[j]; int rank = 0;
        for (int k = 0; k < 64; ++k) { const float o = impv[k]; rank += (o > val || (o == val && k < j)) ? 1 : 0; }
        const unsigned long long mask = __ballot(rank < 16);
        if (tid == 0) sel[r] = mask;
    }
}

__device__ __forceinline__ void k_gla(int vb, int lane, const bf16* __restrict__ proj, const float* __restrict__ wa2  , const float* __restrict__ ba  , const float* __restrict__ ng  , float* __restrict__ mixraw) {
    const int b = vb >> 2, h = vb & 3, kk = lane & 31;
    float wcol[16];
#pragma unroll
    for (int j = 0; j < 16; ++j) wcol[j] = wa2[j * 128 + h * 32 + kk];
    const float bav = ba[h * 32 + kk], gn = ng[lane];
    float S[32];
#pragma unroll
    for (int k = 0; k < 32; ++k) S[k] = 0.f;
    for (int t = 0; t < SQ; ++t) {
        const bf16* pr = proj + (size_t)(b * SQ + t) * PW;
        const float qv = bf2f(pr[P_GQ + h * 32 + kk]) * 0.17677669529663687f, kv = bf2f(pr[P_GK + h * 32 + kk]);
        const v4u a0 = *(const v4u*)(pr + P_GA), a1 = *(const v4u*)(pr + P_GA + 8);
        float z = bav;
        z += bflo(a0.x) * wcol[0] + bfhi(a0.x) * wcol[1] + bflo(a0.y) * wcol[2] + bfhi(a0.y) * wcol[3] + bflo(a0.z) * wcol[4] + bfhi(a0.z) * wcol[5] + bflo(a0.w) * wcol[6] + bfhi(a0.w) * wcol[7];
        z += bflo(a1.x) * wcol[8] + bfhi(a1.x) * wcol[9] + bflo(a1.y) * wcol[10] + bfhi(a1.y) * wcol[11] + bflo(a1.z) * wcol[12] + bfhi(a1.z) * wcol[13] + bflo(a1.w) * wcol[14] + bfhi(a1.w) * wcol[15];
        const float av = __expf(log_sigmoid_f(z) * (1.0f / 16.0f));
        const float vv = bf2f(pr[P_GV + h * 64 + lane]);
        float o = 0.f;
#pragma unroll
        for (int k = 0; k < 32; ++k) { const float ak = __shfl(av, k), kx = __shfl(kv, k), qx = __shfl(qv, k); S[k] = S[k] * ak + kx * vv; o += qx * S[k]; }
        const float ss = wave_sum(o * o);
        float y = o * rsqrtf(ss * (1.0f / 64.0f) + 1e-6f) * gn;
        const float rr = bf2f(pr[P_GR + h * 64 + lane]);
        y *= rr * sigmoid_f(rr);
        mixraw[(size_t)(b * SQ + t) * 1024 + 512 + h * 64 + lane] = y;
    }
}

__device__ __forceinline__ void k_s5(int vb, int lane, LAS float* xs, const bf16* __restrict__ proj, const float* __restrict__ a_re, const float* __restrict__ a_im, const float* __restrict__ b_re, const float* __restrict__ b_im,
                                           const float* __restrict__ c_re, const float* __restrict__ c_im, const float* __restrict__ dvec, const float* __restrict__ log_dt, float* __restrict__ hg) {
    const int b = vb >> 4, g = vb & 15, n = lane;
    const float dt = expf(log_dt[g]), are = a_re[g * 64 + n], aim = a_im[g * 64 + n];
    const float mag = expf(dt * are), abr = mag * cosf(dt * aim), abi = mag * sinf(dt * aim);
    const float den = are * are + aim * aim, f_re = ((abr - 1.0f) * are + abi * aim) / den, f_im = (abi * are - (abr - 1.0f) * aim) / den;
    float bbr[16], bbi[16];
#pragma unroll
    for (int c = 0; c < 16; ++c) { const float br = b_re[(size_t)(g * 64 + n) * 16 + c], bi = b_im[(size_t)(g * 64 + n) * 16 + c]; bbr[c] = f_re * br - f_im * bi; bbi[c] = f_re * bi + f_im * br; }
    const int cc = lane & 15, qq = lane >> 4;
    float cre[16], cim[16];
#pragma unroll
    for (int i = 0; i < 16; ++i) { cre[i] = c_re[(size_t)(g * 16 + cc) * 64 + qq * 16 + i]; cim[i] = c_im[(size_t)(g * 16 + cc) * 64 + qq * 16 + i]; }
    const float dco = dvec[g * 16 + cc];
    float xr = 0.f, xi = 0.f;
    for (int t = 0; t < SQ; ++t) {
        const size_t r = (size_t)b * SQ + t;
        const float uval = bf2f(proj[r * PW + P_SU + g * 16 + cc]);
        float bur = 0.f, bui = 0.f;
#pragma unroll
        for (int c = 0; c < 16; ++c) { const float uc = __shfl(uval, c); bur += bbr[c] * uc; bui += bbi[c] * uc; }
        const float nr = abr * xr - abi * xi + bur, ni = abr * xi + abi * xr + bui; xr = nr; xi = ni;
        xs[n] = xr; xs[64 + n] = xi;
        LDS_WAIT(); asm volatile("" ::: "memory");
        float part = 0.f;
#pragma unroll
        for (int i = 0; i < 16; ++i) part += cre[i] * xs[qq * 16 + i] - cim[i] * xs[64 + qq * 16 + i];
        part += __shfl_xor(part, 16); part += __shfl_xor(part, 32);
        const float y = part + dco * uval;
        if (lane < 16) hg[r * 256 + g * 16 + lane] = gelu_tanh(y);
        LDS_WAIT(); asm volatile("" ::: "memory");
    }
}
__device__ __forceinline__ void k_s5_glu(int vb, int tid, LAS float* hs, const float* __restrict__ hg, const float* __restrict__ gw  , const float* __restrict__ gb, float* __restrict__ mixraw) {
    const int r = vb;
    hs[tid] = hg[(size_t)r * 256 + tid];
    __syncthreads();
    float z = gb[tid];
    for (int i = 0; i < 256; ++i) z += hs[i] * gw[i * 256 + tid];
    mixraw[(size_t)r * 1024 + 768 + tid] = hs[tid] * sigmoid_f(z);
}
__device__ __forceinline__ void k_mixfinal(int vb, int tid, LAS float* sm, const bf16* __restrict__ proj, const float* __restrict__ mixraw, const float* __restrict__ ocmp, int ldoc, const float* __restrict__ os, const float* __restrict__ ow,
                                                  const float* __restrict__ og  , bf16* __restrict__ mix) {
    LAS float (*red)[4] = (LAS float (*)[4])sm;
    const int r = vb, lane = tid & 63, w = tid >> 6;
    float v[4];
    v[0] = mixraw[(size_t)r * 1024 + tid]; v[2] = mixraw[(size_t)r * 1024 + 512 + tid]; v[3] = mixraw[(size_t)r * 1024 + 768 + tid];
    {   const bf16* gp = proj + (size_t)r * PW + P_NG + 3 * w;
        const float g0 = sigmoid_f(bf2f(gp[0])), g1 = sigmoid_f(bf2f(gp[1])), g2 = sigmoid_f(bf2f(gp[2]));
        v[1] = g0 * ocmp[(size_t)r * ldoc + tid] + g1 * os[(size_t)r * 256 + tid] + g2 * ow[(size_t)r * 256 + tid]; }
#pragma unroll
    for (int gidx = 0; gidx < 4; ++gidx) { const float s = wave_sum(v[gidx] * v[gidx]); if (lane == 0) red[gidx][w] = s; }
    __syncthreads();
#pragma unroll
    for (int gidx = 0; gidx < 4; ++gidx) { const float ss = red[gidx][0] + red[gidx][1] + red[gidx][2] + red[gidx][3];
        mix[(size_t)r * 1024 + gidx * 256 + tid] = (bf16)f2bf(v[gidx] * rsqrtf(ss * (1.0f / 256.0f) + 1e-6f) * og[gidx * 256 + tid]); }
}

typedef short s16x4 __attribute__((ext_vector_type(4)));
constexpr float ATT_SC = 0.125f * 1.4426950408889634f;
constexpr int VROWB = 144;
struct AttSt { f32x4 o[4]; float l; };
__device__ __forceinline__ s16x4 lds_tr16(const LAS unsigned char* p) { return __builtin_bit_cast(s16x4, __builtin_amdgcn_ds_read_tr16_b64_v4i16((LAS s16x4*)p)); }
__device__ __forceinline__ unsigned cvtpk(float lo, float hi) { return pg8::cvt_pk_bf16(lo, hi); }

constexpr float ATT_REF = 16.0f;
template <int NG>
__device__ __forceinline__ void att_unit(const bf16x8 (&kf)[2][2], const LAS unsigned char* vl, const bf16x8 (&qf)[NG][2], AttSt (&st)[NG],
                                         const int (&d0)[NG], const float (&c1)[NG], const int (&dmax)[NG], int dstep, int lane) {
    const int g = lane >> 4, i16 = lane & 15;
    const LAS unsigned char* vrd = vl + (4 * g + (i16 >> 2)) * VROWB + (i16 & 3) * 8;
    bf16x8 vt[4];
#pragma unroll
    for (int db = 0; db < 4; ++db) { const s16x4 a = lds_tr16(vrd + db * 32), b = lds_tr16(vrd + 16 * VROWB + db * 32);
        vt[db] = (bf16x8){a[0], a[1], a[2], a[3], b[0], b[1], b[2], b[3]}; }
    asm volatile("s_waitcnt lgkmcnt(0)" ::: "memory");
#pragma unroll
    for (int gi = 0; gi < NG; ++gi) {
        f32x4 s0 = {0.f, 0.f, 0.f, 0.f}, s1 = {0.f, 0.f, 0.f, 0.f};
        s0 = __builtin_amdgcn_mfma_f32_16x16x32_bf16(kf[0][0], qf[gi][0], s0, 0, 0, 0);
        s0 = __builtin_amdgcn_mfma_f32_16x16x32_bf16(kf[0][1], qf[gi][1], s0, 0, 0, 0);
        s1 = __builtin_amdgcn_mfma_f32_16x16x32_bf16(kf[1][0], qf[gi][0], s1, 0, 0, 0);
        s1 = __builtin_amdgcn_mfma_f32_16x16x32_bf16(kf[1][1], qf[gi][1], s1, 0, 0, 0);
        const float cd = c1[gi] * (float)dstep, B0 = fmaf(-c1[gi], (float)d0[gi], -ATT_REF);
        float x[8];
#pragma unroll
        for (int e = 0; e < 8; ++e) { const int kq = 16 * (e >> 2) + (e & 3), dist = d0[gi] - dstep * kq; const float a = (e < 4) ? s0[e & 3] : s1[e & 3];
            const float v = __builtin_amdgcn_exp2f(fmaf(a, ATT_SC, fmaf(cd, (float)kq, B0)));
            x[e] = ((unsigned)dist <= (unsigned)dmax[gi]) ? v : 0.f; }
        st[gi].l += ((x[0] + x[1]) + (x[2] + x[3])) + ((x[4] + x[5]) + (x[6] + x[7]));
        v4u pw; pw.x = cvtpk(x[0], x[1]); pw.y = cvtpk(x[2], x[3]); pw.z = cvtpk(x[4], x[5]); pw.w = cvtpk(x[6], x[7]);
        const bf16x8 pf = __builtin_bit_cast(bf16x8, pw);
#pragma unroll
        for (int db = 0; db < 4; ++db) st[gi].o[db] = __builtin_amdgcn_mfma_f32_16x16x32_bf16(vt[db], pf, st[gi].o[db], 0, 0, 0);
    }
}
__device__ __forceinline__ void att_load_k(bf16x8 (&kf)[2][2], const bf16* kb, int pitch, int r0, int r1, int g) {
    kf[0][0] = *(const bf16x8*)(kb + (size_t)r0 * pitch + 8 * g); kf[0][1] = *(const bf16x8*)(kb + (size_t)r0 * pitch + 32 + 8 * g);
    kf[1][0] = *(const bf16x8*)(kb + (size_t)r1 * pitch + 8 * g); kf[1][1] = *(const bf16x8*)(kb + (size_t)r1 * pitch + 32 + 8 * g);
}
__device__ __forceinline__ void att_load_v(v4u (&vf)[4], const bf16* vb, int pitch, const int (&vr)[4], int lane) {
#pragma unroll
    for (int i = 0; i < 4; ++i) vf[i] = *(const v4u*)(vb + (size_t)vr[i] * pitch + 8 * (lane & 7));
}
__device__ __forceinline__ void att_store_v(LAS unsigned char* vl, const v4u (&vf)[4], int lane) {
#pragma unroll
    for (int i = 0; i < 4; ++i) *(LAS v4u*)(vl + (8 * i + (lane >> 3)) * VROWB + 16 * (lane & 7)) = vf[i];
    asm volatile("s_waitcnt lgkmcnt(0)" ::: "memory");
}
__device__ __forceinline__ void att_init(AttSt& s) {
#pragma unroll
    for (int db = 0; db < 4; ++db) s.o[db] = (f32x4){0.f, 0.f, 0.f, 0.f};
    s.l = 0.f;
}
__device__ __forceinline__ void att_load_q(bf16x8 (&q)[2], const bf16* qp  , int g) {
    q[0] = *(const bf16x8*)(qp + 8 * g); q[1] = *(const bf16x8*)(qp + 32 + 8 * g);
}
__device__ __forceinline__ void att_finish(AttSt& s) {
    float l = s.l; l += __shfl_xor(l, 16); l += __shfl_xor(l, 32);
    const float il = l > 0.f ? 1.0f / l : 0.f;
#pragma unroll
    for (int db = 0; db < 4; ++db) s.o[db] = s.o[db] * il;
}

__device__ __forceinline__ void att_store_bf16(bf16* op, const AttSt& s) {
#pragma unroll
    for (int db = 0; db < 4; ++db) { v2u w; w.x = pk2(s.o[db][0], s.o[db][1]); w.y = pk2(s.o[db][2], s.o[db][3]); *(v2u*)(op + 16 * db) = w; }
}
__device__ __forceinline__ void nsa_win_job(int job, int lane, LAS unsigned char* vl, const bf16* __restrict__ proj, bf16* __restrict__ ow) {
    const int b = job / (SQ / 8), t0 = (job % (SQ / 8)) * 8, g = lane >> 4, c = lane & 15, qi = c >> 2, h = c & 3;
    const bf16* pb = proj + (size_t)b * SQ * PW;
    bf16x8 qf[2][2]; AttSt st[2]; int tq[2], dmax[2], d0[2]; float c1[2];
#pragma unroll
    for (int gi = 0; gi < 2; ++gi) { tq[gi] = t0 + 4 * gi + qi; att_load_q(qf[gi], pb + (size_t)tq[gi] * PW + P_NQ + 64 * h, g); att_init(st[gi]);
        c1[gi] = exp2f(-(2.0f * h + 1.0f)) * 1.4426950408889634f; dmax[gi] = tq[gi] < 511 ? tq[gi] : 511; }
    const int u0 = (t0 - 511) > 0 ? ((t0 - 511) >> 5) : 0, u1 = (t0 + 7) >> 5;
    bf16x8 kf[2][2]; v4u vf[4]; int vr[4];
    {   const int p0 = 32 * u0;
#pragma unroll
        for (int i = 0; i < 4; ++i) vr[i] = p0 + 8 * i + (lane >> 3);
        att_load_k(kf, pb + P_KW, PW, p0 + c, p0 + 16 + c, g); att_load_v(vf, pb + P_VW, PW, vr, lane); }
    for (int u = u0; u <= u1; ++u) {
        bf16x8 kc[2][2];
#pragma unroll
        for (int a = 0; a < 2; ++a)
#pragma unroll
            for (int k = 0; k < 2; ++k) kc[a][k] = kf[a][k];
        att_store_v(vl, vf, lane);
        if (u < u1) { const int p1 = 32 * (u + 1);
#pragma unroll
            for (int i = 0; i < 4; ++i) vr[i] = p1 + 8 * i + (lane >> 3);
            att_load_k(kf, pb + P_KW, PW, p1 + c, p1 + 16 + c, g); att_load_v(vf, pb + P_VW, PW, vr, lane); }
#pragma unroll
        for (int gi = 0; gi < 2; ++gi) d0[gi] = tq[gi] - 32 * u - 4 * g;
        att_unit<2>(kc, vl, qf, st, d0, c1, dmax, 1, lane);
    }
#pragma unroll
    for (int gi = 0; gi < 2; ++gi) { att_finish(st[gi]);
        att_store_bf16(ow + (size_t)(b * SQ + tq[gi]) * 256 + 64 * h + 4 * g, st[gi]); }
}

__device__ __forceinline__ void nsa_sel_job(int job, int lane, LAS unsigned char* vl, const bf16* __restrict__ proj, const unsigned long long* __restrict__ sel, bf16* __restrict__ os) {
    const int b = job / (SQ / 8), t0 = (job % (SQ / 8)) * 8, g = lane >> 4, c = lane & 15, qi = c >> 2, h = c & 3;
    const bf16* pb = proj + (size_t)b * SQ * PW;
    const unsigned long long mk = sel[(size_t)b * SQ + t0 + (lane & 7)];
    const unsigned mlo = (unsigned)mk, mhi = (unsigned)(mk >> 32);
    unsigned ulo = 0u, uhi = 0u;
#pragma unroll
    for (int k = 0; k < 8; ++k) { ulo |= (unsigned)__shfl((int)mlo, k); uhi |= (unsigned)__shfl((int)mhi, k); }
    ulo = __builtin_amdgcn_readfirstlane(ulo); uhi = __builtin_amdgcn_readfirstlane(uhi);
    const int cur = t0 >> 6;
    unsigned long long rem = ((unsigned long long)uhi << 32) | ulo;
    if (cur < 63) rem &= ((2ull << cur) - 1ull);
    bf16x8 qf[2][2]; AttSt st[2]; int tq[2], dmax[2], d0[2]; float c1[2]; unsigned long long mq[2];
#pragma unroll
    for (int gi = 0; gi < 2; ++gi) { tq[gi] = t0 + 4 * gi + qi; att_load_q(qf[gi], pb + (size_t)tq[gi] * PW + P_NQ + 64 * h, g); att_init(st[gi]);
        c1[gi] = exp2f(-(2.0f * h + 1.0f)) * 1.4426950408889634f; dmax[gi] = tq[gi];
        mq[gi] = ((unsigned long long)(unsigned)__shfl((int)mhi, 4 * gi + qi) << 32) | (unsigned)__shfl((int)mlo, 4 * gi + qi); }
    int j = __builtin_ctzll(rem), hf = 0;
    bf16x8 kf[2][2]; v4u vf[4]; int vr[4];
    {   const int p0 = 64 * j;
#pragma unroll
        for (int i = 0; i < 4; ++i) vr[i] = p0 + 8 * i + (lane >> 3);
        att_load_k(kf, pb + P_KS, PW, p0 + c, p0 + 16 + c, g); att_load_v(vf, pb + P_VS, PW, vr, lane); }
    for (;;) {
        bf16x8 kc[2][2];
#pragma unroll
        for (int a = 0; a < 2; ++a)
#pragma unroll
            for (int k = 0; k < 2; ++k) kc[a][k] = kf[a][k];
        att_store_v(vl, vf, lane);
        int nj = j, nhf = hf + 1; bool has = true;
        if (nhf == 2) { rem &= rem - 1ull; if (rem == 0ull) has = false; else { nj = __builtin_ctzll(rem); nhf = 0; } }
        if (has) { const int p1 = 64 * nj + 32 * nhf;
#pragma unroll
            for (int i = 0; i < 4; ++i) vr[i] = p1 + 8 * i + (lane >> 3);
            att_load_k(kf, pb + P_KS, PW, p1 + c, p1 + 16 + c, g); att_load_v(vf, pb + P_VS, PW, vr, lane); }
#pragma unroll
        for (int gi = 0; gi < 2; ++gi) d0[gi] = ((mq[gi] >> j) & 1ull) ? (tq[gi] - (64 * j + 32 * hf) - 4 * g) : -1000000;
        att_unit<2>(kc, vl, qf, st, d0, c1, dmax, 1, lane);
        if (!has) break;
        j = nj; hf = nhf;
    }
#pragma unroll
    for (int gi = 0; gi < 2; ++gi) { att_finish(st[gi]);
        att_store_bf16(os + (size_t)(b * SQ + tq[gi]) * 256 + 64 * h + 4 * g, st[gi]); }
}

__device__ __forceinline__ void dil_job(int job, int lane, LAS unsigned char* vl, const bf16* __restrict__ proj, bf16* __restrict__ mixraw, const float* __restrict__ do1, const float* __restrict__ dl1) {
    const int r = job & 15, blk = (job >> 4) & 15, h = (job >> 8) & 3, b = job >> 10, g = lane >> 4, c = lane & 15;
    const int tb = 256 * blk + r;
    const bf16* pb = proj + (size_t)b * SQ * PW;
    bf16x8 qf[1][2]; AttSt st[1]; int dmax[1], d0[1]; float c1[1];
    const int tq = tb + 16 * c;
    att_load_q(qf[0], pb + (size_t)tq * PW + P_DQ + 64 * h, g); att_init(st[0]);
    c1[0] = exp2f(-2.0f * (h + 1)) * 1.4426950408889634f;
    const bf16* kb = pb + P_DK + 64 * h; const bf16* vb = pb + P_DV + 64 * h;
#pragma unroll 1
    for (int p = 0; p < 2; ++p) {
        const int dil = (p == 0) ? 16 : 4, win = (p == 0) ? 2048 : 512, nun = (p == 0) ? 5 : 6;
        const int pstart = tb - win;
        dmax[0] = tq < win ? tq : win;
        bf16x8 kf[2][2]; v4u vf[4]; int vr[4];
#define DIL_ROW(n) ({ int _p = pstart + dil * (n); _p = _p < 0 ? 0 : _p; _p > SQ - 1 ? SQ - 1 : _p; })
        {
#pragma unroll
            for (int i = 0; i < 4; ++i) vr[i] = DIL_ROW(8 * i + (lane >> 3));
            att_load_k(kf, kb, PW, DIL_ROW(c), DIL_ROW(16 + c), g); att_load_v(vf, vb, PW, vr, lane); }
        for (int u = 0; u < nun; ++u) {
            bf16x8 kc[2][2];
#pragma unroll
            for (int a = 0; a < 2; ++a)
#pragma unroll
                for (int k = 0; k < 2; ++k) kc[a][k] = kf[a][k];
            att_store_v(vl, vf, lane);
            if (u + 1 < nun) { const int n1 = 32 * (u + 1);
#pragma unroll
                for (int i = 0; i < 4; ++i) vr[i] = DIL_ROW(n1 + 8 * i + (lane >> 3));
                att_load_k(kf, kb, PW, DIL_ROW(n1 + c), DIL_ROW(n1 + 16 + c), g); att_load_v(vf, vb, PW, vr, lane); }
            d0[0] = tq - (pstart + dil * (32 * u + 4 * g));
            att_unit<1>(kc, vl, qf, st, d0, c1, dmax, dil, lane);
        }
#undef DIL_ROW
    }
    {   const float* op = do1 + (size_t)(b * SQ + tq) * 256 + 64 * h + 4 * g;
        f32x4 p1[4];
#pragma unroll
        for (int db = 0; db < 4; ++db) p1[db] = *(const f32x4*)(op + 16 * db);
        float l = st[0].l; l += __shfl_xor(l, 16); l += __shfl_xor(l, 32); l += dl1[(size_t)(b * SQ + tq) * 4 + h];
        const float il = 1.0f / l;
#pragma unroll
        for (int db = 0; db < 4; ++db) st[0].o[db] = (st[0].o[db] + p1[db]) * il; }
    att_store_bf16(mixraw + (size_t)(b * SQ + tq) * 1024 + 64 * h + 4 * g, st[0]);
}


__device__ __forceinline__ void dil_p1_job(int job, int lane, LAS unsigned char* vl, const bf16* __restrict__ proj, float* __restrict__ do1, float* __restrict__ dl1) {
    const int qb = job & 127, h = (job >> 7) & 3, b = job >> 9, g = lane >> 4, c = lane & 15, t0 = 32 * qb;
    const bf16* pb = proj + (size_t)b * SQ * PW; const bf16* kb = pb + P_DK + 64 * h; const bf16* vb = pb + P_DV + 64 * h;
    bf16x8 qf[2][2]; AttSt st[2]; int tq[2], dmax[2], d0[2]; float c1[2];
#pragma unroll
    for (int gi = 0; gi < 2; ++gi) { tq[gi] = t0 + 16 * gi + c; att_load_q(qf[gi], pb + (size_t)tq[gi] * PW + P_DQ + 64 * h, g); att_init(st[gi]);
        c1[gi] = exp2f(-2.0f * (h + 1)) * 1.4426950408889634f; dmax[gi] = tq[gi] < 128 ? tq[gi] : 128; }
    const int u0 = (t0 - 128) > 0 ? ((t0 - 128) >> 5) : 0, u1 = (t0 + 31) >> 5;
    bf16x8 kf[2][2]; v4u vf[4]; int vr[4];
    {   const int p0 = 32 * u0;
#pragma unroll
        for (int i = 0; i < 4; ++i) vr[i] = p0 + 8 * i + (lane >> 3);
        att_load_k(kf, kb, PW, p0 + c, p0 + 16 + c, g); att_load_v(vf, vb, PW, vr, lane); }
    for (int u = u0; u <= u1; ++u) {
        bf16x8 kc[2][2];
#pragma unroll
        for (int a = 0; a < 2; ++a)
#pragma unroll
            for (int k = 0; k < 2; ++k) kc[a][k] = kf[a][k];
        att_store_v(vl, vf, lane);
        if (u < u1) { const int p1 = 32 * (u + 1);
#pragma unroll
            for (int i = 0; i < 4; ++i) vr[i] = p1 + 8 * i + (lane >> 3);
            att_load_k(kf, kb, PW, p1 + c, p1 + 16 + c, g); att_load_v(vf, vb, PW, vr, lane); }
#pragma unroll
        for (int gi = 0; gi < 2; ++gi) d0[gi] = tq[gi] - 32 * u - 4 * g;
        att_unit<2>(kc, vl, qf, st, d0, c1, dmax, 1, lane);
    }
#pragma unroll
    for (int gi = 0; gi < 2; ++gi) { float l = st[gi].l; l += __shfl_xor(l, 16); l += __shfl_xor(l, 32);
        float* op = do1 + (size_t)(b * SQ + tq[gi]) * 256 + 64 * h + 4 * g;
#pragma unroll
        for (int db = 0; db < 4; ++db) *(f32x4*)(op + 16 * db) = st[gi].o[db];
        if (g == 0) dl1[(size_t)(b * SQ + tq[gi]) * 4 + h] = l; }
}

__device__ __forceinline__ void cmp_second_job(int jw, int lane, const bf16* __restrict__ chid, const bf16* __restrict__ w2t  , const float* __restrict__ gk, bf16* __restrict__ KCb, bf16* __restrict__ VCb) {
    const int i16 = lane & 15, g4 = lane >> 4, which = jw >> 7;
    const bf16* hp = chid + (size_t)(16 * jw + i16) * 256 + 8 * g4; const bf16* wp = w2t + (size_t)which * 64 * 256 + (size_t)i16 * 256 + 8 * g4;
    f32x4 acc[4] = {{0.f, 0.f, 0.f, 0.f}, {0.f, 0.f, 0.f, 0.f}, {0.f, 0.f, 0.f, 0.f}, {0.f, 0.f, 0.f, 0.f}};
#pragma unroll
    for (int ks = 0; ks < 8; ++ks) { const bf16x8 af = *(const bf16x8*)(hp + 32 * ks);
#pragma unroll
        for (int cb = 0; cb < 4; ++cb) { const bf16x8 bfg = *(const bf16x8*)(wp + (size_t)cb * 16 * 256 + 32 * ks); acc[cb] = __builtin_amdgcn_mfma_f32_16x16x32_bf16(af, bfg, acc[cb], 0, 0, 0); } }
    bf16* dst = which ? VCb : KCb;
#pragma unroll
    for (int r = 0; r < 4; ++r) {
        const int R = (16 * jw + 4 * g4 + r) & 2047;
        float v[4] = {acc[0][r], acc[1][r], acc[2][r], acc[3][r]};
        if (which == 0) { float ss = (v[0] * v[0] + v[1] * v[1]) + (v[2] * v[2] + v[3] * v[3]);
            ss += dpp_lane<0xB1>(ss); ss += dpp_lane<0x4E>(ss); ss += dpp_lane<0x141>(ss); ss += dpp_lane<0x140>(ss);
            const float rs = rsqrtf(ss * (1.0f / 64.0f) + 1e-6f);
#pragma unroll
            for (int cb = 0; cb < 4; ++cb) v[cb] *= rs * gk[16 * cb + i16]; }
        if (R < NB * NCMP) { const int b = R / NCMP, c = R - b * NCMP;
#pragma unroll
            for (int cb = 0; cb < 4; ++cb) dst[((size_t)b * 256 + c) * 64 + 16 * cb + i16] = (bf16)f2bf(v[cb]); }
        else { const int b = R - NB * NCMP;
#pragma unroll
            for (int cb = 0; cb < 4; ++cb) dst[((size_t)b * 256 + 255) * 64 + 16 * cb + i16] = 0; }
    }
}

__device__ __forceinline__ void cmp_second(int row, int lane, const bf16* __restrict__ chid, const float* __restrict__ w2  , const float* __restrict__ gk, bf16* __restrict__ KCb, bf16* __restrict__ VCb) {
    const int which = row >> 11, R = row & 2047;
    if (R >= NB * NCMP) { if (R < NB * NCMP + NB) { const int b = R - NB * NCMP; (which ? VCb : KCb)[((size_t)b * 256 + 255) * 64 + lane] = 0; } return; }
    const int b = R / NCMP, c = R - b * NCMP;
    const bf16* hp = chid + (size_t)row * 256; const float* wp = w2 + (size_t)which * 256 * 64 + lane;
    float o = 0.f;
#pragma unroll 4
    for (int j8 = 0; j8 < 32; ++j8) { const v4u hv = *(const v4u*)(hp + 8 * j8); const float* w = wp + j8 * 8 * 64;
        o += bflo(hv.x) * w[0] + bfhi(hv.x) * w[64] + bflo(hv.y) * w[128] + bfhi(hv.y) * w[192] + bflo(hv.z) * w[256] + bfhi(hv.z) * w[320] + bflo(hv.w) * w[384] + bfhi(hv.w) * w[448]; }
    if (which == 0) { const float ss = wave_sum(o * o); o = o * rsqrtf(ss * (1.0f / 64.0f) + 1e-6f) * gk[lane]; KCb[((size_t)b * 256 + c) * 64 + lane] = (bf16)f2bf(o); }
    else VCb[((size_t)b * 256 + c) * 64 + lane] = (bf16)f2bf(o);
}

__device__ __forceinline__ void nsa_cmp_job(int job, int lane, LAS unsigned char* vl, const bf16* __restrict__ proj, const bf16* __restrict__ KCb, const bf16* __restrict__ VCb,
                                            bf16* __restrict__ ocmp, int ldoc, unsigned long long* __restrict__ sel) {
    const int b = job / (SQ / 8), t0 = (job % (SQ / 8)) * 8, g = lane >> 4, c = lane & 15, qi = c >> 2, h = c & 3;
    const bf16* pb = proj + (size_t)b * SQ * PW; const bf16* kb = KCb + (size_t)b * 256 * 64; const bf16* vb = VCb + (size_t)b * 256 * 64;
    LAS float* impA = (LAS float*)(vl + 8192); LAS float* impB = impA + 8 * 64;
    bf16x8 qf[2][2]; AttSt st[2]; int tq[2], dmax[2], d0[2]; float c1[2];
#pragma unroll
    for (int gi = 0; gi < 2; ++gi) { tq[gi] = t0 + 4 * gi + qi; att_load_q(qf[gi], pb + (size_t)tq[gi] * PW + P_NQ + 64 * h, g); att_init(st[gi]);
        c1[gi] = exp2f(-(2.0f * h + 1.0f)) * 1.4426950408889634f; dmax[gi] = 1 << 20; }
    const int nun = (t0 + 7 >= 31) ? ((((t0 + 7 - 31) >> 4) >> 5) + 1) : 0;
    for (int i = lane; i < 2 * 8 * 64; i += 64) impA[i] = 0.f;
    int vr[4];
    for (int u = 0; u < nun; ++u) {
        bf16x8 kf[2][2]; v4u vf[4];
#pragma unroll
        for (int i = 0; i < 4; ++i) vr[i] = 32 * u + 8 * i + (lane >> 3);
        att_load_k(kf, kb, 64, 32 * u + c, 32 * u + 16 + c, g); att_load_v(vf, vb, 64, vr, lane);
        att_store_v(vl, vf, lane);
#pragma unroll
        for (int gi = 0; gi < 2; ++gi) d0[gi] = tq[gi] - 31 - 16 * (32 * u + 4 * g);
        att_unit<2>(kf, vl, qf, st, d0, c1, dmax, 16, lane);
    }
    float il[2];
#pragma unroll
    for (int gi = 0; gi < 2; ++gi) { float l = st[gi].l; l += __shfl_xor(l, 16); l += __shfl_xor(l, 32); il[gi] = l > 0.f ? 1.0f / l : 0.f;
        bf16* op = ocmp + (size_t)(b * SQ + tq[gi]) * ldoc + 64 * h + 4 * g;
#pragma unroll
        for (int db = 0; db < 4; ++db) { const f32x4 t = st[gi].o[db] * il[gi]; v2u w; w.x = pk2(t[0], t[1]); w.y = pk2(t[2], t[3]); *(v2u*)(op + 16 * db) = w; } }
    bf16x8 kn[2][2];
    if (nun > 0) att_load_k(kn, kb, 64, c, 16 + c, g);
    for (int u = 0; u < nun; ++u) {
        bf16x8 kf[2][2];
#pragma unroll
        for (int a_ = 0; a_ < 2; ++a_) { kf[a_][0] = kn[a_][0]; kf[a_][1] = kn[a_][1]; }
        if (u + 1 < nun) att_load_k(kn, kb, 64, 32 * (u + 1) + c, 32 * (u + 1) + 16 + c, g);
#pragma unroll
        for (int gi = 0; gi < 2; ++gi) {
            f32x4 s0 = {0.f, 0.f, 0.f, 0.f}, s1 = {0.f, 0.f, 0.f, 0.f};
            s0 = __builtin_amdgcn_mfma_f32_16x16x32_bf16(kf[0][0], qf[gi][0], s0, 0, 0, 0); s0 = __builtin_amdgcn_mfma_f32_16x16x32_bf16(kf[0][1], qf[gi][1], s0, 0, 0, 0);
            s1 = __builtin_amdgcn_mfma_f32_16x16x32_bf16(kf[1][0], qf[gi][0], s1, 0, 0, 0); s1 = __builtin_amdgcn_mfma_f32_16x16x32_bf16(kf[1][1], qf[gi][1], s1, 0, 0, 0);
            const int dd = tq[gi] - 31 - 16 * (32 * u + 4 * g);
            float S4[2], P3[2];
#pragma unroll
            for (int blk = 0; blk < 2; ++blk) { float sum = 0.f, last = 0.f;
#pragma unroll
                for (int r = 0; r < 4; ++r) { const int dist = dd - 16 * (16 * blk + r); const float a = blk ? s1[r] : s0[r];
                    const float p = (dist >= 0) ? __builtin_amdgcn_exp2f(fmaf(a, ATT_SC, fmaf(-c1[gi], (float)dist, -ATT_REF))) * il[gi] : 0.f; sum += p; last = p; }
                S4[blk] = sum; P3[blk] = last; }
#pragma unroll
            for (int blk = 0; blk < 2; ++blk) { S4[blk] += dpp_xor1(S4[blk]); S4[blk] += dpp_xor2(S4[blk]); P3[blk] += dpp_xor1(P3[blk]); P3[blk] += dpp_xor2(P3[blk]); }
            if (h == 0) {
#pragma unroll
                for (int blk = 0; blk < 2; ++blk) { const int c4 = 8 * u + 4 * blk + g, q = 4 * gi + qi; impA[q * 64 + c4] = S4[blk]; if (c4 < 63) impB[q * 64 + c4 + 1] = P3[blk]; } }
        }
    }
    asm volatile("s_waitcnt lgkmcnt(0)" ::: "memory");
    LAS float* valL = impB + 8 * 64;
    const int cur = t0 >> 6, j = lane;
#pragma unroll 1
    for (int q = 0; q < 8; ++q) {
        const float imp = impA[q * 64 + j] + impB[q * 64 + j];
        const bool forced = (j == 0) || (j == cur) || (j == cur - 1);
        const float val = (j <= cur) ? (imp + (forced ? 1.0e4f : 0.f)) : -1.0e30f;
        valL[j] = val;
        asm volatile("s_waitcnt lgkmcnt(0)" ::: "memory");
        int rank = 0;
#pragma unroll
        for (int k4 = 0; k4 < 16; ++k4) { const f32x4 o = *(const LAS f32x4*)(valL + 4 * k4);
#pragma unroll
            for (int k = 0; k < 4; ++k) rank += (o[k] > val || (o[k] == val && (4 * k4 + k) < j)) ? 1 : 0; }
        const unsigned long long mask = __ballot(rank < 16);
        if (lane == 0) sel[(size_t)b * SQ + t0 + q] = mask;
        asm volatile("s_waitcnt lgkmcnt(0)" ::: "memory");
    }
}


constexpr int SEG = 64, NSEG = SQ / SEG;
typedef float f32x2 __attribute__((ext_vector_type(2)));
__device__ __forceinline__ void gla_gate_row(int row, int lane, const bf16* __restrict__ proj, const float* __restrict__ wa2, const float* __restrict__ ba, float* __restrict__ GA) {
    const bf16* pr = proj + (size_t)row * PW + P_GA;
    const v4u a0 = *(const v4u*)pr, a1 = *(const v4u*)(pr + 8);
    float gv[16] = {bflo(a0.x), bfhi(a0.x), bflo(a0.y), bfhi(a0.y), bflo(a0.z), bfhi(a0.z), bflo(a0.w), bfhi(a0.w), bflo(a1.x), bfhi(a1.x), bflo(a1.y), bfhi(a1.y), bflo(a1.z), bfhi(a1.z), bflo(a1.w), bfhi(a1.w)};
#pragma unroll
    for (int hh = 0; hh < 2; ++hh) { const int j = lane + 64 * hh; float z = ba[j];
#pragma unroll
        for (int i = 0; i < 16; ++i) z += gv[i] * wa2[i * 128 + j];
        GA[(size_t)row * 128 + j] = log_sigmoid_f(z) * (1.0f / 16.0f); }
}
constexpr int GLA_KLROWB = 80;
template <bool OUT>
__device__ __forceinline__ void gla_seg(int job, int lane, LAS unsigned char* vl, const bf16* __restrict__ proj, const float* __restrict__ GA, float* __restrict__ Sbuf, float* __restrict__ Dbuf,
                                        const float* __restrict__ ng, bf16* __restrict__ mixraw) {
    const int seg = job % NSEG, h = (job / NSEG) & 3, b = job / (NSEG * 4), g4 = lane >> 4, i16 = lane & 15;
    LAS unsigned char* kll = vl + 16 * VROWB;
    f32x4 Sr[4][2];
    float* sp = Sbuf + (size_t)job * 2048 + lane;
#pragma unroll
    for (int vb = 0; vb < 4; ++vb)
#pragma unroll
        for (int kb = 0; kb < 2; ++kb)
#pragma unroll
            for (int r = 0; r < 4; ++r) Sr[vb][kb][r] = OUT ? sp[((vb * 2 + kb) * 4 + r) * 64] : 0.f;
    float btot[8];
#pragma unroll
    for (int jj = 0; jj < 8; ++jj) btot[jj] = 0.f;
    const size_t r0 = (size_t)b * SQ + (size_t)seg * SEG;
    const LAS unsigned char* vrd = vl + (4 * g4 + (i16 >> 2)) * VROWB + (i16 & 3) * 8;
    const LAS unsigned char* klrd = kll + (4 * g4 + (i16 >> 2)) * GLA_KLROWB + (i16 & 3) * 8;
    f32x4 nla0, nla1; v2u nkw0, nkw1, nqw0 = {0u, 0u}, nqw1 = {0u, 0u}, nrr[4] = {{0u, 0u}, {0u, 0u}, {0u, 0u}, {0u, 0u}}; v4u nv0, nv1;
#define GLA_LOADCH(ch_) do { const size_t r_ = r0 + 16 * (ch_) + i16; const bf16* pr_ = proj + r_ * PW; \
        nla0 = *(const f32x4*)(GA + r_ * 128 + 32 * h + 4 * g4); nla1 = *(const f32x4*)(GA + r_ * 128 + 32 * h + 16 + 4 * g4); \
        nkw0 = *(const v2u*)(pr_ + P_GK + 32 * h + 4 * g4); nkw1 = *(const v2u*)(pr_ + P_GK + 32 * h + 16 + 4 * g4); \
        if (OUT) { nqw0 = *(const v2u*)(pr_ + P_GQ + 32 * h + 4 * g4); nqw1 = *(const v2u*)(pr_ + P_GQ + 32 * h + 16 + 4 * g4); \
            _Pragma("unroll") for (int vb_ = 0; vb_ < 4; ++vb_) nrr[vb_] = *(const v2u*)(pr_ + P_GR + 64 * h + 16 * vb_ + 4 * g4); } \
        const size_t rr_ = r0 + 16 * (ch_) + (lane >> 3); \
        nv0 = *(const v4u*)(proj + rr_ * PW + P_GV + 64 * h + 8 * (lane & 7)); nv1 = *(const v4u*)(proj + (rr_ + 8) * PW + P_GV + 64 * h + 8 * (lane & 7)); } while (0)
    GLA_LOADCH(0);
#pragma unroll 1
    for (int ch = 0; ch < SEG / 16; ++ch) {
        const size_t r = r0 + 16 * ch + i16;
        const f32x4 la0 = nla0, la1 = nla1; const v2u kw0 = nkw0, kw1 = nkw1, qw0 = nqw0, qw1 = nqw1; const v2u rrc[4] = {nrr[0], nrr[1], nrr[2], nrr[3]};
        *(LAS v4u*)(vl + (lane >> 3) * VROWB + 16 * (lane & 7)) = nv0; *(LAS v4u*)(vl + (8 + (lane >> 3)) * VROWB + 16 * (lane & 7)) = nv1;
        if (ch + 1 < SEG / 16) GLA_LOADCH(ch + 1);
        float bc[8] = {la0[0], la0[1], la0[2], la0[3], la1[0], la1[1], la1[2], la1[3]};
#pragma unroll
        for (int jj = 0; jj < 8; ++jj) bc[jj] += dpp_row_shr<1>(bc[jj]);
#pragma unroll
        for (int jj = 0; jj < 8; ++jj) bc[jj] += dpp_row_shr<2>(bc[jj]);
#pragma unroll
        for (int jj = 0; jj < 8; ++jj) bc[jj] += dpp_row_shr<4>(bc[jj]);
#pragma unroll
        for (int jj = 0; jj < 8; ++jj) bc[jj] += dpp_row_shr<8>(bc[jj]);
        const float kf[8] = {bflo(kw0.x), bfhi(kw0.x), bflo(kw0.y), bfhi(kw0.y), bflo(kw1.x), bfhi(kw1.x), bflo(kw1.y), bfhi(kw1.y)};
        float eb[8], emb[8], e15[8], b15[8];
#pragma unroll
        for (int jj = 0; jj < 8; ++jj) { b15[jj] = __shfl(bc[jj], 16 * g4 + 15); eb[jj] = __expf(bc[jj]); emb[jj] = __builtin_amdgcn_rcpf(eb[jj]); e15[jj] = __expf(b15[jj]); btot[jj] += b15[jj]; }
        {   v2u w0, w1; w0.x = pk2(kf[0] * e15[0] * emb[0], kf[1] * e15[1] * emb[1]); w0.y = pk2(kf[2] * e15[2] * emb[2], kf[3] * e15[3] * emb[3]);
            w1.x = pk2(kf[4] * e15[4] * emb[4], kf[5] * e15[5] * emb[5]); w1.y = pk2(kf[6] * e15[6] * emb[6], kf[7] * e15[7] * emb[7]);
            *(LAS v2u*)(kll + i16 * GLA_KLROWB + 8 * g4) = w0; *(LAS v2u*)(kll + i16 * GLA_KLROWB + 32 + 8 * g4) = w1; }
        asm volatile("s_waitcnt lgkmcnt(0)" ::: "memory");
        bf16x8 vt[4], klt[2];
#pragma unroll
        for (int vb = 0; vb < 4; ++vb) { const s16x4 a = lds_tr16(vrd + vb * 32); vt[vb] = (bf16x8){a[0], a[1], a[2], a[3], 0, 0, 0, 0}; }
#pragma unroll
        for (int kb = 0; kb < 2; ++kb) { const s16x4 a = lds_tr16(klrd + kb * 32); klt[kb] = (bf16x8){a[0], a[1], a[2], a[3], 0, 0, 0, 0}; }
        asm volatile("s_waitcnt lgkmcnt(0)" ::: "memory");
        if (OUT) {
            const float qf[8] = {bflo(qw0.x), bfhi(qw0.x), bflo(qw0.y), bfhi(qw0.y), bflo(qw1.x), bfhi(qw1.x), bflo(qw1.y), bfhi(qw1.y)};
            v4u qe_w, ke_w;
            qe_w.x = pk2(qf[0] * eb[0] * 0.17677669529663687f, qf[1] * eb[1] * 0.17677669529663687f); qe_w.y = pk2(qf[2] * eb[2] * 0.17677669529663687f, qf[3] * eb[3] * 0.17677669529663687f);
            qe_w.z = pk2(qf[4] * eb[4] * 0.17677669529663687f, qf[5] * eb[5] * 0.17677669529663687f); qe_w.w = pk2(qf[6] * eb[6] * 0.17677669529663687f, qf[7] * eb[7] * 0.17677669529663687f);
            ke_w.x = pk2(kf[0] * emb[0], kf[1] * emb[1]); ke_w.y = pk2(kf[2] * emb[2], kf[3] * emb[3]); ke_w.z = pk2(kf[4] * emb[4], kf[5] * emb[5]); ke_w.w = pk2(kf[6] * emb[6], kf[7] * emb[7]);
            const bf16x8 qe = __builtin_bit_cast(bf16x8, qe_w), ke = __builtin_bit_cast(bf16x8, ke_w);
            f32x4 at = {0.f, 0.f, 0.f, 0.f};
            at = __builtin_amdgcn_mfma_f32_16x16x32_bf16(ke, qe, at, 0, 0, 0);
            v4u pw; pw.x = pk2((4 * g4 + 0 <= i16) ? at[0] : 0.f, (4 * g4 + 1 <= i16) ? at[1] : 0.f); pw.y = pk2((4 * g4 + 2 <= i16) ? at[2] : 0.f, (4 * g4 + 3 <= i16) ? at[3] : 0.f); pw.z = 0u; pw.w = 0u;
            const bf16x8 pf = __builtin_bit_cast(bf16x8, pw);
            f32x4 o[4];
#pragma unroll
            for (int vb = 0; vb < 4; ++vb) {
                v4u sw; sw.x = pk2(Sr[vb][0][0], Sr[vb][0][1]); sw.y = pk2(Sr[vb][0][2], Sr[vb][0][3]); sw.z = pk2(Sr[vb][1][0], Sr[vb][1][1]); sw.w = pk2(Sr[vb][1][2], Sr[vb][1][3]);
                o[vb] = (f32x4){0.f, 0.f, 0.f, 0.f};
                o[vb] = __builtin_amdgcn_mfma_f32_16x16x32_bf16(__builtin_bit_cast(bf16x8, sw), qe, o[vb], 0, 0, 0);
                o[vb] = __builtin_amdgcn_mfma_f32_16x16x32_bf16(vt[vb], pf, o[vb], 0, 0, 0); }
            float ss = 0.f;
#pragma unroll
            for (int vb = 0; vb < 4; ++vb) ss += (o[vb][0] * o[vb][0] + o[vb][1] * o[vb][1]) + (o[vb][2] * o[vb][2] + o[vb][3] * o[vb][3]);
            ss += __shfl_xor(ss, 16); ss += __shfl_xor(ss, 32);
            const float rstd = rsqrtf(ss * (1.0f / 64.0f) + 1e-6f);
#pragma unroll
            for (int vb = 0; vb < 4; ++vb) { const f32x4 gn = *(const f32x4*)(ng + 16 * vb + 4 * g4); const v2u rr = rrc[vb];
                const float rf[4] = {bflo(rr.x), bfhi(rr.x), bflo(rr.y), bfhi(rr.y)}; float y[4];
#pragma unroll
                for (int q = 0; q < 4; ++q) y[q] = o[vb][q] * rstd * gn[q] * rf[q] * sigmoid_f(rf[q]);
                v2u w; w.x = pk2(y[0], y[1]); w.y = pk2(y[2], y[3]); *(v2u*)(mixraw + r * 1024 + 512 + 64 * h + 16 * vb + 4 * g4) = w; }
        }
#pragma unroll
        for (int vb = 0; vb < 4; ++vb)
#pragma unroll
            for (int kb = 0; kb < 2; ++kb) { f32x4 c = Sr[vb][kb];
#pragma unroll
                for (int q = 0; q < 4; ++q) c[q] *= e15[4 * kb + q];
                Sr[vb][kb] = __builtin_amdgcn_mfma_f32_16x16x32_bf16(klt[kb], vt[vb], c, 0, 0, 0); }
    }
#undef GLA_LOADCH
    if (!OUT) {
#pragma unroll
        for (int vb = 0; vb < 4; ++vb)
#pragma unroll
            for (int kb = 0; kb < 2; ++kb)
#pragma unroll
                for (int r = 0; r < 4; ++r) sp[((vb * 2 + kb) * 4 + r) * 64] = Sr[vb][kb][r];
        if (i16 == 0) {
#pragma unroll
            for (int jj = 0; jj < 8; ++jj) Dbuf[(size_t)job * 32 + ((jj < 4) ? (4 * g4 + jj) : (16 + 4 * g4 + (jj - 4)))] = __expf(btot[jj]); }
    }
}
__device__ __forceinline__ void gla_scan(int wj, int lane, float* __restrict__ Sbuf, const float* __restrict__ Dbuf) {
    const int e8 = wj & 7, kb = e8 & 1, bh = wj >> 3, g4 = lane >> 4;
    float S[4] = {0.f, 0.f, 0.f, 0.f};
    for (int s0 = 0; s0 < NSEG; s0 += 16) {
        float L[16][4]; f32x4 Dv[16];
#pragma unroll
        for (int u = 0; u < 16; ++u) { const size_t job = (size_t)bh * NSEG + s0 + u; Dv[u] = *(const f32x4*)(Dbuf + job * 32 + 16 * kb + 4 * g4);
#pragma unroll
            for (int j = 0; j < 4; ++j) L[u][j] = Sbuf[job * 2048 + (e8 * 4 + j) * 64 + lane]; }
#pragma unroll
        for (int u = 0; u < 16; ++u) { const size_t job = (size_t)bh * NSEG + s0 + u;
#pragma unroll
            for (int j = 0; j < 4; ++j) { Sbuf[job * 2048 + (e8 * 4 + j) * 64 + lane] = S[j]; S[j] = fmaf(S[j], Dv[u][j], L[u][j]); } }
    }
}

struct S5C { float abr, abi; f32x2 bb[16]; };
__device__ __forceinline__ void s5_consts(S5C& c, int g, int n, const float* __restrict__ a_re, const float* __restrict__ a_im, const float* __restrict__ b_re, const float* __restrict__ b_im, const float* __restrict__ log_dt) {
    const float dt = expf(log_dt[g]), are = a_re[g * 64 + n], aim = a_im[g * 64 + n];
    const float mag = expf(dt * are); c.abr = mag * cosf(dt * aim); c.abi = mag * sinf(dt * aim);
    const float den = are * are + aim * aim, f_re = ((c.abr - 1.0f) * are + c.abi * aim) / den, f_im = (c.abi * are - (c.abr - 1.0f) * aim) / den;
#pragma unroll
    for (int k = 0; k < 16; ++k) { const float br = b_re[(size_t)(g * 64 + n) * 16 + k], bi = b_im[(size_t)(g * 64 + n) * 16 + k]; c.bb[k] = (f32x2){f_re * br - f_im * bi, f_re * bi + f_im * br}; }
}
__device__ __forceinline__ void s5_step(const S5C& c, const v4u u0, const v4u u1, float& xr, float& xi) {
    const float uf[16] = {bflo(u0.x), bfhi(u0.x), bflo(u0.y), bfhi(u0.y), bflo(u0.z), bfhi(u0.z), bflo(u0.w), bfhi(u0.w), bflo(u1.x), bfhi(u1.x), bflo(u1.y), bfhi(u1.y), bflo(u1.z), bfhi(u1.z), bflo(u1.w), bfhi(u1.w)};
    f32x2 bu0 = {0.f, 0.f}, bu1 = {0.f, 0.f};
#pragma unroll
    for (int k = 0; k < 16; k += 2) { bu0 = __builtin_elementwise_fma(c.bb[k], (f32x2){uf[k], uf[k]}, bu0); bu1 = __builtin_elementwise_fma(c.bb[k + 1], (f32x2){uf[k + 1], uf[k + 1]}, bu1); }
    const f32x2 bu = bu0 + bu1;
    const float nr = c.abr * xr - c.abi * xi + bu.x, ni = c.abr * xi + c.abi * xr + bu.y; xr = nr; xi = ni;
}
__device__ __forceinline__ void s5_passA(int gw, int ngw, int lane, const bf16* __restrict__ proj, const float* __restrict__ a_re, const float* __restrict__ a_im, const float* __restrict__ b_re, const float* __restrict__ b_im,
                                        const float* __restrict__ log_dt, float* __restrict__ Xbuf) {
    const int g = gw & 15;
    S5C c; s5_consts(c, g, lane, a_re, a_im, b_re, b_im, log_dt);
    for (int jr = gw >> 4; jr < NB * NSEG; jr += ngw >> 4) {
    const int b = jr / NSEG, seg = jr - b * NSEG, job = (b * 16 + g) * NSEG + seg;
    float xr = 0.f, xi = 0.f;
    const bf16* up = proj + ((size_t)b * SQ + (size_t)seg * SEG) * PW + P_SU + 16 * g;
#define S5_LOADB(U_, tb_) do { _Pragma("unroll") for (int i_ = 0; i_ < 4; ++i_) { const bf16* q_ = up + (size_t)((tb_) + i_) * PW; U_[i_][0] = *(const v4u*)q_; U_[i_][1] = *(const v4u*)(q_ + 8); } } while (0)
    v4u Ua[4][2], Ub[4][2];
    S5_LOADB(Ua, 0);
    for (int t0 = 0; t0 < SEG; t0 += 8) {
        S5_LOADB(Ub, t0 + 4);
#pragma unroll
        for (int i = 0; i < 4; ++i) s5_step(c, Ua[i][0], Ua[i][1], xr, xi);
        if (t0 + 8 < SEG) S5_LOADB(Ua, t0 + 8);
#pragma unroll
        for (int i = 0; i < 4; ++i) s5_step(c, Ub[i][0], Ub[i][1], xr, xi);
    }
    Xbuf[(size_t)job * 128 + lane] = xr; Xbuf[(size_t)job * 128 + 64 + lane] = xi;
    }
}
__device__ __forceinline__ void s5_scan(int bg, int lane, const float* __restrict__ a_re, const float* __restrict__ a_im, const float* __restrict__ log_dt, float* __restrict__ Xbuf) {
    const int g = bg & 15;
    const float dt = expf(log_dt[g]) * (float)SEG, are = a_re[g * 64 + lane], aim = a_im[g * 64 + lane];
    const float mag = expf(dt * are), pr = mag * cosf(dt * aim), pi = mag * sinf(dt * aim);
    float xr = 0.f, xi = 0.f;
    for (int s0 = 0; s0 < NSEG; s0 += 32) {
        float lr[32], li[32];
#pragma unroll
        for (int u = 0; u < 32; ++u) { const size_t job = (size_t)bg * NSEG + s0 + u; lr[u] = Xbuf[job * 128 + lane]; li[u] = Xbuf[job * 128 + 64 + lane]; }
#pragma unroll
        for (int u = 0; u < 32; ++u) { const size_t job = (size_t)bg * NSEG + s0 + u; Xbuf[job * 128 + lane] = xr; Xbuf[job * 128 + 64 + lane] = xi;
            const float nr = pr * xr - pi * xi + lr[u], ni = pr * xi + pi * xr + li[u]; xr = nr; xi = ni; }
    }
}
constexpr int S5_XROWB = 272;
struct S5O { bf16x8 cf[4]; float dco; };
__device__ __forceinline__ void s5_oconsts(S5O& o, int g, int lane, const float* __restrict__ c_re, const float* __restrict__ c_im, const float* __restrict__ dvec) {
    const int cc = lane & 15, g4 = lane >> 4;
#pragma unroll
    for (int ks = 0; ks < 4; ++ks) { v4u w;
        const int n0 = (32 * ks + 8 * g4) >> 1; const float* cr = c_re + (size_t)(g * 16 + cc) * 64 + n0; const float* ci = c_im + (size_t)(g * 16 + cc) * 64 + n0;
        w.x = pk2(cr[0], -ci[0]); w.y = pk2(cr[1], -ci[1]); w.z = pk2(cr[2], -ci[2]); w.w = pk2(cr[3], -ci[3]); o.cf[ks] = __builtin_bit_cast(bf16x8, w); }
    o.dco = dvec[g * 16 + cc];
}
__device__ __forceinline__ void s5_passC(int gw, int ngw, int lane, LAS unsigned char* xl, const bf16* __restrict__ proj, const float* __restrict__ a_re, const float* __restrict__ a_im, const float* __restrict__ b_re, const float* __restrict__ b_im,
                                        const float* __restrict__ c_re, const float* __restrict__ c_im, const float* __restrict__ dvec, const float* __restrict__ log_dt, const float* __restrict__ Xbuf, bf16* __restrict__ hg) {
    const int g = gw & 15, cc = lane & 15, g4 = lane >> 4;
    S5C c; s5_consts(c, g, lane, a_re, a_im, b_re, b_im, log_dt);
    S5O oc; s5_oconsts(oc, g, lane, c_re, c_im, dvec);
    for (int jr = gw >> 4; jr < NB * NSEG; jr += ngw >> 4) {
    const int b = jr / NSEG, seg = jr - b * NSEG, job = (b * 16 + g) * NSEG + seg;
    float xr = Xbuf[(size_t)job * 128 + lane], xi = Xbuf[(size_t)job * 128 + 64 + lane];
    const size_t r0 = (size_t)b * SQ + (size_t)seg * SEG;
    const bf16* up = proj + r0 * PW + P_SU + 16 * g;
    v4u Ua[4][2], Ub[4][2];
    S5_LOADB(Ua, 0);
    for (int t0 = 0; t0 < SEG; t0 += 16) {
        float uv[4];
#pragma unroll
        for (int q = 0; q < 4; ++q) uv[q] = bf2f(proj[(r0 + t0 + 4 * g4 + q) * PW + P_SU + 16 * g + cc]);
#pragma unroll
        for (int hb = 0; hb < 2; ++hb) {
            S5_LOADB(Ub, t0 + 8 * hb + 4);
#pragma unroll
            for (int i = 0; i < 4; ++i) { s5_step(c, Ua[i][0], Ua[i][1], xr, xi); *(LAS unsigned*)(xl + (8 * hb + i) * S5_XROWB + 4 * lane) = pk2(xr, xi); }
            if (t0 + 8 * hb + 8 < SEG) S5_LOADB(Ua, t0 + 8 * hb + 8);
#pragma unroll
            for (int i = 0; i < 4; ++i) { s5_step(c, Ub[i][0], Ub[i][1], xr, xi); *(LAS unsigned*)(xl + (8 * hb + 4 + i) * S5_XROWB + 4 * lane) = pk2(xr, xi); }
        }
        asm volatile("s_waitcnt lgkmcnt(0)" ::: "memory");
        f32x4 acc = {0.f, 0.f, 0.f, 0.f};
#pragma unroll
        for (int ks = 0; ks < 4; ++ks) { const bf16x8 xa = *(const LAS bf16x8*)(xl + cc * S5_XROWB + (32 * ks + 8 * g4) * 2);
            acc = __builtin_amdgcn_mfma_f32_16x16x32_bf16(xa, oc.cf[ks], acc, 0, 0, 0); }
        asm volatile("s_waitcnt lgkmcnt(0)" ::: "memory");
#pragma unroll
        for (int q = 0; q < 4; ++q) { const size_t r = r0 + t0 + 4 * g4 + q;
            hg[r * 256 + 16 * g + cc] = (bf16)f2bf(gelu_tanh(acc[q] + oc.dco * uv[q])); }
    }
    }
}

__device__ __forceinline__ void s5_table_item(int item, int p, const float* __restrict__ a_re, const float* __restrict__ a_im, const float* __restrict__ b_re, const float* __restrict__ b_im,
                                              const float* __restrict__ log_dt, f32x2* __restrict__ tab) {
    const int g = item >> 6;
    const float dt = expf(log_dt[g]), are = a_re[item], aim = a_im[item];
    const float lm = dt * are, th = dt * aim;
    f32x2* t = tab + (size_t)item * 48;
    {   const float mn = expf(-(float)p * lm), mp = expf((float)p * lm), cs = cosf((float)p * th), sn = sinf((float)p * th);
        t[p] = (f32x2){mn * cs, -mn * sn}; t[16 + p] = (f32x2){mp * cs, mp * sn}; }
    const float mag = expf(lm), abr = mag * cosf(th), abi = mag * sinf(th);
    const float den = are * are + aim * aim, f_re = ((abr - 1.0f) * are + abi * aim) / den, f_im = (abi * are - (abr - 1.0f) * aim) / den;
    {   const int k = p; const float br = b_re[(size_t)item * 16 + k], bi = b_im[(size_t)item * 16 + k]; t[32 + k] = (f32x2){f_re * br - f_im * bi, f_re * bi + f_im * br}; }
}
template <bool OUT>
__device__ __forceinline__ void s5_mfma_pass(int gw, int ngw, int lane, LAS unsigned char* xl, const bf16* __restrict__ proj, const f32x2* __restrict__ tabl  ,
                                             const float* __restrict__ c_re, const float* __restrict__ c_im, const float* __restrict__ dvec, float* __restrict__ Xbuf, bf16* __restrict__ hg) {
    const int g = gw & 15, i16 = lane & 15, g4 = lane >> 4;
    const f32x2* tg = tabl + (size_t)g * 64 * 48;
    LAS float* xs = (LAS float*)xl;
    LAS unsigned char* bml = xl + 512;
    f32x2 AM[4][4], AT[4][4], A1[4];
#pragma unroll
    for (int rb = 0; rb < 4; ++rb) { A1[rb] = tg[(size_t)(16 * rb + i16) * 48 + 16 + 1];
#pragma unroll
        for (int r = 0; r < 4; ++r) { AM[rb][r] = tg[(size_t)(16 * rb + i16) * 48 + (4 * g4 + r)]; AT[rb][r] = tg[(size_t)(16 * rb + 4 * g4 + r) * 48 + 16 + i16]; } }
#pragma unroll
    for (int rb8 = 0; rb8 < 8; ++rb8) { v4u w = {0u, 0u, 0u, 0u};
        if (g4 < 2) { const f32x2* bp = tg + (size_t)(16 * (rb8 & 3) + i16) * 48 + 32 + 8 * g4; const int im = rb8 >> 2;
            w.x = pk2(bp[0][im], bp[1][im]); w.y = pk2(bp[2][im], bp[3][im]); w.z = pk2(bp[4][im], bp[5][im]); w.w = pk2(bp[6][im], bp[7][im]); }
        *(LAS v4u*)(bml + (rb8 * 64 + lane) * 16) = w; }
    v4u lfw;
    {   const unsigned one = 0x3f80u; unsigned e[4];
#pragma unroll
        for (int jj = 0; jj < 4; ++jj) e[jj] = (4 * g4 + jj <= i16) ? one : 0u;
        lfw.x = e[0] | (e[1] << 16); lfw.y = e[2] | (e[3] << 16); lfw.z = (g4 == 0) ? one : 0u; lfw.w = 0u; }
    const bf16x8 Lf = __builtin_bit_cast(bf16x8, lfw);
    bf16x8 Cm[4]; f32x4 dco4 = {0.f, 0.f, 0.f, 0.f};
    if (OUT) {
#pragma unroll
        for (int ks = 0; ks < 4; ++ks) { float cv[8];
#pragma unroll
            for (int jj = 0; jj < 8; ++jj) { const int np = 16 * (2 * ks + (jj >> 2)) + 4 * g4 + (jj & 3);
                cv[jj] = (np < 64) ? c_re[(size_t)(g * 16 + i16) * 64 + np] : -c_im[(size_t)(g * 16 + i16) * 64 + (np - 64)]; }
            v4u w; w.x = pk2(cv[0], cv[1]); w.y = pk2(cv[2], cv[3]); w.z = pk2(cv[4], cv[5]); w.w = pk2(cv[6], cv[7]); Cm[ks] = __builtin_bit_cast(bf16x8, w); }
        dco4 = *(const f32x4*)(dvec + g * 16 + 4 * g4);
    }
    asm volatile("s_waitcnt lgkmcnt(0)" ::: "memory");
    for (int jr = gw >> 4; jr < NB * NSEG; jr += ngw >> 4) {
        const int b = jr / NSEG, seg = jr - b * NSEG, job = (b * 16 + g) * NSEG + seg;
        const size_t r0 = (size_t)b * SQ + (size_t)seg * SEG;
        float xinr[4], xini[4];
#pragma unroll
        for (int rb = 0; rb < 4; ++rb) { xinr[rb] = OUT ? Xbuf[(size_t)job * 128 + 16 * rb + i16] : 0.f; xini[rb] = OUT ? Xbuf[(size_t)job * 128 + 64 + 16 * rb + i16] : 0.f; }
        f32x4 xr[4], xi[4];
        v4u nuw; v2u nue = {0u, 0u};
        {   const bf16* pr0 = proj + (r0 + i16) * PW + P_SU + 16 * g; nuw = *(const v4u*)(pr0 + 8 * (g4 & 1)); if (OUT) nue = *(const v2u*)(pr0 + 4 * g4); }
#pragma unroll 1
        for (int ch = 0; ch < SEG / 16; ++ch) {
            const v4u uw = nuw; const v2u ue = nue;
            if (ch + 1 < SEG / 16) { const bf16* pr1 = proj + (r0 + 16 * (ch + 1) + i16) * PW + P_SU + 16 * g; nuw = *(const v4u*)(pr1 + 8 * (g4 & 1)); if (OUT) nue = *(const v2u*)(pr1 + 4 * g4); }
            const bf16x8 uf = __builtin_bit_cast(bf16x8, uw);
            f32x4 bu[8];
#pragma unroll
            for (int rb8 = 0; rb8 < 8; ++rb8) { const bf16x8 bm = *(const LAS bf16x8*)(bml + (rb8 * 64 + lane) * 16);
                bu[rb8] = (f32x4){0.f, 0.f, 0.f, 0.f}; bu[rb8] = __builtin_amdgcn_mfma_f32_16x16x32_bf16(uf, bm, bu[rb8], 0, 0, 0); }
            v4u fz[8];
#pragma unroll
            for (int rb = 0; rb < 4; ++rb) { float zr[4], zi[4];
#pragma unroll
                for (int r = 0; r < 4; ++r) { zr[r] = bu[rb][r] * AM[rb][r].x - bu[rb + 4][r] * AM[rb][r].y; zi[r] = bu[rb][r] * AM[rb][r].y + bu[rb + 4][r] * AM[rb][r].x; }
                const float wr = A1[rb].x * xinr[rb] - A1[rb].y * xini[rb], wi = A1[rb].x * xini[rb] + A1[rb].y * xinr[rb];
                fz[rb].x = pk2(zr[0], zr[1]); fz[rb].y = pk2(zr[2], zr[3]); fz[rb].z = pk2(wr, 0.f); fz[rb].w = 0u;
                fz[rb + 4].x = pk2(zi[0], zi[1]); fz[rb + 4].y = pk2(zi[2], zi[3]); fz[rb + 4].z = pk2(wi, 0.f); fz[rb + 4].w = 0u; }
            f32x4 P[8];
#pragma unroll
            for (int rb8 = 0; rb8 < 8; ++rb8) { P[rb8] = (f32x4){0.f, 0.f, 0.f, 0.f}; P[rb8] = __builtin_amdgcn_mfma_f32_16x16x32_bf16(__builtin_bit_cast(bf16x8, fz[rb8]), Lf, P[rb8], 0, 0, 0); }
#pragma unroll
            for (int rb = 0; rb < 4; ++rb)
#pragma unroll
                for (int r = 0; r < 4; ++r) { xr[rb][r] = P[rb][r] * AT[rb][r].x - P[rb + 4][r] * AT[rb][r].y; xi[rb][r] = P[rb][r] * AT[rb][r].y + P[rb + 4][r] * AT[rb][r].x; }
            f32x4 y = {0.f, 0.f, 0.f, 0.f};
            if (OUT) {
#pragma unroll
                for (int ks = 0; ks < 4; ++ks) { const f32x4 lo = (ks < 2) ? xr[2 * ks] : xi[2 * ks - 4], hi = (ks < 2) ? xr[2 * ks + 1] : xi[2 * ks - 3];
                    v4u w; w.x = pk2(lo[0], lo[1]); w.y = pk2(lo[2], lo[3]); w.z = pk2(hi[0], hi[1]); w.w = pk2(hi[2], hi[3]);
                    y = __builtin_amdgcn_mfma_f32_16x16x32_bf16(Cm[ks], __builtin_bit_cast(bf16x8, w), y, 0, 0, 0); }
            }
            if (i16 == 15) {
#pragma unroll
                for (int rb = 0; rb < 4; ++rb) { *(LAS f32x4*)(xs + 16 * rb + 4 * g4) = xr[rb]; *(LAS f32x4*)(xs + 64 + 16 * rb + 4 * g4) = xi[rb]; } }
            asm volatile("s_waitcnt lgkmcnt(0)" ::: "memory");
#pragma unroll
            for (int rb = 0; rb < 4; ++rb) { xinr[rb] = xs[16 * rb + i16]; xini[rb] = xs[64 + 16 * rb + i16]; }
            asm volatile("s_waitcnt lgkmcnt(0)" ::: "memory");
            if (OUT) {
                const float uv[4] = {bflo(ue.x), bfhi(ue.x), bflo(ue.y), bfhi(ue.y)};
                v2u o; o.x = pk2(gelu_tanh(y[0] + dco4[0] * uv[0]), gelu_tanh(y[1] + dco4[1] * uv[1])); o.y = pk2(gelu_tanh(y[2] + dco4[2] * uv[2]), gelu_tanh(y[3] + dco4[3] * uv[3]));
                *(v2u*)(hg + (r0 + 16 * ch + i16) * 256 + 16 * g + 4 * g4) = o;
            }
        }
        if (!OUT && i16 == 15) {
#pragma unroll
            for (int rb = 0; rb < 4; ++rb) { *(f32x4*)(Xbuf + (size_t)job * 128 + 16 * rb + 4 * g4) = xr[rb]; *(f32x4*)(Xbuf + (size_t)job * 128 + 64 + 16 * rb + 4 * g4) = xi[rb]; } }
    }
}

__device__ __forceinline__ void headnorm8(int row0, int lane, bf16* __restrict__ proj, const float* __restrict__ dil_g  , const float* __restrict__ nsa_g  ) {
    bf16* pr = proj + (size_t)(row0 + (lane >> 3)) * PW + 8 * (lane & 7);
#pragma unroll
    for (int i = 0; i < 14; ++i) {
        const int off = (i < 4) ? (P_DQ + 64 * i) : (i < 8) ? (P_DK + 64 * (i - 4)) : (i < 12) ? (P_NQ + 64 * (i - 8)) : (i == 12) ? P_KS : P_KW;
        const float* gp = ((i < 4) ? dil_g : (i < 8) ? (dil_g + 64) : (i < 12) ? nsa_g : (i == 12) ? (nsa_g + 128) : (nsa_g + 192)) + 8 * (lane & 7);
        const v4u w = *(const v4u*)(pr + off);
        float v[8] = {bflo(w.x), bfhi(w.x), bflo(w.y), bfhi(w.y), bflo(w.z), bfhi(w.z), bflo(w.w), bfhi(w.w)};
        float ss = 0.f;
#pragma unroll
        for (int k = 0; k < 8; ++k) ss += v[k] * v[k];
        ss += dpp_lane<0xB1>(ss); ss += dpp_lane<0x4E>(ss); ss += dpp_lane<0x141>(ss);
        const float rs = rsqrtf(ss * (1.0f / 64.0f) + 1e-6f);
        const f32x4 g0 = *(const f32x4*)gp, g1 = *(const f32x4*)(gp + 4);
        v4u o; o.x = pk2(v[0] * rs * g0.x, v[1] * rs * g0.y); o.y = pk2(v[2] * rs * g0.z, v[3] * rs * g0.w); o.z = pk2(v[4] * rs * g1.x, v[5] * rs * g1.y); o.w = pk2(v[6] * rs * g1.z, v[7] * rs * g1.w);
        *(v4u*)(pr + off) = o;
    }
}
__device__ __forceinline__ f32x4 ld4bf(const bf16* p) { const v2u w = *(const v2u*)p; return (f32x4){bflo(w.x), bfhi(w.x), bflo(w.y), bfhi(w.y)}; }
__device__ __forceinline__ void mixfinal_row(int r, int lane, const bf16* __restrict__ proj, const bf16* __restrict__ mixraw, const bf16* __restrict__ os, const bf16* __restrict__ ow,
                                             const float* __restrict__ og  , bf16* __restrict__ mix) {
    const bf16* mr = mixraw + (size_t)r * 1024 + 4 * lane;
    f32x4 v[4];
    v[0] = ld4bf(mr); v[2] = ld4bf(mr + 512); v[3] = ld4bf(mr + 768);
    {   const f32x4 oc = ld4bf(mr + 256), s = ld4bf(os + (size_t)r * 256 + 4 * lane), w = ld4bf(ow + (size_t)r * 256 + 4 * lane);
        const bf16* gp = proj + (size_t)r * PW + P_NG + 3 * (lane >> 4);
        const float g0 = sigmoid_f(bf2f(gp[0])), g1 = sigmoid_f(bf2f(gp[1])), g2 = sigmoid_f(bf2f(gp[2]));
        v[1] = oc * g0 + s * g1 + w * g2; }
#pragma unroll
    for (int gi = 0; gi < 4; ++gi) {
        float ss = (v[gi].x * v[gi].x + v[gi].y * v[gi].y) + (v[gi].z * v[gi].z + v[gi].w * v[gi].w);
        ss = wave_sum(ss);
        const float rs = rsqrtf(ss * (1.0f / 256.0f) + 1e-6f);
        const f32x4 g = *(const f32x4*)(og + 256 * gi + 4 * lane);
        v2u o; o.x = pk2(v[gi].x * rs * g.x, v[gi].y * rs * g.y); o.y = pk2(v[gi].z * rs * g.z, v[gi].w * rs * g.w);
        *(v2u*)(mix + (size_t)r * 1024 + 256 * gi + 4 * lane) = o;
    }
}


__device__ __forceinline__ void moe_route(int vb, int wave, int lane, const float* __restrict__ x, const float* __restrict__ g, const float* __restrict__ rw, const float* __restrict__ rb,
                                          bf16* __restrict__ hn, unsigned* __restrict__ tokinfo, float* __restrict__ topw, int* __restrict__ wcnt) {
    int c[8];
#pragma unroll
    for (int e = 0; e < 8; ++e) c[e] = 0;
    const f32x4* gr = (const f32x4*)g + lane;
    f32x4 nv[4];
    {   const f32x4* xr0 = (const f32x4*)(x + (size_t)(128 * vb + 16 * wave) * DM) + lane;
#pragma unroll
        for (int j = 0; j < 4; ++j) nv[j] = xr0[64 * j]; }
#pragma unroll 1
    for (int i = 0; i < 16; ++i) {
        const int row = 128 * vb + 16 * wave + i;
        f32x4 v[4]; float s = 0.f;
#pragma unroll
        for (int j = 0; j < 4; ++j) v[j] = nv[j];
        {   const f32x4* xn = (const f32x4*)(x + (size_t)(row + (i < 15 ? 1 : 0)) * DM) + lane;
#pragma unroll
            for (int j = 0; j < 4; ++j) nv[j] = xn[64 * j]; }
#pragma unroll
        for (int j = 0; j < 4; ++j) s += (v[j].x * v[j].x + v[j].y * v[j].y) + (v[j].z * v[j].z + v[j].w * v[j].w);
        s = wave_sum(s);
        const float rstd = rsqrtf(s * (1.0f / DM) + 1e-6f);
        v2u* o8 = (v2u*)(hn + (size_t)row * DM) + lane;
#pragma unroll
        for (int j = 0; j < 4; ++j) { const f32x4 gv = gr[64 * j]; v[j] = v[j] * rstd * gv; v2u o; o.x = pk2(v[j].x, v[j].y); o.y = pk2(v[j].z, v[j].w); o8[64 * j] = o; }
        float lg[8];
#pragma unroll
        for (int e = 0; e < 8; ++e) lg[e] = 0.f;
#pragma unroll
        for (int j = 0; j < 4; ++j)
#pragma unroll
            for (int k = 0; k < 4; ++k) { const int col = 4 * lane + 256 * j + k; const f32x4 w0 = *(const f32x4*)(rw + (size_t)col * 8), w1 = *(const f32x4*)(rw + (size_t)col * 8 + 4); const float h = v[j][k];
                lg[0] += h * w0.x; lg[1] += h * w0.y; lg[2] += h * w0.z; lg[3] += h * w0.w; lg[4] += h * w1.x; lg[5] += h * w1.y; lg[6] += h * w1.z; lg[7] += h * w1.w; }
#pragma unroll
        for (int e = 0; e < 8; ++e) lg[e] = wave_sum(lg[e]) + rb[e];
        int i1 = 0; float v1 = lg[0];
#pragma unroll
        for (int e = 1; e < 8; ++e) if (lg[e] > v1) { v1 = lg[e]; i1 = e; }
        int i2 = -1; float v2 = -3.0e38f;
#pragma unroll
        for (int e = 0; e < 8; ++e) if (e != i1 && lg[e] > v2) { v2 = lg[e]; i2 = e; }
        i1 = __builtin_amdgcn_readfirstlane(i1); i2 = __builtin_amdgcn_readfirstlane(i2);
        const float e2 = __expf(v2 - v1), w1 = 1.0f / (1.0f + e2), w2 = e2 * w1;
        int r1 = 0, r2 = 0;
#pragma unroll
        for (int e = 0; e < 8; ++e) { if (e == i1) { r1 = c[e]; c[e] += 1; } if (e == i2) { r2 = c[e]; c[e] += 1; } }
        if (lane == 0) { tokinfo[row] = (unsigned)i1 | ((unsigned)i2 << 3) | ((unsigned)r1 << 6) | ((unsigned)r2 << 11); topw[(size_t)row * 2] = w1; topw[(size_t)row * 2 + 1] = w2; }
    }
    int cv = 0;
#pragma unroll
    for (int e = 0; e < 8; ++e) cv = (lane == e) ? c[e] : cv;
    if (lane < 8) wcnt[(vb * 8 + wave) * 8 + lane] = cv;
}
__device__ __forceinline__ void moe_assign(int vb, int tid, LAS int* sm, const int* __restrict__ wcnt, const unsigned* __restrict__ tokinfo, unsigned short* __restrict__ rowtok, int* __restrict__ tokpos, int* __restrict__ mtab) {
    const int wave = tid >> 6, lane = tid & 63;
    {   const int e = tid & 7, part = tid >> 3; int s = 0;
        for (int b = 4 * part; b < 4 * part + 4; ++b)
#pragma unroll
            for (int w = 0; w < 8; ++w) s += wcnt[(b * 8 + w) * 8 + e];
        sm[part * 8 + e] = s; }
    __syncthreads();
    if (tid < 8) { const int e = tid; int total = 0, base = 0;
        for (int p = 0; p < 64; ++p) { const int s = sm[p * 8 + e]; total += s; if (4 * p + 4 <= vb) base += s; }
        for (int b = (vb >> 2) << 2; b < vb; ++b)
#pragma unroll
            for (int w = 0; w < 8; ++w) base += wcnt[(b * 8 + w) * 8 + e];
        sm[512 + e] = total; sm[520 + e] = base; }
    __syncthreads();
    if (tid == 0) { int acc = 0; sm[528] = 0;
        for (int e = 0; e < 8; ++e) { acc += (sm[512 + e] + 255) >> 8; sm[529 + e] = acc; }
        if (vb == 0) { for (int e = 0; e < 9; ++e) mtab[e] = sm[528 + e]; } }
    __syncthreads();
    if (lane < 16) {
        const int row = 128 * vb + 16 * wave + lane; const unsigned info = tokinfo[row];
        const int e1 = info & 7, e2 = (info >> 3) & 7, r1 = (info >> 6) & 31, r2 = (info >> 11) & 31;
        int wb1 = 0, wb2 = 0;
        for (int w = 0; w < wave; ++w) { wb1 += wcnt[(vb * 8 + w) * 8 + e1]; wb2 += wcnt[(vb * 8 + w) * 8 + e2]; }
        const int p1 = 256 * sm[528 + e1] + sm[520 + e1] + wb1 + r1, p2 = 256 * sm[528 + e2] + sm[520 + e2] + wb2 + r2;
        rowtok[p1] = (unsigned short)row; rowtok[p2] = (unsigned short)row; tokpos[(size_t)row * 2] = p1; tokpos[(size_t)row * 2 + 1] = p2;
    }
    if (vb < 8) { const int e = vb; for (int p = 256 * sm[528 + e] + sm[512 + e] + tid; p < 256 * sm[529 + e]; p += 512) rowtok[p] = 0; }
    __syncthreads();
}
template <bool EARLY>
__device__ __forceinline__ void moe_combine(int row, int lane, float* __restrict__ out, const bf16* __restrict__ Y, const int* __restrict__ tokpos, const float* __restrict__ topw, int tail0) {
    const int p0 = tokpos[(size_t)row * 2], p1 = tokpos[(size_t)row * 2 + 1];
    if (((p0 < tail0) && (p1 < tail0)) != EARLY) return;
    const float w0 = topw[(size_t)row * 2], w1 = topw[(size_t)row * 2 + 1];
    f32x4* xr = (f32x4*)(out + (size_t)row * DM) + lane; const v2u* y0 = (const v2u*)(Y + (size_t)p0 * DM) + lane; const v2u* y1 = (const v2u*)(Y + (size_t)p1 * DM) + lane;
#pragma unroll
    for (int j = 0; j < 4; ++j) { f32x4 v = xr[64 * j]; const v2u a = y0[64 * j], b = y1[64 * j];
        v.x += w0 * bflo(a.x) + w1 * bflo(b.x); v.y += w0 * bfhi(a.x) + w1 * bfhi(b.x); v.z += w0 * bflo(a.y) + w1 * bflo(b.y); v.w += w0 * bfhi(a.y) + w1 * bfhi(b.y); xr[64 * j] = v; }
}
__device__ __forceinline__ void moe_combine_late16(int row0, int lane, float* __restrict__ out, const bf16* __restrict__ Y, const int* __restrict__ tokpos, const float* __restrict__ topw, int tail0) {
    bool late = false;
    if (lane < 16) { const int p0 = tokpos[(size_t)(row0 + lane) * 2], p1 = tokpos[(size_t)(row0 + lane) * 2 + 1]; late = !((p0 < tail0) && (p1 < tail0)); }
    unsigned long long m = __ballot(late);
    while (m) { const int i = __builtin_ctzll(m); m &= m - 1; moe_combine<false>(row0 + i, lane, out, Y, tokpos, topw, tail0); }
}

constexpr int NPH = 16;
struct Args { const float* in[32]; float* out; unsigned char* ws; int ph_lo, ph_hi; };
typedef const __attribute__((address_space(4))) Args* KArgs;
__device__ __forceinline__ KArgs get_args() { KArgs p = (KArgs)__builtin_amdgcn_kernarg_segment_ptr(); asm volatile("" : "+s"(p)); return p; }
#define LOCALS  int tid = wave0 * 64 + (int)__builtin_amdgcn_mbcnt_hi(~0u, __builtin_amdgcn_mbcnt_lo(~0u, 0u)); asm volatile("" : "+v"(tid)); const int lane = tid & 63, wave = __builtin_amdgcn_readfirstlane(tid >> 6), gw = blockIdx.x * NWAVES + wave, gx = (((G & 7) == 0) ? ((int)(blockIdx.x & 7) * (G >> 3) + (int)(blockIdx.x >> 3)) : (int)blockIdx.x) * NWAVES + wave  , ngw = G * NWAVES, half = tid >> 8, htid = tid & 255; \
    LAS float* scr = (LAS float*)(lds + RING_OFF + wave * 16384); LAS float* hsm = (LAS float*)(lds + RING_OFF + half * 32768); (void)lane; (void)gw; (void)gx; (void)ngw; (void)htid; (void)scr; (void)hsm; \
    KArgs A_ = get_args(); unsigned char* ws = A_->ws; float* out = A_->out; \
    bf16* HN = (bf16*)(ws + WS_HN); bf16* PROJ = (bf16*)(ws + WS_PROJ); \
    bf16* MIXRAW = (bf16*)(ws + WS_MIXRAW); bf16* OCMP = MIXRAW + 256; bf16* OS = (bf16*)(ws + WS_OS); bf16* OW = (bf16*)(ws + WS_OW); bf16* HG = (bf16*)(ws + WS_HG); float* GA = (float*)(ws + WS_GA); float* GLAS = (float*)(ws + WS_GLAS); float* GLAD = (float*)(ws + WS_GLAD); float* S5X = (float*)(ws + WS_S5X); \
    float* KC = (float*)(ws + WS_KC); float* VC = (float*)(ws + WS_VC); unsigned long long* SEL = (unsigned long long*)(ws + WS_SEL); float* CW = (float*)(ws + WS_CW); \
    (void)GA; (void)GLAS; (void)GLAD; (void)S5X; (void)out; (void)HN; (void)PROJ; (void)MIXRAW; (void)OCMP; (void)OS; (void)OW; (void)HG; (void)KC; (void)VC; (void)SEL; (void)CW;
#define IN(i) (A_->in[i])
__global__ void __launch_bounds__(NWAVES * 64, 2) mk_fwd(Args args) {
    extern __shared__ __attribute__((aligned(16))) unsigned char lds_raw[];
    LAS unsigned char* lds = (LAS unsigned char*)lds_raw;
    const int G = gridDim.x;
    const int wave0 = __builtin_amdgcn_readfirstlane(threadIdx.x >> 6);
    for (int u = threadIdx.x; u < (LDS_BYTES - LDSCTL_OFF) / 4; u += NWAVES * 64) ((LAS unsigned*)(lds + LDSCTL_OFF))[u] = 0u;
    __syncthreads();
    volatile LAS unsigned* MISC = (volatile LAS unsigned*)(lds + MISC_OFF);
    XcdBarrier bar = xcd_barrier_post((unsigned*)(args.ws + WS_CTL) + CW_BAR, MISC + 8);
    const int lo = args.ph_lo, hi = args.ph_hi;
#ifndef PROBE_DUP
#define PROBE_DUP -1
#endif
#ifndef PROBE_SUB
#define PROBE_SUB -1
#endif
#define SUBREP(id) _Pragma("unroll") for (int rep2_ = 0; rep2_ < (((id) == PROBE_SUB) ? 2 : 1); ++rep2_)
#define PH(k) const int pc##k = l * NPH + (k); _Pragma("unroll") for (int rep_ = 0; rep_ < (((k) == PROBE_DUP) ? 2 : 1); ++rep_) if (lo <= pc##k && pc##k < hi)
#define SEAM(k) do { if (pc##k + 1 < hi) xcd_barrier(bar); } while (0)

    {   const int l = -1;
        PH(15) { LOCALS
            for (int ll = 0; ll < 2; ++ll) {
                ConvJob j1{IN(2) + (size_t)ll * DM * PROJ_SRC, nullptr, (bf16*)(ws + WS_WIN) + (size_t)ll * PW * DM, PROJ_SRC, DM, PROJ_SRC, PW, DM, 1, 0, ll == 1 ? IN(1) + DM : nullptr};
                conv_run(j1, scr, gw, ngw, lane);
                ConvJob j2{IN(22) + (size_t)ll * DM * DM, nullptr, (bf16*)(ws + WS_WOUT) + (size_t)ll * DM * DM, DM, DM, DM, DM, DM, 0, 0};
                conv_fast(j2, gw, ngw, lane);
                for (int wh = 0; wh < 2; ++wh) { ConvJob j6{IN(6) + (size_t)(ll * 2 + wh) * 2048 * 256, nullptr, (bf16*)(ws + WS_W1CT) + (size_t)(ll * 2 + wh) * 256 * 2048, 256, 2048, 256, 256, 2048, 0, 0};
                    conv_fast(j6, gw, ngw, lane); }
                for (int wh = 0; wh < 2; ++wh) { ConvJob j7{IN(7) + (size_t)(ll * 2 + wh) * 256 * 64, nullptr, (bf16*)(ws + WS_W2T) + (size_t)(ll * 2 + wh) * 64 * 256, 64, 256, 64, 64, 256, 0, 0};
                    conv_run(j7, scr, gw, ngw, lane); }
                ConvJob j5{IN(19) + (size_t)ll * 65536, nullptr, (bf16*)(ws + WS_WGLU) + (size_t)ll * 65536, 256, 256, 256, 256, 256, 0, 0};
                conv_fast(j5, gw, ngw, lane);
            }
            {   const int o = blockIdx.x * 512 + tid;
                if (o < 1024) { const float* pp = IN(5) + (size_t)(o >> 8) * 2048; const float* wp = IN(6) + (size_t)(o >> 8) * 2048 * 256 + (o & 255); float a = 0.f;
                    _Pragma("unroll 64") for (int i = 0; i < 2048; ++i) a += pp[i] * wp[(size_t)i * 256];
                    ((float*)(ws + WS_BIASP))[o] = a; } }
            for (int it = blockIdx.x * 512 + tid; it < 2 * 1024 * 16; it += G * 512) { const int ll = it >> 14, gn = (it >> 4) & 1023;
                s5_table_item(gn, it & 15, IN(11) + ll * 1024, IN(12) + ll * 1024, IN(13) + ll * 16384, IN(14) + ll * 16384, IN(18) + ll * 16, (f32x2*)(ws + WS_S5TAB) + (size_t)ll * 1024 * 48); }
        }
    }
#pragma clang loop unroll(full)
    for (int l = 0; l < 2; ++l) {
        PH(0) { LOCALS
            if (l == 0) { for (int row = gw; row < NT; row += ngw) k_norm<false>(row, lane, IN(0), IN(1), HN, nullptr, nullptr, nullptr);
                SEAM(0); }
        }
        PH(1) { LOCALS
            pg8::StaticOrder S; S.init(NT, PW, G, (int)blockIdx.x);
            if (l == 0) { pg8::Gemm g{HN, (bf16*)(ws + WS_WIN), NT, PW, DM}; pg8::EpiStoreBf16 Ep{PROJ, PW};
                pg8::gemm_phase<pg8::EpiStoreBf16, pg8::StaticOrder, false, true>(lds + RING_OFF, g, S, Ep, nullptr, wave0); }
            else { pg8::Gemm g{(bf16*)(ws + WS_XB), (bf16*)(ws + WS_WIN) + (size_t)PW * DM, NT, PW, DM}; pg8::EpiStoreBf16N Ep{PROJ, PW, (const float*)(ws + WS_SSQ)};
                pg8::gemm_phase<pg8::EpiStoreBf16N, pg8::StaticOrder, false, true>(lds + RING_OFF, g, S, Ep, nullptr, wave0); }
            SEAM(1);
        }
        PH(2) { LOCALS
            if (blockIdx.x < 16) {
                LAS unsigned short* gidx = (LAS unsigned short*)(lds + GIDX_OFF);
                if (tid < 256) { int R = 256 * (blockIdx.x & 7) + tid; R = R < NB * NCMP ? R : NB * NCMP - 1; const int bb = R / NCMP, cc = R - bb * NCMP;
                    gidx[tid] = (unsigned short)((bb * SQ + 16 * cc) | ((blockIdx.x >> 3) << 15)); }
                __syncthreads();
                pg8::Gemm g{PROJ + P_KC, (bf16*)(ws + WS_W1CT) + (size_t)l * 512 * 2048, 4096, 512, 2048, PW, PW * 2, P_VC - P_KC};
                pg8::FirstNOrder S{16, (int)blockIdx.x, 8}; pg8::EpiGeluBias Ep{(bf16*)(ws + WS_CHID), 256, (const float*)(ws + WS_BIASP) + l * 512};
                pg8::gemm_phase<pg8::EpiGeluBias, pg8::FirstNOrder, true, true, true>(lds + RING_OFF, g, S, Ep, gidx, wave0);
            }
            if (G > 32) {
                if (blockIdx.x >= 16) { const int gw2 = gw - 16 * NWAVES, ngw2 = ngw - 16 * NWAVES;
                    const int gs5 = ngw2 - 1 - gw2, ggt = (gw2 + (ngw2 >> 1)) % ngw2;
                    if (wave & 4) s5_mfma_pass<false>(gs5, ngw2, lane, (LAS unsigned char*)scr, PROJ, (const f32x2*)(ws + WS_S5TAB) + (size_t)l * 1024 * 48, nullptr, nullptr, nullptr, S5X, nullptr);
                    for (int r8 = gw2; r8 < NT / 8; r8 += ngw2) headnorm8(8 * r8, lane, PROJ, IN(3) + l * 128, IN(4) + l * 256);
                    for (int row = ggt; row < NT; row += ngw2) gla_gate_row(row, lane, PROJ, IN(8) + l * 16 * 128, IN(9) + l * 128, GA);
                    if (!(wave & 4)) s5_mfma_pass<false>(gs5, ngw2, lane, (LAS unsigned char*)scr, PROJ, (const f32x2*)(ws + WS_S5TAB) + (size_t)l * 1024 * 48, nullptr, nullptr, nullptr, S5X, nullptr); }
            } else {
                for (int r8 = gw; r8 < NT / 8; r8 += ngw) headnorm8(8 * r8, lane, PROJ, IN(3) + l * 128, IN(4) + l * 256);
                for (int row = gw; row < NT; row += ngw) gla_gate_row(row, lane, PROJ, IN(8) + l * 16 * 128, IN(9) + l * 128, GA);
            }
            SEAM(2);
        }
        PH(3) { LOCALS
            if (wave & 4) { for (int job = gx; job < NB * 4 * NSEG; job += ngw) gla_seg<false>(job, lane, (LAS unsigned char*)scr, PROJ, GA, GLAS, GLAD, nullptr, nullptr); }
            SUBREP(35) for (int jw = gw; jw < 256; jw += ngw) cmp_second_job(jw, lane, (const bf16*)(ws + WS_CHID), (const bf16*)(ws + WS_W2T) + (size_t)l * 2 * 64 * 256, IN(4) + l * 256 + 64, (bf16*)(ws + WS_KCB), (bf16*)(ws + WS_VCB));
            SUBREP(31) for (int job = gx; job < NB * 4 * 128; job += ngw) dil_p1_job(job, lane, (LAS unsigned char*)scr, PROJ, (float*)(ws + WS_DO1), (float*)(ws + WS_DL1));
            SUBREP(32) for (int rnd = 0, job; rnd * ngw < NT / 8; ++rnd) if ((job = rnd * ngw + ((rnd & 1) ? (ngw - 1 - gx) : gx)) < NT / 8) nsa_win_job(job, lane, (LAS unsigned char*)scr, PROJ, OW);
            if (!(wave & 4)) { for (int job = gx; job < NB * 4 * NSEG; job += ngw) gla_seg<false>(job, lane, (LAS unsigned char*)scr, PROJ, GA, GLAS, GLAD, nullptr, nullptr); }
            if (G <= 32) { SUBREP(34) s5_mfma_pass<false>(gx, ngw, lane, (LAS unsigned char*)scr, PROJ, (const f32x2*)(ws + WS_S5TAB) + (size_t)l * 1024 * 48, nullptr, nullptr, nullptr, S5X, nullptr); }
            SEAM(3);
        }
        PH(4) { LOCALS
            { LOCALS
              if (G >= NB * 4 * 8) {
                  if (wave == 7 && (int)blockIdx.x < NB * 4 * 8) gla_scan((int)blockIdx.x, lane, GLAS, GLAD);
                  else if (wave == 6 && (int)blockIdx.x < NB * 16) s5_scan((int)blockIdx.x, lane, IN(11) + l * 1024, IN(12) + l * 1024, IN(18) + l * 16, S5X);
              } else {
                  if (gw < NB * 4 * 8) gla_scan(gw, lane, GLAS, GLAD);
                  else if (gw < NB * 4 * 8 + NB * 16) s5_scan(gw - NB * 4 * 8, lane, IN(11) + l * 1024, IN(12) + l * 1024, IN(18) + l * 16, S5X); } }
            { LOCALS
            SUBREP(41) for (int rnd = 0, job; rnd * ngw < NT / 8; ++rnd) if ((job = rnd * ngw + ((rnd & 1) ? (ngw - 1 - gx) : gx)) < NT / 8) nsa_cmp_job(job, lane, (LAS unsigned char*)scr, PROJ, (const bf16*)(ws + WS_KCB), (const bf16*)(ws + WS_VCB), OCMP, 1024, SEL);
            SUBREP(42) for (int job = gx; job < NB * 4 * 16 * 16; job += ngw) dil_job(job, lane, (LAS unsigned char*)scr, PROJ, MIXRAW, (const float*)(ws + WS_DO1), (const float*)(ws + WS_DL1)); }
            SEAM(4);
        }
        PH(5) { LOCALS
            if (wave & 4) { for (int job = gx; job < NB * 4 * NSEG; job += ngw) gla_seg<true>(job, lane, (LAS unsigned char*)scr, PROJ, GA, GLAS, GLAD, IN(10) + l * 64, MIXRAW);
                s5_mfma_pass<true>(gx, ngw, lane, (LAS unsigned char*)scr, PROJ, (const f32x2*)(ws + WS_S5TAB) + (size_t)l * 1024 * 48, IN(15) + l * 16384, IN(16) + l * 16384, IN(17) + l * 256, S5X, HG); }
            SUBREP(51) for (int rnd = 0, job; rnd * ngw < NT / 8; ++rnd) if ((job = rnd * ngw + ((rnd & 1) ? (ngw - 1 - gx) : gx)) < NT / 8) nsa_sel_job(job, lane, (LAS unsigned char*)scr, PROJ, SEL, OS);
            if (!(wave & 4)) { for (int job = gx; job < NB * 4 * NSEG; job += ngw) gla_seg<true>(job, lane, (LAS unsigned char*)scr, PROJ, GA, GLAS, GLAD, IN(10) + l * 64, MIXRAW);
                s5_mfma_pass<true>(gx, ngw, lane, (LAS unsigned char*)scr, PROJ, (const f32x2*)(ws + WS_S5TAB) + (size_t)l * 1024 * 48, IN(15) + l * 16384, IN(16) + l * 16384, IN(17) + l * 256, S5X, HG); }
            SEAM(5);
        }
        PH(6) { LOCALS
            pg8::Gemm g{HG, (bf16*)(ws + WS_WGLU) + (size_t)l * 65536, NT, 256, 256}; pg8::StaticOrder S; S.init(NT, 256, G, (int)blockIdx.x);
            pg8::EpiGlu Ep{HG, IN(20) + l * 256, MIXRAW + 768, 1024};
            pg8::gemm_phase<pg8::EpiGlu, pg8::StaticOrder, true, true>(lds + RING_OFF, g, S, Ep, nullptr, wave0);
            {   const int c0 = (G > 128) ? 128 : 0;
                if ((int)blockIdx.x >= c0) { const int gw2 = gw - c0 * NWAVES, ngw2 = ngw - c0 * NWAVES;
                    if (l == 0) {
                        ConvJob j3{IN(24), IN(25), (bf16*)(ws + WS_WFGU), DFF, DM, DFF, 2 * DFFP, DM, 2, 0, IN(23)};
                        conv_fast(j3, gw2, ngw2, lane);
                        ConvJob j4{IN(26), nullptr, (bf16*)(ws + WS_WFDN), DM, DFF, DM, DM, DFFP, 0, 0};
                        conv_fast(j4, gw2, ngw2, lane);
                    } else {
                        constexpr int NIT = (MOE_HH / 32) * (DM / 256);
                        for (int git = 4 * NIT + gw2; git < NEXP * NIT; git += ngw2) { const int e = git / NIT;
                            ConvJob j2{IN(31) + (size_t)e * DFE * DM, nullptr, (bf16*)(ws + WS_W2H) + (size_t)e * DM * MOE_HH, DM, MOE_HH, DM, DM, MOE_HH, 0, 0};
                            conv_fast_item(j2, git - e * NIT, lane); } } } }
            SEAM(6);
        }
        PH(7) { LOCALS
            for (int row = gw; row < NT; row += ngw) mixfinal_row(row, lane, PROJ, MIXRAW, OS, OW, IN(21) + l * 1024, HN);
            SEAM(7);
        }
        PH(8) { LOCALS
            pg8::Gemm g{HN, (bf16*)(ws + WS_WOUT) + (size_t)l * DM * DM, NT, DM, DM}; pg8::StaticOrder S; S.init(NT, DM, G, (int)blockIdx.x);
            if (l == 0) { pg8::EpiResF32N Ep{IN(0), out, (bf16*)(ws + WS_XB), (float*)(ws + WS_SSQ)};
                pg8::gemm_phase<pg8::EpiResF32N, pg8::StaticOrder, true, true>(lds + RING_OFF, g, S, Ep, nullptr, wave0); }
            else { pg8::EpiResF32 Ep{(const float*)out, out, DM};
                pg8::gemm_phase<pg8::EpiResF32, pg8::StaticOrder, true, true>(lds + RING_OFF, g, S, Ep, nullptr, wave0); }
            SEAM(8);
        }
#define MOE_VCU ((((G & 7) == 0) ? ((int)(blockIdx.x & 7) * (G >> 3) + (int)(blockIdx.x >> 3)) : (int)blockIdx.x))
#define MOE_CONV_W1(hf, c0) do { constexpr int NIT = (DM / 32) * (MOE_NPN * 256 / 256); if (MOE_VCU >= (c0)) for (int git = (MOE_VCU - (c0)) * NWAVES + wave; git < NEXP * NIT; git += ngw - (c0) * NWAVES) { const int e = git / NIT; \
                ConvJob j1{IN(29) + (size_t)e * DM * DFE, IN(30) + (size_t)e * DM * DFE, (bf16*)(ws + WS_W1H) + (size_t)e * MOE_NPN * 256 * DM, DFE, DM, DFE, MOE_NPN * 256, DM, 2, (hf) * MOE_HH}; \
                conv_fast_item(j1, git - e * NIT, lane); } } while (0)
#define MOE_CONV_W2(hf, c0, ne) do { constexpr int NIT = (MOE_HH / 32) * (DM / 256); if (MOE_VCU >= (c0)) for (int git = (MOE_VCU - (c0)) * NWAVES + wave; git < (ne) * NIT; git += ngw - (c0) * NWAVES) { const int e = git / NIT; \
                ConvJob j2{IN(31) + (size_t)e * DFE * DM + (size_t)(hf) * MOE_HH * DM, nullptr, (bf16*)(ws + WS_W2H) + (size_t)e * DM * MOE_HH, DM, MOE_HH, DM, DM, MOE_HH, 0, 0}; \
                conv_fast_item(j2, git - e * NIT, lane); } } while (0)
        PH(9) { LOCALS
            if (l == 1) { if (wave & 1) MOE_CONV_W1(0, 0);
                for (int vb = blockIdx.x; vb < 256; vb += G) moe_route(vb, wave, lane, out, IN(23) + l * DM, IN(27), IN(28), HN, (unsigned*)(ws + WS_TOKINFO), (float*)(ws + WS_TOPW), (int*)(ws + WS_WCNT));
                if (!(wave & 1)) MOE_CONV_W1(0, 0);
                SEAM(9); }
        }
        if (l == 0) {
            PH(10) { LOCALS
                {   pg8::Gemm g{(bf16*)(ws + WS_XB), (bf16*)(ws + WS_WFGU), NT, 2 * DFFP, DM}; pg8::StaticOrder S; S.init(NT, 2 * DFFP, G, (int)blockIdx.x);
                    pg8::EpiSwigluN Ep{(bf16*)(ws + WS_FH), DFFP, 1 << 20, (const float*)(ws + WS_SSQ)};
                    pg8::gemm_phase<pg8::EpiSwigluN, pg8::StaticOrder, true, true>(lds + RING_OFF, g, S, Ep, nullptr, wave0); }
                xcd_barrier(bar);
                {   pg8::Gemm g{(bf16*)(ws + WS_FH), (bf16*)(ws + WS_WFDN), NT, DM, DFFP}; pg8::StaticOrder S; S.init(NT, DM, G, (int)blockIdx.x);
                    pg8::EpiResF32N Ep{out, out, (bf16*)(ws + WS_XB), (float*)(ws + WS_SSQ)};
                    pg8::gemm_phase<pg8::EpiResF32N, pg8::StaticOrder, true, true>(lds + RING_OFF, g, S, Ep, nullptr, wave0); }
                SEAM(10);
            }
        } else {
#define MOE_ORDER(S, NPNL) pg8::MoeOrder S; { const int* mt = (const int*)(ws + WS_MTAB); _Pragma("unroll") for (int e = 0; e < 9; ++e) S.ts[e] = __builtin_amdgcn_readfirstlane(mt[e]); S.npn = (NPNL); S.nunits = S.ts[8] * (NPNL); S.G = G; S.c = ((G & 7) == 0) ? ((int)(blockIdx.x & 7) * (G >> 3) + (int)(blockIdx.x >> 3)) : (int)blockIdx.x; }
#define MOE_GU() do { MOE_ORDER(S, MOE_NPN); \
                LAS unsigned short* gidx = (LAS unsigned short*)(lds + GIDX_OFF); const unsigned short* rowtok = (const unsigned short*)(ws + WS_ROWTOK); \
                { pg8::Unit u; for (int i = 0; S.next(i, u); ++i) { if (tid < 256) gidx[i * 256 + tid] = rowtok[u.pm * 256 + tid]; } } \
                __syncthreads(); \
                pg8::Gemm g{HN, (bf16*)(ws + WS_W1H), NT, NEXP * MOE_NPN * 256, DM, DM, 128, 0}; pg8::EpiSwiglu Ep{(bf16*)(ws + WS_MHID), MOE_HH, MOE_NPN}; \
                pg8::gemm_phase<pg8::EpiSwiglu, pg8::MoeOrder, true, true, true>(lds + RING_OFF, g, S, Ep, gidx, wave0); } while (0)
            PH(10) { LOCALS
                for (int vb = blockIdx.x; vb < 256; vb += G) moe_assign(vb, tid, (LAS int*)(lds + RING_OFF + 65536), (const int*)(ws + WS_WCNT), (const unsigned*)(ws + WS_TOKINFO), (unsigned short*)(ws + WS_ROWTOK), (int*)(ws + WS_TOKPOS), (int*)(ws + WS_MTAB));
                SEAM(10);
            }
            PH(11) { LOCALS
                MOE_GU();
                { const int* mt = (const int*)(ws + WS_MTAB); const int rem = (__builtin_amdgcn_readfirstlane(mt[8]) * MOE_NPN) % G; const int c0 = (rem <= G / 2) ? rem : 0;
                  MOE_CONV_W2(0, c0, 4); }
                SEAM(11);
            }
            PH(12) { LOCALS
                {   MOE_ORDER(S, 4);
                    pg8::Gemm g{(bf16*)(ws + WS_MHID), (bf16*)(ws + WS_W2H), MOE_ROWS, NEXP * DM, MOE_HH}; pg8::EpiYBf16<false> Ep{(bf16*)(ws + WS_MY), DM, 4};
                    pg8::gemm_phase<pg8::EpiYBf16<false>, pg8::MoeOrder, true, true>(lds + RING_OFF, g, S, Ep, nullptr, wave0); }
                { const int* mt = (const int*)(ws + WS_MTAB); const int rem = (__builtin_amdgcn_readfirstlane(mt[8]) * 4) % G; const int c0 = (rem <= G / 2) ? rem : 0;
                  MOE_CONV_W1(1, c0); }
                SEAM(12);
            }
            PH(13) { LOCALS
                MOE_GU();
                { const int* mt = (const int*)(ws + WS_MTAB); const int rem = (__builtin_amdgcn_readfirstlane(mt[8]) * MOE_NPN) % G; const int c0 = (rem <= G / 2) ? rem : 0;
                  MOE_CONV_W2(1, c0, NEXP); }
                SEAM(13);
            }
            PH(14) {
                int tail0 = 0x7fffffff, rem = 0, vc = 0;
                {   LOCALS MOE_ORDER(S, 4);
                    const int nun = S.nunits, nfull0 = (nun / G) * G, rem0 = nun - nfull0; const bool split = (rem0 > 0) && (rem0 * 4 <= G) && ((nfull0 & 31) == 0);
                    if (split) { S.nunits = nfull0; rem = rem0; tail0 = (nfull0 >> 2) * 256; }
                    vc = S.c;
                    pg8::Gemm g{(bf16*)(ws + WS_MHID), (bf16*)(ws + WS_W2H), MOE_ROWS, NEXP * DM, MOE_HH}; pg8::EpiYBf16<true> Ep{(bf16*)(ws + WS_MY), DM, 4};
                    pg8::gemm_phase<pg8::EpiYBf16<true>, pg8::MoeOrder, true, true>(lds + RING_OFF, g, S, Ep, nullptr, wave0); }
                xcd_barrier(bar);
                if (vc < rem) { LOCALS MOE_ORDER(S, 4);
                    S.c = (S.nunits / G) * G + S.c; S.G = 1 << 24;
                    pg8::Gemm g{(bf16*)(ws + WS_MHID), (bf16*)(ws + WS_W2H), MOE_ROWS, NEXP * DM, MOE_HH}; pg8::EpiYBf16<true> Ep{(bf16*)(ws + WS_MY), DM, 4};
                    pg8::gemm_phase<pg8::EpiYBf16<true>, pg8::MoeOrder, true, true>(lds + RING_OFF, g, S, Ep, nullptr, wave0);
                } else { LOCALS
                    for (int row = (vc - rem) * NWAVES + wave; row < NT; row += (G - rem) * NWAVES) moe_combine<true>(row, lane, out, (const bf16*)(ws + WS_MY), (const int*)(ws + WS_TOKPOS), (const float*)(ws + WS_TOPW), tail0); }
                SEAM(14);
            }
            PH(15) { LOCALS
                const int* mt = (const int*)(ws + WS_MTAB); const int nun = __builtin_amdgcn_readfirstlane(mt[8]) * 4, nfull0 = (nun / G) * G, rem0 = nun - nfull0;
                const bool split = (rem0 > 0) && (rem0 * 4 <= G) && ((nfull0 & 31) == 0);
                if (split) { const int tail0 = (nfull0 >> 2) * 256;
                    for (int r16 = gw; r16 < NT / 16; r16 += ngw) moe_combine_late16(16 * r16, lane, out, (const bf16*)(ws + WS_MY), (const int*)(ws + WS_TOKPOS), (const float*)(ws + WS_TOPW), tail0); }
            }
#undef MOE_VCU
#undef MOE_CONV_W1
#undef MOE_CONV_W2
#undef MOE_ORDER
#undef MOE_GU
        }
    }
#undef PH
#undef SEAM
}

#ifndef MK_SPLIT
#define MK_SPLIT 0
#endif
extern "C" void kernel_launch(void* const* d_in, const int* in_sizes, int n_in, void* d_out, int out_size, void* d_ws, size_t ws_size, hipStream_t stream) {
    static int grid = 0;
    if (grid == 0) {
        if (n_in != 32 || in_sizes[0] != NT * DM || out_size != NT * DM || ws_size < WS_END) { fprintf(stderr, "kernel_launch: unexpected shapes (n_in %d, in0 %d, out %d, ws %zu)\n", n_in, n_in > 0 ? in_sizes[0] : -1, out_size, ws_size); grid = -1; return; }
        int dev = 0, cus = 0, per_cu = 0;
        if (hipGetDevice(&dev) != hipSuccess || hipDeviceGetAttribute(&cus, hipDeviceAttributeMultiprocessorCount, dev) != hipSuccess) { grid = -1; return; }
        if (hipFuncSetAttribute((const void*)mk_fwd, hipFuncAttributeMaxDynamicSharedMemorySize, LDS_BYTES) != hipSuccess) { fprintf(stderr, "kernel_launch: hipFuncSetAttribute failed\n"); grid = -1; return; }
        if (hipOccupancyMaxActiveBlocksPerMultiprocessor(&per_cu, (const void*)mk_fwd, NWAVES * 64, LDS_BYTES) != hipSuccess || per_cu < 1) { fprintf(stderr, "kernel_launch: occupancy query says %d blocks per CU\n", per_cu); }
        (void)hipGetLastError();
        grid = cus;
    }
    if (grid < 0) return;
    (void)hipMemsetAsync((unsigned char*)d_ws + WS_CTL, 0, CTL_ZERO_BYTES, stream);
    Args a{};
    for (int i = 0; i < 32; ++i) a.in[i] = (const float*)d_in[i];
    a.out = (float*)d_out; a.ws = (unsigned char*)d_ws;
#if MK_SPLIT
    for (int pc = -1; pc < 2 * NPH; ++pc) { const int k = (pc < 0) ? 15 : pc % NPH; if (pc >= 0 && pc < NPH && k > 10) continue; a.ph_lo = pc; a.ph_hi = pc + 1; hipLaunchKernelGGL(mk_fwd, dim3(grid), dim3(NWAVES * 64), LDS_BYTES, stream, a); }
#else
    a.ph_lo = -1; a.ph_hi = 2 * NPH;
    hipLaunchKernelGGL(mk_fwd, dim3(grid), dim3(NWAVES * 64), LDS_BYTES, stream, a);
#endif
}
```
